# Optimizing an MI355X kernel written in HIP

```python
import jax, jax.numpy as jnp
from jax import lax
import numpy as np

D_MODEL = 1024
BATCH = 4
SEQ = 8192
DEPTH = 1

CTX_LEN = 256
GRID_W = 64

D_SSD = 1024
SSD_HEAD_DIM = 64
SSD_HEADS = D_SSD // SSD_HEAD_DIM
SSD_GROUPS = 4
SSD_HPG = SSD_HEADS // SSD_GROUPS
SSD_STATE = 128
SSD_CONV = 5
SSD_CHUNK = 128
D_CONV = 1024
SC_WIDTH = 3
D_MIX = D_SSD + D_CONV
XBC_DIM = D_SSD + 2 * SSD_GROUPS * SSD_STATE
IN_COLS = D_SSD + XBC_DIM + 2 * SSD_HEADS + 3 * D_CONV

PEER_HEADS = 8
PEER_N_KEYS = 128
PEER_N_EXPERTS = PEER_N_KEYS * PEER_N_KEYS
PEER_TOPK = 16
PEER_QUERY_DIM = 256
PEER_HALF = PEER_QUERY_DIM // 2
PEER_BLOCK = 128

N_MOD = 6
EPS = 1e-6

kernel_name = "hymba_ssd_shortconv_peer_prefix_block"


def rmsnorm(x, g):
    xf = x.astype(jnp.float32)
    y = xf * lax.rsqrt(jnp.mean(xf * xf, axis=-1, keepdims=True) + EPS)
    return y.astype(x.dtype) * g


def modulate(x, shift, scale):
    return x * (1 + scale) + shift


def dwconv_centred(u, w):
    K = w.shape[0]
    p = K // 2
    L = u.shape[-2]
    up = jnp.pad(u, [(0, 0)] * (u.ndim - 2) + [(p, p), (0, 0)])
    out = up[..., 0:L, :] * w[0]
    for k in range(1, K):
        out = out + up[..., k:k + L, :] * w[k]
    return out


def conv_rows(u, w):
    b, L, C = u.shape
    rows = L // GRID_W
    return dwconv_centred(u.reshape(b, rows, GRID_W, C), w).reshape(b, L, C)


def split_proj(proj):
    o = 0
    z = proj[..., o:o + D_SSD]; o += D_SSD
    xbc = proj[..., o:o + XBC_DIM]; o += XBC_DIM
    dt = proj[..., o:o + 2 * SSD_HEADS]; o += 2 * SSD_HEADS
    g_b = proj[..., o:o + D_CONV]; o += D_CONV
    g_c = proj[..., o:o + D_CONV]; o += D_CONV
    v = proj[..., o:o + D_CONV]
    return z, xbc, dt, g_b, g_c, v


def ssd_chunk_scan(xdt, a, bm, cm, h0):
    b, L, G, R, P = xdt.shape
    N = bm.shape[-1]
    Q = SSD_CHUNK
    nc = L // Q
    xdt = xdt.reshape(b, nc, Q, G, R, P)
    a = a.reshape(b, nc, Q, G, R)
    bm = bm.reshape(b, nc, Q, G, N)
    cm = cm.reshape(b, nc, Q, G, N)
    acs = jnp.cumsum(a, axis=2)
    lower = jnp.tril(jnp.ones((Q, Q), bool))[:, :, None, None]
    seg = acs[:, :, :, None] - acs[:, :, None, :]
    decay = jnp.exp(jnp.where(lower, seg, -jnp.inf))
    cb = jnp.einsum('bclgn,bcsgn->bclsg', cm, bm)
    y_diag = jnp.einsum('bclsg,bclsgr,bcsgrp->bclgrp', cb, decay, xdt)
    to_end = jnp.exp(acs[:, :, -1:] - acs)
    states = jnp.einsum('bclgn,bclgr,bclgrp->bcgrpn', bm, to_end, xdt)
    chunk_decay = jnp.exp(acs[:, :, -1])

    def step(h, inp):
        st, dec = inp
        return h * dec[..., None, None] + st, h

    h_final, h_enter = lax.scan(step, h0, (jnp.moveaxis(states, 1, 0), jnp.moveaxis(chunk_decay, 1, 0)))
    h_enter = jnp.moveaxis(h_enter, 0, 1)
    y_off = jnp.einsum('bclgn,bcgrpn,bclgr->bclgrp', cm, h_enter, jnp.exp(acs))
    return (y_diag + y_off).reshape(b, L, G, R, P), h_final


def ssd_prepare(xbc, dt_raw, conv_fn, conv_w, conv_b, dt_bias, a_log):
    xbc = jax.nn.silu(conv_fn(xbc, conv_w) + conv_b).astype(jnp.float32)
    b, L, _ = xbc.shape
    gn = SSD_GROUPS * SSD_STATE
    xs = xbc[..., :D_SSD].reshape(b, L, SSD_GROUPS, SSD_HPG, SSD_HEAD_DIM)
    bm = xbc[..., D_SSD:D_SSD + gn].reshape(b, L, SSD_GROUPS, SSD_STATE)
    cm = xbc[..., D_SSD + gn:].reshape(b, L, SSD_GROUPS, SSD_STATE)
    dt = jax.nn.softplus(dt_raw.astype(jnp.float32).reshape(b, L, 2, SSD_HEADS) + dt_bias.astype(jnp.float32))
    dt = dt.reshape(b, L, 2, SSD_GROUPS, SSD_HPG)
    a = dt * (-jnp.exp(a_log.astype(jnp.float32))).reshape(2, SSD_GROUPS, SSD_HPG)
    return xs, bm, cm, dt, a


def ssd_direction(xs, bm, cm, dt, a, h0, reverse):
    xdt = xs * dt[..., None]
    if reverse:
        xdt, a, bm, cm = jnp.flip(xdt, 1), jnp.flip(a, 1), jnp.flip(bm, 1), jnp.flip(cm, 1)
    y, h = ssd_chunk_scan(xdt, a, bm, cm, h0)
    if reverse:
        y = jnp.flip(y, 1)
    return y, h


def ssd_bidirectional(xs, bm, cm, dt, a, h0_fwd, h0_bwd):
    y_f, h_f = ssd_direction(xs, bm, cm, dt[:, :, 0], a[:, :, 0], h0_fwd, False)
    y_b, h_b = ssd_direction(xs, bm, cm, dt[:, :, 1], a[:, :, 1], h0_bwd, True)
    return y_f + y_b, h_f, h_b


def ssd_output(y, xs, z, d_skip, norm_g):
    b, L = y.shape[:2]
    y = y + d_skip.astype(jnp.float32).reshape(SSD_GROUPS, SSD_HPG)[..., None] * xs
    y = y.reshape(b, L, D_SSD) * jax.nn.silu(z.astype(jnp.float32))
    yg = y.reshape(b, L, SSD_GROUPS, D_SSD // SSD_GROUPS)
    yg = yg * lax.rsqrt(jnp.mean(yg * yg, axis=-1, keepdims=True) + EPS)
    return yg.reshape(b, L, D_SSD).astype(z.dtype) * norm_g


def shortconv_branch(g_b, g_c, v, conv_fn, w, norm_g):
    return rmsnorm(g_b * conv_fn(g_c * v, w), norm_g)


def token_mixer(h_lat, h_ctx, w_in, ssd_conv_w, ssd_conv_b, dt_bias, a_log, d_skip, ssd_norm_g,
                sc_conv_w, sc_norm_g, w_out, with_ctx_out):
    b = h_lat.shape[0]
    z_l, xbc_l, dt_l, gb_l, gc_l, v_l = split_proj(h_lat @ w_in)
    z_c, xbc_c, dt_c, gb_c, gc_c, v_c = split_proj(h_ctx @ w_in)
    xs_c, bm_c, cm_c, dtd_c, a_c = ssd_prepare(xbc_c, dt_c, dwconv_centred, ssd_conv_w, ssd_conv_b, dt_bias, a_log)
    h0 = jnp.zeros((b, SSD_GROUPS, SSD_HPG, SSD_HEAD_DIM, SSD_STATE), jnp.float32)
    y_c, hc_f, hc_b = ssd_bidirectional(xs_c, bm_c, cm_c, dtd_c, a_c, h0, h0)
    xs_l, bm_l, cm_l, dtd_l, a_l = ssd_prepare(xbc_l, dt_l, conv_rows, ssd_conv_w, ssd_conv_b, dt_bias, a_log)
    y_l, _, _ = ssd_bidirectional(xs_l, bm_l, cm_l, dtd_l, a_l, hc_f, hc_b)
    out_l = jnp.concatenate([ssd_output(y_l, xs_l, z_l, d_skip, ssd_norm_g),
                             shortconv_branch(gb_l, gc_l, v_l, conv_rows, sc_conv_w, sc_norm_g)], axis=-1) @ w_out
    out_c = None
    if with_ctx_out:
        out_c = jnp.concatenate([ssd_output(y_c, xs_c, z_c, d_skip, ssd_norm_g),
                                 shortconv_branch(gb_c, gc_c, v_c, dwconv_centred, sc_conv_w, sc_norm_g)], axis=-1) @ w_out
    return out_l, out_c


def peer(h, w_q, keys, u_tab, v_tab):
    b, L, D = h.shape
    tok = h.reshape(-1, PEER_BLOCK, D)

    def block(xb):
        T = xb.shape[0]
        q = (xb @ w_q).reshape(T, PEER_HEADS, 2, PEER_HALF)
        s = jnp.einsum('thpd,hpnd->thpn', q, keys).astype(jnp.float32)
        sv, si = lax.top_k(s, PEER_TOPK)
        cand = (sv[:, :, 0, :, None] + sv[:, :, 1, None, :]).reshape(T, PEER_HEADS, PEER_TOPK * PEER_TOPK)
        cv, ci = lax.top_k(cand, PEER_TOPK)
        i1 = jnp.take_along_axis(si[:, :, 0], ci // PEER_TOPK, axis=-1)
        i2 = jnp.take_along_axis(si[:, :, 1], ci % PEER_TOPK, axis=-1)
        eid = i1 * PEER_N_KEYS + i2
        g = jax.nn.softmax(cv, axis=-1).astype(xb.dtype)
        u = jnp.take(u_tab, eid, axis=0)
        act = jax.nn.gelu(jnp.einsum('thkd,td->thk', u, xb))
        return jnp.einsum('thk,thkd->td', g * act, jnp.take(v_tab, eid, axis=0))

    return lax.map(block, tok).reshape(b, L, D)


def setup_inputs(seed: int = 0) -> dict:
    key = jax.random.key(seed)
    ks = jax.random.split(key, 24)
    nrm = lambda k, shape, s: jax.random.normal(k, shape, jnp.float32) * s
    gain = lambda k, n: 1.0 + nrm(k, (DEPTH, n), 0.05)
    u = jax.random.uniform(ks[10], (DEPTH, 2, SSD_HEADS), jnp.float32)
    dt0 = jnp.exp(u * (np.log(0.1) - np.log(0.001)) + np.log(0.001)).astype(jnp.float32)
    dt_bias = dt0 + jnp.log(-jnp.expm1(-dt0))
    a_log = jnp.log(jax.random.uniform(ks[11], (DEPTH, 2, SSD_HEADS), jnp.float32, 1.0, 16.0))
    return {
        'x': nrm(ks[0], (BATCH, SEQ, D_MODEL), 1.0),
        'c': nrm(ks[1], (BATCH, D_MODEL), 1.0),
        'ctx': nrm(ks[2], (BATCH, CTX_LEN, D_MODEL), 1.0),
        'c_ctx': nrm(ks[3], (D_MODEL,), 1.0),
        'w_ada': nrm(ks[4], (DEPTH, D_MODEL, N_MOD * D_MODEL), 0.5 * D_MODEL ** -0.5),
        'b_ada': nrm(ks[5], (DEPTH, N_MOD * D_MODEL), 0.02),
        'g_pre_mix': gain(ks[6], D_MODEL),
        'g_post_mix': gain(ks[7], D_MODEL),
        'g_pre_ffn': gain(ks[8], D_MODEL),
        'g_post_ffn': gain(ks[9], D_MODEL),
        'w_in': nrm(ks[12], (DEPTH, D_MODEL, IN_COLS), D_MODEL ** -0.5),
        'ssd_conv_w': nrm(ks[13], (DEPTH, SSD_CONV, XBC_DIM), SSD_CONV ** -0.5),
        'ssd_conv_b': nrm(ks[14], (DEPTH, XBC_DIM), 0.02),
        'ssd_dt_bias': dt_bias,
        'ssd_a_log': a_log,
        'ssd_d': 1.0 + nrm(ks[15], (DEPTH, SSD_HEADS), 0.1),
        'ssd_norm_g': gain(ks[16], D_SSD),
        'sc_conv_w': nrm(ks[17], (DEPTH, SC_WIDTH, D_CONV), SC_WIDTH ** -0.5),
        'sc_norm_g': gain(ks[18], D_CONV),
        'w_out': nrm(ks[19], (DEPTH, D_MIX, D_MODEL), D_MIX ** -0.5),
        'peer_w_q': nrm(ks[20], (DEPTH, D_MODEL, PEER_HEADS * PEER_QUERY_DIM), D_MODEL ** -0.5),
        'peer_keys': nrm(ks[21], (DEPTH, PEER_HEADS, 2, PEER_N_KEYS, PEER_HALF), PEER_HALF ** -0.5),
        'peer_u': nrm(ks[22], (DEPTH, PEER_N_EXPERTS, D_MODEL), D_MODEL ** -0.5),
        'peer_v': nrm(ks[23], (DEPTH, PEER_N_EXPERTS, D_MODEL), D_MODEL ** -0.5),
    }


def reference(x, c, ctx, c_ctx, w_ada, b_ada, g_pre_mix, g_post_mix, g_pre_ffn, g_post_ffn,
              w_in, ssd_conv_w, ssd_conv_b, ssd_dt_bias, ssd_a_log, ssd_d, ssd_norm_g,
              sc_conv_w, sc_norm_g, w_out, peer_w_q, peer_keys, peer_u, peer_v):
    x_lat, x_ctx = x, ctx
    for layer in range(DEPTH):
        last = layer == DEPTH - 1
        mod_l = (jax.nn.silu(c) @ w_ada[layer] + b_ada[layer])[:, None, :]
        mod_c = jax.nn.silu(c_ctx) @ w_ada[layer] + b_ada[layer]
        sh1_l, sc1_l, gt1_l, sh2_l, sc2_l, gt2_l = jnp.split(mod_l, N_MOD, axis=-1)
        sh1_c, sc1_c, gt1_c, sh2_c, sc2_c, gt2_c = jnp.split(mod_c, N_MOD, axis=-1)
        h_l = modulate(rmsnorm(x_lat, g_pre_mix[layer]), sh1_l, sc1_l)
        h_c = modulate(rmsnorm(x_ctx, g_pre_mix[layer]), sh1_c, sc1_c)
        mix_l, mix_c = token_mixer(h_l, h_c, w_in[layer], ssd_conv_w[layer], ssd_conv_b[layer],
                                   ssd_dt_bias[layer], ssd_a_log[layer], ssd_d[layer], ssd_norm_g[layer],
                                   sc_conv_w[layer], sc_norm_g[layer], w_out[layer], not last)
        x_lat = x_lat + gt1_l * rmsnorm(mix_l, g_post_mix[layer])
        h2_l = modulate(rmsnorm(x_lat, g_pre_ffn[layer]), sh2_l, sc2_l)
        x_lat = x_lat + gt2_l * rmsnorm(peer(h2_l, peer_w_q[layer], peer_keys[layer], peer_u[layer], peer_v[layer]),
                                        g_post_ffn[layer])
        if not last:
            x_ctx = x_ctx + gt1_c * rmsnorm(mix_c, g_post_mix[layer])
            h2_c = modulate(rmsnorm(x_ctx, g_pre_ffn[layer]), sh2_c, sc2_c)
            x_ctx = x_ctx + gt2_c * rmsnorm(peer(h2_c, peer_w_q[layer], peer_keys[layer], peer_u[layer], peer_v[layer]),
                                            g_post_ffn[layer])
    return x_lat
```

```cpp
#include <hip/hip_runtime.h>
#include <cstdio>
#include <cstdint>

#define LAS __attribute__((address_space(3)))
typedef unsigned short bf16;
typedef float f32x4 __attribute__((ext_vector_type(4)));
typedef unsigned u32x4 __attribute__((ext_vector_type(4)));
typedef unsigned u32x2 __attribute__((ext_vector_type(2)));

#ifndef G2_WGM
#define G2_WGM 8
#endif
#ifndef G3_WGM
#define G3_WGM 8
#endif
#ifndef G1_WGM
#define G1_WGM 2
#endif
#ifndef U4_TABLE
#define U4_TABLE 1
#endif
#ifndef SLICED_PEER
#define SLICED_PEER 1
#endif
#ifndef PROBE_DBL
#define PROBE_DBL -1
#endif
#ifndef FAST_SSD
#define FAST_SSD 1
#endif
#ifndef N_LAUNCH_PER_PHASE
#define N_LAUNCH_PER_PHASE 0
#endif

constexpr int NB = 4, SEQ = 8192, DM = 1024, CTXL = 256;
constexpr int ML = NB * SEQ, MC = NB * CTXL, MT = ML + MC;
constexpr int N1 = 6400, NMOD = 6144;
constexpr int HEADS = 16, GROUPS = 4;
constexpr float EPS = 1e-6f;
constexpr float STSCALE = 64.f;
constexpr float XSCALE = 16.f;
constexpr float USCALE = 64.f;
#ifndef V4_TABLE
#define V4_TABLE 1
#endif
#ifndef V5_MFMA
#define V5_MFMA 1
#endif
#ifndef FP8_GEMM2
#define FP8_GEMM2 1
#endif
#ifndef TABLES_IN_SELECT
#define TABLES_IN_SELECT 0
#endif
#ifndef FP8_GEMM3
#define FP8_GEMM3 0
#endif
#ifndef FP8_GEMM1
#define FP8_GEMM1 1
#endif
#ifndef G1_ALIGN
#define G1_ALIGN true
#endif
#ifndef FP8_SP2
#define FP8_SP2 true
#endif
#ifndef FP8_TPL
#define FP8_TPL FP8_GEMM2
#endif
#ifndef FUSE_TAIL
#define FUSE_TAIL 0
#endif
constexpr float WSC = 256.f, WLO = 16.f;
constexpr float YSCALE = 16.f, WOSCALE = 64.f, HSCALE = 16.f, WISCALE = 64.f;
constexpr float TSCALE = 32.f;
constexpr int MOD_SH1 = 0, MOD_SC1 = 1024, MOD_GT1 = 2048, MOD_SH2 = 3072, MOD_SC2 = 4096, MOD_GT2 = 5120;

constexpr size_t MiB = 1u << 20;
constexpr size_t WS_CTL = 0, CTL_ZERO_BYTES = 64 * 1024;
constexpr size_t WS_MOD = 1 * MiB;
constexpr size_t WS_DEC = 1 * MiB + 512 * 1024;
constexpr size_t WS_HC = 2 * MiB;
constexpr size_t WS_WIN = 6 * MiB;
constexpr size_t WS_WOUT = 19 * MiB;
constexpr size_t WS_WQK = 23 * MiB;
constexpr size_t WS_DT = 27 * MiB;
constexpr size_t WS_RA = 32 * MiB;
constexpr size_t WS_RB = 160 * MiB;
constexpr size_t WS_RC = 292 * MiB;
constexpr size_t WS_RE = 420 * MiB;
constexpr size_t WS_END = 484 * MiB;
constexpr size_t WS_X1 = WS_RE;
constexpr int CW_BAR = 1024;

constexpr int LDS_BYTES = 147456;
constexpr int MISC_OFF = LDS_BYTES - 128;

__device__ __forceinline__ float bf2f(bf16 b) { return __uint_as_float(((unsigned)b) << 16); }
__device__ __forceinline__ bf16 f2bf(float f) { unsigned u = __float_as_uint(f); return (bf16)((u + 0x7fffu + ((u >> 16) & 1u)) >> 16); }
__device__ __forceinline__ unsigned pk2(float lo, float hi) { return (unsigned)f2bf(lo) | ((unsigned)f2bf(hi) << 16); }
__device__ __forceinline__ float silu_f(float x) { return x / (1.f + __expf(-x)); }
__device__ __forceinline__ float softplus_f(float x) { return x > 20.f ? x : log1pf(__expf(x)); }
__device__ __forceinline__ float gelu_tanh(float x) { const float u = 0.7978845608028654f * (x + 0.044715f * x * x * x); return 0.5f * x * (1.f + tanhf(u)); }
template <int CTRL> __device__ __forceinline__ float dpp_f(float v) { return __builtin_bit_cast(float, __builtin_amdgcn_update_dpp(0, __builtin_bit_cast(int, v), CTRL, 0xf, 0xf, true)); }
template <int CTRL> __device__ __forceinline__ unsigned dpp_u(unsigned v) { return (unsigned)__builtin_amdgcn_update_dpp(0, (int)v, CTRL, 0xf, 0xf, true); }
__device__ __forceinline__ float row16_sum(float v) { v += dpp_f<0xB1>(v); v += dpp_f<0x4E>(v); v += dpp_f<0x141>(v); v += dpp_f<0x140>(v); return v; }
__device__ __forceinline__ float wave_sum(float v) {
    v = row16_sum(v);
    { const unsigned u = __builtin_bit_cast(unsigned, v); auto r = __builtin_amdgcn_permlane16_swap(u, u, false, false); v = __builtin_bit_cast(float, (unsigned)r[0]) + __builtin_bit_cast(float, (unsigned)r[1]); }
    { const unsigned u = __builtin_bit_cast(unsigned, v); auto r = __builtin_amdgcn_permlane32_swap(u, u, false, false); v = __builtin_bit_cast(float, (unsigned)r[0]) + __builtin_bit_cast(float, (unsigned)r[1]); }
    return v;
}
__device__ __forceinline__ unsigned umax2(unsigned a, unsigned b) { return a > b ? a : b; }
__device__ __forceinline__ unsigned wave_umax(unsigned v) {
    v = umax2(v, dpp_u<0xB1>(v)); v = umax2(v, dpp_u<0x4E>(v)); v = umax2(v, dpp_u<0x141>(v)); v = umax2(v, dpp_u<0x140>(v));
    { auto r = __builtin_amdgcn_permlane16_swap(v, v, false, false); v = umax2((unsigned)r[0], (unsigned)r[1]); }
    { auto r = __builtin_amdgcn_permlane32_swap(v, v, false, false); v = umax2((unsigned)r[0], (unsigned)r[1]); }
    return v;
}

#define XB_TMO      128
#define XB_XCNT(j)  (256  + 64 * (j))
#define XB_XSUB(j)  (1280 + 64 * (j))
#define XB_XGEN(j)  (2304 + 64 * (j))
#define XB_TOP      3328
#define XB_TOPGEN   3392
#define XCD_BAR_WORDS 3456
#define XB_SPIN_CAP (1u << 22)
__device__ __forceinline__ unsigned xb_ld(unsigned* p)              { return __hip_atomic_load(p, __ATOMIC_RELAXED, __HIP_MEMORY_SCOPE_AGENT); }
__device__ __forceinline__ unsigned xb_add(unsigned* p, unsigned v) { return __hip_atomic_fetch_add(p, v, __ATOMIC_RELAXED, __HIP_MEMORY_SCOPE_AGENT); }
__device__ __forceinline__ unsigned xb_xcc_id() { return (unsigned)__builtin_amdgcn_s_getreg((3 << 11) | 20) & 0xFu; }
#define XB_SPIN(cond, bar) do { unsigned _sp = 0; while (cond) { __builtin_amdgcn_s_sleep(1); \
    if ((++_sp & 255u) == 0u) { if (xb_ld(&(bar)[XB_TMO])) break; if (_sp > XB_SPIN_CAP) { atomicAdd(&(bar)[XB_TMO], 1u); break; } } } } while (0)
struct XcdBarrier { unsigned* bar; unsigned x; volatile LAS unsigned* st; };
__device__ __forceinline__ XcdBarrier xcd_barrier_post(unsigned* bar, volatile LAS unsigned* st) {
    XcdBarrier b; b.bar = bar; b.x = xb_xcc_id(); b.st = st;
    if (threadIdx.x == 0) (void)xb_add(&bar[XB_XCNT(b.x)], 1u);
    return b;
}
__device__ __forceinline__ void xcd_barrier_complete(unsigned* bar, unsigned x, unsigned& nloc, unsigned& nx) {
    const unsigned G = gridDim.x * gridDim.y * gridDim.z;
    unsigned sum, cnt, mine, sp = 0u;
    for (;;) {
        sum = 0u; cnt = 0u; mine = 0u;
#pragma unroll
        for (unsigned j = 0; j < 16; ++j) { const unsigned c = xb_ld(&bar[XB_XCNT(j)]); sum += c; cnt += (c > 0u) ? 1u : 0u; mine = (j == x) ? c : mine; }
        if (sum == G) break;
        __builtin_amdgcn_s_sleep(1);
        if ((++sp & 255u) == 0u) { if (xb_ld(&bar[XB_TMO])) break; if (sp > XB_SPIN_CAP) { atomicAdd(&bar[XB_TMO], 1u); break; } }
    }
    nloc = mine > 0u ? mine : 1u; nx = cnt > 0u ? cnt : 1u;
}
__device__ __forceinline__ void xcd_barrier(const XcdBarrier& b) {
    asm volatile("s_waitcnt vmcnt(0)" ::: "memory");
    __syncthreads();
    if (threadIdx.x == 0) {
        unsigned* bar = b.bar;
        __builtin_amdgcn_s_waitcnt(0);
        unsigned nloc = b.st[0], nx = b.st[1];
        if (nloc == 0u) { xcd_barrier_complete(bar, b.x, nloc, nx); b.st[0] = nloc; b.st[1] = nx; }
        const unsigned old = xb_add(&bar[XB_XSUB(b.x)], 1u);
        const unsigned gen = old / nloc;
        if (old + 1u == (gen + 1u) * nloc) {
            __builtin_amdgcn_fence(__ATOMIC_RELEASE, "agent");
            asm volatile("s_waitcnt vmcnt(0)" ::: "memory");
            const unsigned og = xb_add(&bar[XB_TOP], 1u);
            const unsigned tg = og / nx;
            if (og + 1u == (tg + 1u) * nx) xb_add(&bar[XB_TOPGEN], 1u);
            else XB_SPIN(xb_ld(&bar[XB_TOPGEN]) == tg, bar);
            __builtin_amdgcn_fence(__ATOMIC_ACQUIRE, "agent");
            xb_add(&bar[XB_XGEN(b.x)], 1u);
            asm volatile("s_waitcnt vmcnt(0)" ::: "memory");
        } else {
            XB_SPIN(xb_ld(&bar[XB_XGEN(b.x)]) == gen, bar);
            __builtin_amdgcn_fence(__ATOMIC_ACQUIRE, "agent");
            asm volatile("s_waitcnt vmcnt(0)" ::: "memory");
        }
    }
    __syncthreads();
}

namespace pg8 {
#define PG8_LAS __attribute__((address_space(3)))
typedef unsigned short bf16_t;
typedef short bf16x8 __attribute__((ext_vector_type(8)));
typedef float f32x4 __attribute__((ext_vector_type(4)));
typedef unsigned u32x4 __attribute__((ext_vector_type(4)));
constexpr int BM = 256, BK = 64, HALF = 128, HTB = HALF * BK * 2  , STAGE_BYTES = 8 * HTB, NXCD = 8, WGM = 8;

__host__ __device__ __forceinline__ int lds_byte(int r, int c) { const int st = (r >> 4) * 2 + (c >> 5), rr = r & 15, cc = c & 31, ob = rr * 64 + cc * 2; return st * 1024 + (ob ^ (((ob >> 9) & 1) << 5)); }
__host__ __device__ __forceinline__ void stage_rc(int b, int& R, int& C) { const int st = b / 1024, sb = b % 1024, swz = sb ^ (((sb >> 9) & 1) << 5); R = (st >> 1) * 16 + swz / 64; C = (st & 1) * 32 + (swz % 64) / 2; }
__host__ __device__ __forceinline__ int perm32(int rho) { const int n = rho >> 4, i = rho & 15; return 8 * (i >> 2) + 4 * n + (i & 3); }

struct Unit { int pm, pn; };
struct Gemm { const bf16_t* A; const bf16_t* Bt; int M, N, K; };

struct StaticOrder {
    int nM, nN, nwg, G, c, wgm;
    __host__ __device__ void init(int M, int N, int G_, int c_, int wgm_ = WGM) { nM = M / BM; nN = N / BM; nwg = nM * nN; G = G_; c = c_; wgm = wgm_; }
    __host__ __device__ bool next(int i, Unit& u) const {
        const long L = (long)i * G + c; if (L >= nwg) return false;
        int wgid = (int)L; { const int q = nwg / NXCD, r = nwg % NXCD, xcd = wgid % NXCD, off = wgid / NXCD; wgid = (xcd < r ? xcd * (q + 1) : r * (q + 1) + (xcd - r) * q) + off; }
        const int nig = wgm * nN, gid = wgid / nig, fm = gid * wgm, gsz = (nM - fm) < wgm ? (nM - fm) : wgm;
        u.pm = fm + ((wgid % nig) % gsz); u.pn = (wgid % nig) / gsz; return true;
    }
    __device__ __forceinline__ void a_ready(const Unit&) const {}
    __device__ __forceinline__ void done(const Unit&) const {}
};

__device__ __forceinline__ unsigned cvt_pk_bf16(float lo, float hi) { unsigned r; asm volatile("v_cvt_pk_bf16_f32 %0, %1, %2" : "=v"(r) : "v"(lo), "v"(hi)); return r; }
template <class Epi, class Sched, bool ALIGN_EPI = false, bool SP2 = false, bool FP8 = false>
__device__ __forceinline__ void gemm_phase(PG8_LAS unsigned char* lds, const Gemm g, const Sched& S, const Epi& E) {
    const int tid = threadIdx.x, wid = __builtin_amdgcn_readfirstlane(tid >> 6), lane = tid & 63, wr = wid >> 2, wc = wid & 3, fr = lane & 15, fq = lane >> 4;
    const int K = g.K, nt = K / BK;
    unsigned voffA[2], voffB[2];
#pragma unroll
    for (int i = 0; i < 2; ++i) { int R, C; stage_rc(tid * 16 + i * 8192, R, C); const int Rb = Epi::PERM ? ((R & ~31) + perm32(R & 31)) : R;
        voffA[i] = (unsigned)(R * K + C) * 2u; voffB[i] = (unsigned)(Rb * K + C) * 2u; }
    const size_t kstep = (size_t)(BK * 2);
    const size_t hstep = (size_t)HALF * K * 2;
    const size_t tstep = 2 * hstep;
    const unsigned ldsw = (unsigned)wid * 1024u;
    const int aoff = lds_byte(wr * 64 + fr, fq * 8), boff = lds_byte(wc * 32 + fr, fq * 8);
#define PG8_SA(b, h) (((b) * 2 + (h)) * HTB)
#define PG8_SB(b, h) ((4 + (b) * 2 + (h)) * HTB)
#define PG8_STAGE(bufoff, gbase, voff) do { _Pragma("unroll") for (int _i = 0; _i < 2; ++_i) \
        __builtin_amdgcn_global_load_lds((const unsigned*)((const char*)(gbase) + (voff)[_i]), (PG8_LAS unsigned*)(lds + (bufoff) + ldsw + _i * 8192), 16, 0, 0); } while (0)
#define PG8_LDA(dst, b, h) do { _Pragma("unroll") for (int m = 0; m < 4; ++m) { if constexpr (FP8) { \
            const i32x4_ lo_ = *(const PG8_LAS i32x4_*)(lds + PG8_SA(b, h) + aoff + m * 2048), hi_ = *(const PG8_LAS i32x4_*)(lds + PG8_SA(b, h) + aoff + m * 2048 + 1024); \
            dst.wf[m] = __builtin_shufflevector(lo_, hi_, 0, 1, 2, 3, 4, 5, 6, 7); } \
        else { _Pragma("unroll") for (int k = 0; k < 2; ++k) dst.hf[m][k] = *(const PG8_LAS bf16x8*)(lds + PG8_SA(b, h) + aoff + m * 2048 + k * 1024); } } } while (0)
#define PG8_LDB(dst, b, h) do { _Pragma("unroll") for (int n = 0; n < 2; ++n) { if constexpr (FP8) { \
            const i32x4_ lo_ = *(const PG8_LAS i32x4_*)(lds + PG8_SB(b, h) + boff + n * 2048), hi_ = *(const PG8_LAS i32x4_*)(lds + PG8_SB(b, h) + boff + n * 2048 + 1024); \
            dst.wf[n] = __builtin_shufflevector(lo_, hi_, 0, 1, 2, 3, 4, 5, 6, 7); } \
        else { _Pragma("unroll") for (int k = 0; k < 2; ++k) dst.hf[n][k] = *(const PG8_LAS bf16x8*)(lds + PG8_SB(b, h) + boff + n * 2048 + k * 1024); } } } while (0)
#define PG8_MMA(ai, bj, At, Bt) do { __builtin_amdgcn_s_setprio(1); \
        if constexpr (FP8) { _Pragma("unroll") for (int m = 0; m < 4; ++m) _Pragma("unroll") for (int n = 0; n < 2; ++n) \
                asm volatile("v_mfma_scale_f32_16x16x128_f8f6f4 %0, %1, %2, %0, %3, %4 op_sel_hi:[0,0,0]" : "+v"(acc[ai][bj][m][n]) : "v"(Bt.wf[n]), "v"(At.wf[m]), "v"(scb_), "v"(sca_)); } \
        else { _Pragma("unroll") for (int m = 0; m < 4; ++m) _Pragma("unroll") for (int n = 0; n < 2; ++n) _Pragma("unroll") for (int k = 0; k < 2; ++k) \
            acc[ai][bj][m][n] = __builtin_amdgcn_mfma_f32_16x16x32_bf16(Bt.hf[n][k], At.hf[m][k], acc[ai][bj][m][n], 0, 0, 0); } \
        __builtin_amdgcn_s_setprio(0); } while (0)
#define PG8_WAIT_V(n) asm volatile("s_waitcnt vmcnt(" #n ")" ::: "memory")
#define PG8_WAIT_L(n) asm volatile("s_waitcnt lgkmcnt(" #n ")" ::: "memory")
#define PG8_BAR __builtin_amdgcn_s_barrier()
#define PG8_SCHED __builtin_amdgcn_sched_barrier(0)
    Unit cur, nxt; int ui = 0;
    if (!S.next(0, cur)) return;
    f32x4 acc[2][2][4][2];
#pragma unroll
    for (int a = 0; a < 2; ++a)
#pragma unroll
        for (int b = 0; b < 2; ++b)
#pragma unroll
            for (int m = 0; m < 4; ++m)
#pragma unroll
                for (int n = 0; n < 2; ++n) acc[a][b][m][n] = (f32x4){0.f, 0.f, 0.f, 0.f};
    typedef int i32x4_ __attribute__((ext_vector_type(4))); typedef int i32x8_ __attribute__((ext_vector_type(8)));
    struct FragA_ { bf16x8 hf[4][2]; i32x8_ wf[4]; }; struct FragB_ { bf16x8 hf[2][2]; i32x8_ wf[2]; };
    int sca_ = 127, scb_ = 127; if constexpr (FP8) { sca_ = Epi::SCA; scb_ = Epi::SCB; }
    FragA_ At; FragB_ B0, B1;
    const char* cA = (const char*)g.A + (size_t)cur.pm * tstep; const char* cB = (const char*)g.Bt + (size_t)cur.pn * tstep;
    S.a_ready(cur);
    if constexpr (SP2) {
        PG8_STAGE(PG8_SB(0, 0), cB, voffB); PG8_STAGE(PG8_SB(0, 1), cB + hstep, voffB); PG8_STAGE(PG8_SA(0, 0), cA, voffA); PG8_STAGE(PG8_SA(0, 1), cA + hstep, voffA);
        if (wr == 1) PG8_BAR;
        PG8_WAIT_V(2); PG8_BAR;
        PG8_STAGE(PG8_SB(1, 0), cB + kstep, voffB); PG8_STAGE(PG8_SA(1, 0), cA + kstep, voffA); PG8_STAGE(PG8_SB(1, 1), cB + hstep + kstep, voffB);
        PG8_WAIT_V(6); PG8_BAR;
    } else {
        PG8_STAGE(PG8_SB(0, 0), cB, voffB); PG8_STAGE(PG8_SA(0, 0), cA, voffA); PG8_STAGE(PG8_SB(0, 1), cB + hstep, voffB); PG8_STAGE(PG8_SA(0, 1), cA + hstep, voffA);
        if (wr == 1) PG8_BAR;
        PG8_WAIT_V(4); PG8_BAR;
        PG8_STAGE(PG8_SB(1, 0), cB + kstep, voffB); PG8_STAGE(PG8_SA(1, 0), cA + kstep, voffA); PG8_STAGE(PG8_SB(1, 1), cB + hstep + kstep, voffB);
        PG8_WAIT_V(6); PG8_BAR;
    }
    for (;;) {
        const bool has_next = S.next(ui + 1, nxt);
        const char* nA = has_next ? (const char*)g.A + (size_t)nxt.pm * tstep : cA; const char* nB = has_next ? (const char*)g.Bt + (size_t)nxt.pn * tstep : cB;
        for (int t = 0; t < nt; t += 2) {
            const bool last = (t == nt - 2);
            const char* a1 = cA + (size_t)(t + 1) * kstep;
            const char* a2 = last ? nA : cA + (size_t)(t + 2) * kstep; const char* b2 = last ? nB : cB + (size_t)(t + 2) * kstep;
            const char* a3 = a2 + kstep; const char* b3 = b2 + kstep;
            if (last && has_next) S.a_ready(nxt);
            if constexpr (SP2) {
            PG8_LDB(B0, 0, 0); PG8_LDB(B1, 0, 1); PG8_SCHED; PG8_LDA(At, 0, 0); PG8_STAGE(PG8_SA(1, 1), a1 + hstep, voffA);
            PG8_WAIT_V(8); PG8_WAIT_L(0); PG8_BAR; PG8_MMA(0, 0, At, B0); PG8_MMA(0, 1, At, B1); PG8_BAR; PG8_SCHED;
            PG8_LDA(At, 0, 1); PG8_STAGE(PG8_SB(0, 0), b2, voffB); PG8_STAGE(PG8_SB(0, 1), b2 + hstep, voffB); PG8_STAGE(PG8_SA(0, 0), a2, voffA);
            PG8_WAIT_V(8); PG8_WAIT_L(0); PG8_BAR; PG8_MMA(1, 0, At, B0); PG8_MMA(1, 1, At, B1); PG8_BAR; PG8_SCHED;
            PG8_LDB(B0, 1, 0); PG8_LDB(B1, 1, 1); PG8_SCHED; PG8_LDA(At, 1, 0); PG8_STAGE(PG8_SA(0, 1), a2 + hstep, voffA);
            PG8_WAIT_V(8); PG8_WAIT_L(0); PG8_BAR; PG8_MMA(0, 0, At, B0); PG8_MMA(0, 1, At, B1); PG8_BAR; PG8_SCHED;
            PG8_LDA(At, 1, 1); PG8_STAGE(PG8_SB(1, 0), b3, voffB); PG8_STAGE(PG8_SB(1, 1), b3 + hstep, voffB); PG8_STAGE(PG8_SA(1, 0), a3, voffA);
            PG8_WAIT_V(8); PG8_WAIT_L(0); PG8_BAR; PG8_MMA(1, 0, At, B0); PG8_MMA(1, 1, At, B1); PG8_BAR; PG8_SCHED;
            } else {
            PG8_LDB(B0, 0, 0); PG8_SCHED; PG8_LDA(At, 0, 0); PG8_STAGE(PG8_SA(1, 1), a1 + hstep, voffA);
            PG8_WAIT_L(8); PG8_BAR; PG8_WAIT_L(0); PG8_MMA(0, 0, At, B0); PG8_BAR; PG8_SCHED;
            PG8_LDB(B1, 0, 1); PG8_STAGE(PG8_SB(0, 0), b2, voffB);
            PG8_BAR; PG8_WAIT_L(0); PG8_MMA(0, 1, At, B1); PG8_BAR;
            PG8_LDA(At, 0, 1); PG8_STAGE(PG8_SA(0, 0), a2, voffA);
            PG8_BAR; PG8_WAIT_L(0); PG8_MMA(1, 0, At, B0); PG8_BAR; PG8_SCHED;
            PG8_STAGE(PG8_SB(0, 1), b2 + hstep, voffB);
            PG8_WAIT_V(6); PG8_BAR; PG8_MMA(1, 1, At, B1); PG8_BAR;
            PG8_LDB(B0, 1, 0); PG8_SCHED; PG8_LDA(At, 1, 0); PG8_STAGE(PG8_SA(0, 1), a2 + hstep, voffA);
            PG8_WAIT_L(8); PG8_BAR; PG8_WAIT_L(0); PG8_MMA(0, 0, At, B0); PG8_BAR; PG8_SCHED;
            PG8_LDB(B1, 1, 1); PG8_STAGE(PG8_SB(1, 0), b3, voffB);
            PG8_BAR; PG8_WAIT_L(0); PG8_MMA(0, 1, At, B1); PG8_BAR;
            PG8_LDA(At, 1, 1); PG8_STAGE(PG8_SA(1, 0), a3, voffA);
            PG8_BAR; PG8_WAIT_L(0); PG8_MMA(1, 0, At, B0); PG8_BAR; PG8_SCHED;
            PG8_STAGE(PG8_SB(1, 1), b3 + hstep, voffB);
            PG8_WAIT_V(6); PG8_BAR; PG8_MMA(1, 1, At, B1); PG8_BAR;
            }
        }
        if constexpr (ALIGN_EPI) { if (wr == 0) PG8_BAR; }
        if constexpr (FP8) asm volatile("s_nop 15\n\ts_nop 15" ::: "memory");
        if constexpr (!Epi::AFTER_DRAIN) { E(acc, cur, wr, wc, fr, fq); S.done(cur); }
        if (!has_next) break;
#pragma unroll
        for (int a = 0; a < 2; ++a)
#pragma unroll
            for (int b = 0; b < 2; ++b)
#pragma unroll
                for (int m = 0; m < 4; ++m)
#pragma unroll
                    for (int n = 0; n < 2; ++n) acc[a][b][m][n] = (f32x4){0.f, 0.f, 0.f, 0.f};
        cur = nxt; cA = nA; cB = nB; ++ui;
        if constexpr (ALIGN_EPI) { if (wr == 1) PG8_BAR; }
    }
    PG8_WAIT_V(0);
    if constexpr (!ALIGN_EPI) { if (wr == 0) PG8_BAR; }
    PG8_BAR;
    if constexpr (Epi::AFTER_DRAIN) { E.fused(acc, cur, wr, wc, fr, fq, lds, wid, lane); S.done(cur); }
#undef PG8_SA
#undef PG8_SB
#undef PG8_STAGE
#undef PG8_LDA
#undef PG8_LDB
#undef PG8_MMA
#undef PG8_WAIT_V
#undef PG8_WAIT_L
#undef PG8_BAR
#undef PG8_SCHED
}
}

struct Args { const float* in[24]; float* out; unsigned char* ws; int ph_lo, ph_hi; };
struct Ctx {
    const float* const* in; float* out; unsigned char* ws; unsigned char* lds;
    int tid, lane, wave, gw, ngw, gtid, gsz, bid, nblk, qsel;
};
enum { I_X = 0, I_C, I_CTX, I_CCTX, I_WADA, I_BADA, I_GPREMIX, I_GPOSTMIX, I_GPREFFN, I_GPOSTFFN, I_WIN, I_CONVW, I_CONVB, I_DTBIAS, I_ALOG, I_DSKIP,
       I_SSDNORMG, I_SCCONVW, I_SCNORMG, I_WOUT, I_WQ, I_KEYS, I_U, I_V };

__device__ __forceinline__ unsigned pk4_fp8(float a, float b, float c_, float d, float s) {
    a = fminf(fmaxf(a * s, -440.f), 440.f); b = fminf(fmaxf(b * s, -440.f), 440.f); c_ = fminf(fmaxf(c_ * s, -440.f), 440.f); d = fminf(fmaxf(d * s, -440.f), 440.f);
    return (unsigned)__builtin_amdgcn_cvt_pk_fp8_f32(c_, d, __builtin_amdgcn_cvt_pk_fp8_f32(a, b, 0, false), true);
}
__device__ __forceinline__ void transpose_item(const float* W, int K, int N, bf16* WT, int row_off, float* scr, int item, int lane) {
    const int nblk = N / 32, kb = item / nblk, nb = item % nblk, k0 = 64 * kb, n0 = 32 * nb;
#pragma unroll
    for (int i = 0; i < 8; ++i) { const int kk = 8 * i + (lane >> 3), c4 = (lane & 7) * 4; const f32x4 v = *(const f32x4*)(W + (size_t)(k0 + kk) * N + n0 + c4);
        float* d = scr + kk * 33 + c4; d[0] = v.x; d[1] = v.y; d[2] = v.z; d[3] = v.w; }
    asm volatile("s_waitcnt lgkmcnt(0)" ::: "memory");
    const int c = lane & 7;
#pragma unroll
    for (int j = 0; j < 4; ++j) { const int n = (lane >> 3) + 8 * j; const float* s = scr + (8 * c) * 33 + n;
        u32x4 o; o.x = pk2(s[0 * 33], s[1 * 33]); o.y = pk2(s[2 * 33], s[3 * 33]); o.z = pk2(s[4 * 33], s[5 * 33]); o.w = pk2(s[6 * 33], s[7 * 33]);
        *(u32x4*)(WT + (size_t)(row_off + n0 + n) * K + k0 + 8 * c) = o; }
    asm volatile("s_waitcnt lgkmcnt(0)" ::: "memory");
}

__device__ __forceinline__ void transpose_item_fp8(const float* W, int K, int N, unsigned char* WT, int row_off, float* scr, int item, int lane, float sc) {
    const int nblk = N / 32, kb = item / nblk, nb = item % nblk, k0 = 64 * kb, n0 = 32 * nb;
#pragma unroll
    for (int i = 0; i < 8; ++i) { const int kk = 8 * i + (lane >> 3), c4 = (lane & 7) * 4; const f32x4 v = *(const f32x4*)(W + (size_t)(k0 + kk) * N + n0 + c4);
        float* d = scr + kk * 33 + c4; d[0] = v.x; d[1] = v.y; d[2] = v.z; d[3] = v.w; }
    asm volatile("s_waitcnt lgkmcnt(0)" ::: "memory");
    const int c = lane & 7;
#pragma unroll
    for (int j = 0; j < 4; ++j) { const int n = (lane >> 3) + 8 * j; const float* s = scr + (8 * c) * 33 + n;
        u32x2 o;
        o.x = (unsigned)__builtin_amdgcn_cvt_pk_fp8_f32(s[2 * 33] * sc, s[3 * 33] * sc, __builtin_amdgcn_cvt_pk_fp8_f32(s[0 * 33] * sc, s[1 * 33] * sc, 0, false), true);
        o.y = (unsigned)__builtin_amdgcn_cvt_pk_fp8_f32(s[6 * 33] * sc, s[7 * 33] * sc, __builtin_amdgcn_cvt_pk_fp8_f32(s[4 * 33] * sc, s[5 * 33] * sc, 0, false), true);
        *(u32x2*)(WT + (size_t)(row_off + n0 + n) * K + k0 + 8 * c) = o; }
    asm volatile("s_waitcnt lgkmcnt(0)" ::: "memory");
}

__device__ __forceinline__ void phase0(const Ctx& c) {
    float* sct = (float*)c.lds;
    float* red = (float*)(c.lds + 20480);
    float* scr = (float*)(c.lds + 32768 + c.wave * 8704);
    const float* cvec = c.in[I_C]; const float* cctx = c.in[I_CCTX];
    for (int i = c.tid; i < 5 * 1024; i += 512) { const int v = i >> 10, k = i & 1023; const float x = v < 4 ? cvec[v * 1024 + k] : cctx[k]; sct[i] = silu_f(x); }
    __syncthreads();
    float* MOD = (float*)(c.ws + WS_MOD);
    const float* w_ada = c.in[I_WADA]; const float* b_ada = c.in[I_BADA];
    for (int item = c.bid; item < NMOD / 64; item += c.nblk) {
        const int j = item * 64 + c.lane; float acc[5] = {0.f, 0.f, 0.f, 0.f, 0.f};
        for (int k = c.wave * 128; k < c.wave * 128 + 128; ++k) { const float w = w_ada[(size_t)k * NMOD + j];
#pragma unroll
            for (int v = 0; v < 5; ++v) acc[v] += sct[v * 1024 + k] * w; }
#pragma unroll
        for (int v = 0; v < 5; ++v) red[(c.wave * 64 + c.lane) * 5 + v] = acc[v];
        __syncthreads();
        if (c.wave == 0) {
#pragma unroll
            for (int v = 0; v < 5; ++v) { float s = b_ada[j];
                for (int w8 = 0; w8 < 8; ++w8) s += red[(w8 * 64 + c.lane) * 5 + v];
                MOD[v * NMOD + j] = s; } }
        __syncthreads();
    }
    bf16* WinT = (bf16*)(c.ws + WS_WIN); bf16* WoutT = (bf16*)(c.ws + WS_WOUT); bf16* WqkT = (bf16*)(c.ws + WS_WQK);
    constexpr int NIN = 6176, I_IN = (1024 / 64) * (NIN / 32), I_OUT = (2048 / 64) * (1024 / 32);
    const bool split = c.nblk >= NMOD / 64 + 64; const int hb = split ? NMOD / 64 : 0;
    if (c.bid < hb) return;
    const int hgw = (c.bid - hb) * 8 + c.wave, hngw = (c.nblk - hb) * 8, hgtid = (c.bid - hb) * 512 + c.tid, hgsz = (c.nblk - hb) * 512;
    for (int it = hgw; it < I_IN + I_OUT; it += hngw) {
        if (it < I_IN) { const int nb = it % (NIN / 32); if (FP8_GEMM1) transpose_item_fp8(c.in[I_WIN], 1024, NIN, (unsigned char*)WinT, nb >= 97 ? 224 : 0, scr, it, c.lane, WISCALE); else transpose_item(c.in[I_WIN], 1024, NIN, WinT, nb >= 97 ? 224 : 0, scr, it, c.lane); }
        else if (FP8_GEMM2) transpose_item_fp8(c.in[I_WOUT], 2048, 1024, (unsigned char*)WoutT, 0, scr, it - I_IN, c.lane, WOSCALE);
        else transpose_item(c.in[I_WOUT], 2048, 1024, WoutT, 0, scr, it - I_IN, c.lane);
    }
    { u32x4* z = FP8_GEMM1 ? (u32x4*)((unsigned char*)WinT + (size_t)3104 * 1024) : (u32x4*)(WinT + (size_t)3104 * 1024); const u32x4 zz = {0u, 0u, 0u, 0u};
      for (int i = hgtid; i < 224 * 1024 / (FP8_GEMM1 ? 16 : 8); i += hgsz) z[i] = zz; }
    { typedef short bf16x8_l __attribute__((ext_vector_type(8)));
      const float* wq = c.in[I_WQ]; const float* keys = c.in[I_KEYS]; const int fr = c.lane & 15, fq = c.lane >> 4;
      for (int it = hgw; it < 16 * 64; it += hngw) { const int hp = it >> 6, kt = it & 63;
          bf16x8_l af[4];
#pragma unroll
          for (int ks = 0; ks < 4; ++ks) { const f32x4* a = (const f32x4*)(wq + (size_t)(16 * kt + fr) * 2048 + hp * 128 + 32 * ks + 8 * fq); const f32x4 a0 = a[0], a1 = a[1];
              u32x4 w; w.x = pk2(a0.x, a0.y); w.y = pk2(a0.z, a0.w); w.z = pk2(a1.x, a1.y); w.w = pk2(a1.z, a1.w); af[ks] = __builtin_bit_cast(bf16x8_l, w); }
#pragma unroll 2
          for (int nt = 0; nt < 8; ++nt) { f32x4 acc = {0.f, 0.f, 0.f, 0.f};
#pragma unroll
              for (int ks = 0; ks < 4; ++ks) { const f32x4* b = (const f32x4*)(keys + (size_t)(hp * 128 + 16 * nt + fr) * 128 + 32 * ks + 8 * fq); const f32x4 b0 = b[0], b1 = b[1];
                  u32x4 w; w.x = pk2(b0.x, b0.y); w.y = pk2(b0.z, b0.w); w.z = pk2(b1.x, b1.y); w.w = pk2(b1.z, b1.w);
                  acc = __builtin_amdgcn_mfma_f32_16x16x32_bf16(af[ks], __builtin_bit_cast(bf16x8_l, w), acc, 0, 0, 0); }
              if (FP8_GEMM3) *(unsigned*)((unsigned char*)WqkT + (size_t)(hp * 128 + 16 * nt + fr) * 1024 + 16 * kt + 4 * fq) = pk4_fp8(acc[0], acc[1], acc[2], acc[3], WISCALE);
              else { u32x2 o; o.x = pk2(acc[0], acc[1]); o.y = pk2(acc[2], acc[3]);
              *(u32x2*)(WqkT + (size_t)(hp * 128 + 16 * nt + fr) * 1024 + 16 * kt + 4 * fq) = o; } } } }
}

__device__ __forceinline__ void phase1(const Ctx& c) {
    bf16* H = (bf16*)c.out; const float* MOD = (const float*)(c.ws + WS_MOD); const float* g = c.in[I_GPREMIX];
    f32x4 xn[4];
#define P1_ROW(m_) ((m_) < ML ? c.in[I_X] + (size_t)(m_) * DM : c.in[I_CTX] + (size_t)((m_) - ML) * DM)
#define P1_LOAD(m_) { const f32x4* x4_ = (const f32x4*)P1_ROW(m_) + c.lane; _Pragma("unroll") for (int j = 0; j < 4; ++j) xn[j] = x4_[64 * j]; }
    if (c.gw < MT) P1_LOAD(c.gw)
    for (int m = c.gw; m < MT; m += c.ngw) {
        const int v = m < ML ? m / SEQ : 4;
        f32x4 xv[4]; float ss = 0.f;
#pragma unroll
        for (int j = 0; j < 4; ++j) { xv[j] = xn[j]; ss += xv[j].x * xv[j].x + xv[j].y * xv[j].y + xv[j].z * xv[j].z + xv[j].w * xv[j].w; }
        { const int mn = (m + c.ngw < MT) ? m + c.ngw : m; P1_LOAD(mn) }
        const float rinv = rsqrtf(wave_sum(ss) * (1.f / DM) + EPS);
        const float* mv = MOD + v * NMOD;
#pragma unroll
        for (int j = 0; j < 4; ++j) { const int col = 4 * c.lane + 256 * j;
            const f32x4 gg = *(const f32x4*)(g + col), sh = *(const f32x4*)(mv + MOD_SH1 + col), sc = *(const f32x4*)(mv + MOD_SC1 + col);
            const f32x4 y = (xv[j] * rinv * gg) * (1.f + sc) + sh;
            if (FP8_GEMM1) *(unsigned*)((unsigned char*)H + (size_t)m * DM + col) = pk4_fp8(y.x, y.y, y.z, y.w, HSCALE);
            else { u32x2 o; o.x = pk2(y.x, y.y); o.y = pk2(y.z, y.w);
            *(u32x2*)(H + (size_t)m * DM + col) = o; } }
    }
#undef P1_LOAD
#undef P1_ROW
}

template <class Epi>
__device__ __forceinline__ void naive_gemm(const Ctx& c, const bf16* A, const bf16* Bt, int M, int N, int K, const Epi& epi) {
    float* As = (float*)c.lds;
    float* Bs = (float*)(c.lds + 64 * 33 * 4);
    const int tn_count = N / 128, tiles = (M / 64) * tn_count;
    const int row = c.tid >> 3, cb = c.tid & 7;
    for (int tile = c.bid; tile < tiles; tile += c.nblk) {
        const int tm = tile / tn_count, tn = tile % tn_count;
        float acc[16];
#pragma unroll
        for (int j = 0; j < 16; ++j) acc[j] = 0.f;
        for (int k0 = 0; k0 < K; k0 += 32) {
            { const int r = c.tid >> 3, c4 = (c.tid & 7) * 4; const u32x2 v = *(const u32x2*)(A + (size_t)(tm * 64 + r) * K + k0 + c4);
              As[r * 33 + c4 + 0] = __uint_as_float(v.x << 16); As[r * 33 + c4 + 1] = __uint_as_float(v.x & 0xffff0000u);
              As[r * 33 + c4 + 2] = __uint_as_float(v.y << 16); As[r * 33 + c4 + 3] = __uint_as_float(v.y & 0xffff0000u); }
            { const int r = c.tid >> 2, c8 = (c.tid & 3) * 8; const u32x4 v = *(const u32x4*)(Bt + (size_t)(tn * 128 + r) * K + k0 + c8);
              float* d = Bs + r * 33 + c8;
              d[0] = __uint_as_float(v.x << 16); d[1] = __uint_as_float(v.x & 0xffff0000u); d[2] = __uint_as_float(v.y << 16); d[3] = __uint_as_float(v.y & 0xffff0000u);
              d[4] = __uint_as_float(v.z << 16); d[5] = __uint_as_float(v.z & 0xffff0000u); d[6] = __uint_as_float(v.w << 16); d[7] = __uint_as_float(v.w & 0xffff0000u); }
            __syncthreads();
#pragma unroll 8
            for (int kk = 0; kk < 32; ++kk) { const float a = As[row * 33 + kk];
#pragma unroll
                for (int j = 0; j < 16; ++j) acc[j] += a * Bs[(cb + 8 * j) * 33 + kk]; }
            __syncthreads();
        }
#pragma unroll
        for (int j = 0; j < 16; ++j) epi(tm * 64 + row, tn * 128 + cb + 8 * j, acc[j]);
    }
}


struct EpiG1 {
    static constexpr bool PERM = true, AFTER_DRAIN = false;
    static constexpr int SCA = 127 - 4, SCB = 127 - 6;
    bf16* ZG; bf16* XBC; float* DT; bf16* GCV; const float* dtb;
    __device__ __forceinline__ void operator()(const pg8::f32x4 (&acc)[2][2][4][2], const pg8::Unit& u, int wr, int wc, int fr, int fq) const {
        const int row0 = u.pm * 256 + wr * 64 + fr, pn = u.pn;
        if (pn == 12) {
            if (wc == 0) {
#pragma unroll
                for (int n = 0; n < 2; ++n) { const int col = 8 * fq + 4 * n; const f32x4 bv = *(const f32x4*)(dtb + col);
#pragma unroll
                    for (int ai = 0; ai < 2; ++ai)
#pragma unroll
                        for (int m = 0; m < 4; ++m) { const pg8::f32x4 v = acc[ai][0][m][n]; f32x4 o;
                            o.x = softplus_f(v[0] + bv.x); o.y = softplus_f(v[1] + bv.y); o.z = softplus_f(v[2] + bv.z); o.w = softplus_f(v[3] + bv.w);
                            *(f32x4*)(DT + (size_t)(row0 + ai * 128 + m * 16) * 32 + col) = o; } }
            }
            return;
        }
        const bool isx = (pn >= 4) & (pn < 12), isg = pn >= 17;
        const size_t boff = isx ? (WS_RB - WS_RA) : (isg ? (WS_RC - WS_RA) : (size_t)0);
        bf16* base = (bf16*)((unsigned char*)ZG + boff);
        const int colt = pn < 4 ? pn * 256 : (isx ? (pn - 4) * 256 : (isg ? (pn - 17) * 256 : 1024 + (pn - 13) * 256));
        if (!isx && u.pm >= 128) return;
        const int col0 = colt + wc * 32 + 8 * fq;
#pragma unroll
        for (int ai = 0; ai < 2; ++ai)
#pragma unroll
            for (int m = 0; m < 4; ++m) { bf16* rowp = base + (size_t)(row0 + ai * 128 + m * 16) * 2048 + col0;
#pragma unroll
                for (int bj = 0; bj < 2; ++bj) { const pg8::f32x4 v0 = acc[ai][bj][m][0], v1 = acc[ai][bj][m][1];
                    u32x4 w; w.x = pg8::cvt_pk_bf16(v0[0], v0[1]); w.y = pg8::cvt_pk_bf16(v0[2], v0[3]); w.z = pg8::cvt_pk_bf16(v1[0], v1[1]); w.w = pg8::cvt_pk_bf16(v1[2], v1[3]);
                    *(u32x4*)(rowp + bj * 128) = w; } }
    }
};
struct EpiPlainT {
    static constexpr bool PERM = true, AFTER_DRAIN = false;
    static constexpr int SCA = 127 - 4, SCB = 127 - 6;
    bf16* O; int ld;
    __device__ __forceinline__ void operator()(const pg8::f32x4 (&acc)[2][2][4][2], const pg8::Unit& u, int wr, int wc, int fr, int fq) const {
        const int row0 = u.pm * 256 + wr * 64 + fr, col0 = u.pn * 256 + wc * 32 + 8 * fq;
#pragma unroll
        for (int ai = 0; ai < 2; ++ai)
#pragma unroll
            for (int m = 0; m < 4; ++m) { bf16* rowp = O + (size_t)(row0 + ai * 128 + m * 16) * ld + col0;
#pragma unroll
                for (int bj = 0; bj < 2; ++bj) { const pg8::f32x4 v0 = acc[ai][bj][m][0], v1 = acc[ai][bj][m][1];
                    u32x4 w; w.x = pg8::cvt_pk_bf16(v0[0], v0[1]); w.y = pg8::cvt_pk_bf16(v0[2], v0[3]); w.z = pg8::cvt_pk_bf16(v1[0], v1[1]); w.w = pg8::cvt_pk_bf16(v1[2], v1[3]);
                    *(u32x4*)(rowp + bj * 128) = w; } }
    }
};
struct Order1 {
    pg8::StaticOrder so; int G, c;
    __device__ void init(int G_, int c_) { so.init(ML, N1, G_, c_, G1_WGM); G = G_; c = c_; }
    __device__ bool next(int i, pg8::Unit& u) const {
        const int L = i * G + c;
        if (L < 3200) return so.next(i, u);
        const int r = L - 3200; if (r >= 36) return false;
        u.pm = 128 + r / 9; u.pn = 4 + r % 9; return true;
    }
    __device__ __forceinline__ void a_ready(const pg8::Unit&) const {}
    __device__ __forceinline__ void done(const pg8::Unit&) const {}
};
struct Epi1 {
    bf16* ZG; bf16* XBC; float* DT; bf16* GCV; const float* dtb;
    __device__ __forceinline__ void operator()(int m, int n, float v) const {
        if (n < 1024) { if (m < ML) ZG[(size_t)m * 2048 + n] = f2bf(v); }
        else if (n < 3072) XBC[(size_t)m * 2048 + (n - 1024)] = f2bf(v);
        else if (n < 3104) DT[(size_t)m * 32 + (n - 3072)] = softplus_f(v + dtb[n - 3072]);
        else if (n < 3328) {}
        else if (n < 4352) { if (m < ML) ZG[(size_t)m * 2048 + 1024 + (n - 3328)] = f2bf(v); }
        else { if (m < ML) GCV[(size_t)m * 2048 + (n - 4352)] = f2bf(v); }
    }
};
struct EpiPlain { bf16* O; int ld; __device__ __forceinline__ void operator()(int m, int n, float v) const { O[(size_t)m * ld + n] = f2bf(v); } };

__device__ __forceinline__ void phase2(const Ctx& c) {
    EpiG1 e{(bf16*)(c.ws + WS_RA), (bf16*)(c.ws + WS_RB), (float*)(c.ws + WS_DT), (bf16*)(c.ws + WS_RC), c.in[I_DTBIAS]};
    pg8::Gemm g{(const bf16*)c.out, (const bf16*)(c.ws + WS_WIN), MT, N1, FP8_GEMM1 ? 512 : 1024};
    Order1 S; S.init(c.nblk, c.bid);
    pg8::gemm_phase<EpiG1, Order1, G1_ALIGN, true, FP8_GEMM1 != 0>((LAS unsigned char*)c.lds, g, S, e);
}

__device__ __forceinline__ void phase3(const Ctx& c) {
    bf16* XBC = (bf16*)(c.ws + WS_RB); const float* cw = c.in[I_CONVW]; const float* cbias = c.in[I_CONVB];
    for (int idx = c.gtid; idx < (ML / 64) * 2048; idx += c.gsz) {
        const int ch = idx & 2047, r64 = idx >> 11; bf16* base = XBC + (size_t)r64 * 64 * 2048 + ch;
        float u[64];
#pragma unroll
        for (int t = 0; t < 64; ++t) u[t] = bf2f(base[(size_t)t * 2048]);
        const float w0 = cw[ch], w1 = cw[2048 + ch], w2 = cw[4096 + ch], w3 = cw[6144 + ch], w4 = cw[8192 + ch], bb = cbias[ch];
#pragma unroll
        for (int t = 0; t < 64; ++t) {
            float o = bb + w2 * u[t];
            if (t >= 2) o += w0 * u[t - 2];
            if (t >= 1) o += w1 * u[t - 1];
            if (t <= 62) o += w3 * u[t + 1];
            if (t <= 61) o += w4 * u[t + 2];
            base[(size_t)t * 2048] = f2bf(silu_f(o));
        }
    }
    for (int idx = c.gtid; idx < NB * 2048; idx += c.gsz) {
        const int ch = idx & 2047, b = idx >> 11; bf16* base = XBC + (size_t)(ML + b * CTXL) * 2048 + ch;
        const float w0 = cw[ch], w1 = cw[2048 + ch], w2 = cw[4096 + ch], w3 = cw[6144 + ch], w4 = cw[8192 + ch], bb = cbias[ch];
        float um2 = 0.f, um1 = 0.f, u0 = bf2f(base[0]), up1 = bf2f(base[2048]), up2;
        for (int t = 0; t < CTXL; ++t) {
            up2 = (t + 2 < CTXL) ? bf2f(base[(size_t)(t + 2) * 2048]) : 0.f;
            const float o = bb + w0 * um2 + w1 * um1 + w2 * u0 + w3 * up1 + w4 * up2;
            base[(size_t)t * 2048] = f2bf(silu_f(o));
            um2 = um1; um1 = u0; u0 = up1; up1 = up2;
        }
    }
    { bf16* ZG = (bf16*)(c.ws + WS_RA); const bf16* GCV = (const bf16*)(c.ws + WS_RC); const float* sw = c.in[I_SCCONVW]; const float* sg = c.in[I_SCNORMG];
      for (int m = c.gw; m < ML; m += c.ngw) {
          const int pos = m & 63, ch0 = c.lane * 16;
          float acc[16];
#pragma unroll
          for (int j = 0; j < 16; ++j) acc[j] = 0.f;
#pragma unroll
          for (int k = 0; k < 3; ++k) { const int tt = pos + k - 1;
              if (tt >= 0 && tt < 64) { const bf16* gr = GCV + (size_t)(m + k - 1) * 2048 + ch0;
#pragma unroll
                  for (int j = 0; j < 16; ++j) acc[j] += sw[k * 1024 + ch0 + j] * (bf2f(gr[j]) * bf2f(gr[1024 + j])); } }
          bf16* gb = ZG + (size_t)m * 2048 + 1024 + ch0; float ss = 0.f;
#pragma unroll
          for (int j = 0; j < 16; ++j) { acc[j] *= bf2f(gb[j]); ss += acc[j] * acc[j]; }
          const float rinv = rsqrtf(wave_sum(ss) * (1.f / 1024.f) + EPS);
#pragma unroll
          for (int j = 0; j < 16; ++j) gb[j] = f2bf(acc[j] * rinv * sg[ch0 + j]);
      } }
    { f32x4* y = (f32x4*)c.out; const f32x4 z = {0.f, 0.f, 0.f, 0.f}; for (int i = c.gtid; i < ML * DM / 4; i += c.gsz) y[i] = z; }
}

__device__ __forceinline__ void phase4(const Ctx& c) {
    const bf16* XBC = (const bf16*)(c.ws + WS_RB); const float* DT = (const float*)(c.ws + WS_DT); float* Y = c.out;
    for (int idx = c.gtid; idx < 65536; idx += c.gsz) {
        const int nc = idx & 7, p = (idx >> 3) & 63, d = (idx >> 9) & 1, hd = (idx >> 10) & 15, b = idx >> 14, g = hd >> 2;
        const float A = -__expf(c.in[I_ALOG][d * 16 + hd]);
        float h[16];
#pragma unroll
        for (int j = 0; j < 16; ++j) h[j] = 0.f;
        for (int step = 0; step < CTXL + SEQ; ++step) {
            int row; bool lat = step >= CTXL;
            if (!lat) { const int t = d == 0 ? step : CTXL - 1 - step; row = ML + b * CTXL + t; }
            else { const int s2 = step - CTXL; const int t = d == 0 ? s2 : SEQ - 1 - s2; row = b * SEQ + t; }
            const float dt = DT[(size_t)row * 32 + d * 16 + hd]; const float dec = __expf(dt * A);
            const bf16* xr = XBC + (size_t)row * 2048;
            const float xv = bf2f(xr[hd * 64 + p]) * dt;
            const u32x4 b0 = *(const u32x4*)(xr + 1024 + g * 128 + nc * 16), b1 = *(const u32x4*)(xr + 1024 + g * 128 + nc * 16 + 8);
            const unsigned bw[8] = {b0.x, b0.y, b0.z, b0.w, b1.x, b1.y, b1.z, b1.w};
#pragma unroll
            for (int j = 0; j < 8; ++j) { h[2 * j] = h[2 * j] * dec + __uint_as_float(bw[j] << 16) * xv; h[2 * j + 1] = h[2 * j + 1] * dec + __uint_as_float(bw[j] & 0xffff0000u) * xv; }
            if (lat) {
                const u32x4 c0 = *(const u32x4*)(xr + 1536 + g * 128 + nc * 16), c1 = *(const u32x4*)(xr + 1536 + g * 128 + nc * 16 + 8);
                const unsigned cwv[8] = {c0.x, c0.y, c0.z, c0.w, c1.x, c1.y, c1.z, c1.w};
                float y = 0.f;
#pragma unroll
                for (int j = 0; j < 8; ++j) y += __uint_as_float(cwv[j] << 16) * h[2 * j] + __uint_as_float(cwv[j] & 0xffff0000u) * h[2 * j + 1];
                y += __shfl_xor(y, 1); y += __shfl_xor(y, 2); y += __shfl_xor(y, 4);
                if (nc == 0) atomicAdd(&Y[(size_t)row * 1024 + hd * 64 + p], y);
            }
        }
    }
}

__device__ __forceinline__ void phase5(const Ctx& c) {
    const bf16* XBC = (const bf16*)(c.ws + WS_RB); bf16* ZG = (bf16*)(c.ws + WS_RA); const float* Y = c.out;
    const float* dsk = c.in[I_DSKIP]; const float* ng = c.in[I_SSDNORMG];
    for (int it = c.gw; it < ML * 4; it += c.ngw) {
        const int m = it >> 2, g = it & 3, ch = g * 256 + c.lane * 4, hd = ch >> 6;
        const f32x4 yv = *(const f32x4*)(Y + (size_t)m * 1024 + ch);
        const u32x2 xw = *(const u32x2*)(XBC + (size_t)m * 2048 + ch), zw = *(const u32x2*)(ZG + (size_t)m * 2048 + ch);
        const float dk = dsk[hd];
        float y[4] = {yv.x, yv.y, yv.z, yv.w};
        const float xs[4] = {__uint_as_float(xw.x << 16), __uint_as_float(xw.x & 0xffff0000u), __uint_as_float(xw.y << 16), __uint_as_float(xw.y & 0xffff0000u)};
        const float zz[4] = {__uint_as_float(zw.x << 16), __uint_as_float(zw.x & 0xffff0000u), __uint_as_float(zw.y << 16), __uint_as_float(zw.y & 0xffff0000u)};
        float ss = 0.f;
#pragma unroll
        for (int j = 0; j < 4; ++j) { y[j] = (y[j] + dk * xs[j]) * silu_f(zz[j]); ss += y[j] * y[j]; }
        const float rinv = rsqrtf(wave_sum(ss) * (1.f / 256.f) + EPS);
        u32x2 o; o.x = pk2(y[0] * rinv * ng[ch], y[1] * rinv * ng[ch + 1]); o.y = pk2(y[2] * rinv * ng[ch + 2], y[3] * rinv * ng[ch + 3]);
        *(u32x2*)(ZG + (size_t)m * 2048 + ch) = o;
    }
}

typedef short bf16x8_t __attribute__((ext_vector_type(8)));
constexpr int XPITCH = 272;
__device__ __forceinline__ float fast_exp(float x) { return __expf(x); }
__device__ __forceinline__ float wave_scan_incl(float v, float& tot) {
    v += dpp_f<0x111>(v); v += dpp_f<0x112>(v); v += dpp_f<0x114>(v); v += dpp_f<0x118>(v);
    const float r0 = __builtin_bit_cast(float, __builtin_amdgcn_readlane(__builtin_bit_cast(int, v), 15));
    const float r1 = __builtin_bit_cast(float, __builtin_amdgcn_readlane(__builtin_bit_cast(int, v), 31));
    const float r2 = __builtin_bit_cast(float, __builtin_amdgcn_readlane(__builtin_bit_cast(int, v), 47));
    const float r3 = __builtin_bit_cast(float, __builtin_amdgcn_readlane(__builtin_bit_cast(int, v), 63));
    const int row = (int)(threadIdx.x & 63) >> 4;
    const float add = row == 0 ? 0.f : (row == 1 ? r0 : (row == 2 ? r0 + r1 : r0 + r1 + r2));
    tot = r0 + r1 + r2 + r3;
    return v + add;
}
__device__ __forceinline__ void unpack8(const u32x4& w, float* f) {
    f[0] = __uint_as_float(w.x << 16); f[1] = __uint_as_float(w.x & 0xffff0000u); f[2] = __uint_as_float(w.y << 16); f[3] = __uint_as_float(w.y & 0xffff0000u);
    f[4] = __uint_as_float(w.z << 16); f[5] = __uint_as_float(w.z & 0xffff0000u); f[6] = __uint_as_float(w.w << 16); f[7] = __uint_as_float(w.w & 0xffff0000u);
}
template <int J> __device__ __forceinline__ float row_elem(const u32x4& w) {
    const unsigned v = (J >> 1) == 0 ? w.x : ((J >> 1) == 1 ? w.y : ((J >> 1) == 2 ? w.z : w.w));
    return (J & 1) ? __uint_as_float(v & 0xffff0000u) : __uint_as_float(v << 16);
}
template <int J> __device__ __forceinline__ u32x4 conv_chan(const u32x4* rows, const float* cw, const float* cb, int chcol) {
    const float w0 = cw[chcol + J], w1 = cw[2048 + chcol + J], w2 = cw[4096 + chcol + J], w3 = cw[6144 + chcol + J], w4 = cw[8192 + chcol + J], bb = cb[chcol + J];
    float x[12];
#pragma unroll
    for (int i = 0; i < 12; ++i) x[i] = row_elem<J>(rows[i]);
    float o[8];
#pragma unroll
    for (int t = 0; t < 8; ++t) o[t] = silu_f(bb + w0 * x[t] + w1 * x[t + 1] + w2 * x[t + 2] + w3 * x[t + 3] + w4 * x[t + 4]);
    u32x4 q; q.x = pk2(o[0], o[1]); q.y = pk2(o[2], o[3]); q.z = pk2(o[4], o[5]); q.w = pk2(o[6], o[7]); return q;
}
__device__ __forceinline__ void conv_unit(const u32x4* rows, const float* cw, const float* cb, int chcol, u32x4* out) {
    out[0] = conv_chan<0>(rows, cw, cb, chcol); out[1] = conv_chan<1>(rows, cw, cb, chcol); out[2] = conv_chan<2>(rows, cw, cb, chcol); out[3] = conv_chan<3>(rows, cw, cb, chcol);
    out[4] = conv_chan<4>(rows, cw, cb, chcol); out[5] = conv_chan<5>(rows, cw, cb, chcol); out[6] = conv_chan<6>(rows, cw, cb, chcol); out[7] = conv_chan<7>(rows, cw, cb, chcol);
}


__device__ __forceinline__ void un4_fp8(unsigned w, float* f) {
    typedef float f32x2_u __attribute__((ext_vector_type(2)));
    const f32x2_u lo = __builtin_amdgcn_cvt_pk_f32_fp8((int)w, false), hi = __builtin_amdgcn_cvt_pk_f32_fp8((int)w, true);
    f[0] = lo.x; f[1] = lo.y; f[2] = hi.x; f[3] = hi.y;
}
__device__ __forceinline__ void s1_item(const Ctx& c, int b, int cc, int g) {
    LAS unsigned char* L = (LAS unsigned char*)c.lds;
    LAS unsigned char* XT = L;
    LAS unsigned char* BT = L + 256 * XPITCH;
    LAS float* WT = (LAS float*)(L + 384 * XPITCH);
    const bf16* XBC = (const bf16*)(c.ws + WS_RB); const float* DT = (const float*)(c.ws + WS_DT);
    const bool isctx = cc < 2;
    const int seq0 = isctx ? ML + b * CTXL : b * SEQ;
    const int t0c = isctx ? cc * 128 : (cc - 2) * 128;
    const int tid = c.tid, lane = c.lane, w = c.wave;
    { const int d = w >> 2, r = w & 3, hd = g * 4 + r;
      const float A = -__expf(c.in[I_ALOG][d * 16 + hd]);
      const float dt0 = DT[(size_t)(seq0 + t0c + lane) * 32 + d * 16 + hd], dt1 = DT[(size_t)(seq0 + t0c + 64 + lane) * 32 + d * 16 + hd];
      const float a0 = dt0 * A, a1 = dt1 * A; float tot0, tot1;
      const float P0 = wave_scan_incl(a0, tot0); const float P1 = wave_scan_incl(a1, tot1) + tot0; const float Ptot = tot0 + tot1;
      float w0, w1;
      if (d == 0) { w0 = dt0 * fast_exp(Ptot - P0); w1 = dt1 * fast_exp(Ptot - P1); }
      else { w0 = dt0 * fast_exp(P0 - a0); w1 = dt1 * fast_exp(P1 - a1); }
      WT[w * 128 + lane] = w0; WT[w * 128 + 64 + lane] = w1;
      if (lane == 0) ((float*)(c.ws + WS_DEC))[((b * 66 + cc) * 16 + hd) * 2 + d] = fast_exp(Ptot); }
    { const int sg = tid & 15, q = tid >> 4;
      const int tok0 = sg * 8;
      int lo, hi;
      if (isctx) { lo = -t0c; hi = CTXL - t0c; } else { lo = tok0 & ~63; hi = lo + 64; }
#pragma unroll 1
      for (int pass = 0; pass < 2; ++pass) {
          if (pass == 1 && q >= 16) break;
          const int chcol = pass == 0 ? g * 256 + 8 * q : 1024 + g * 128 + 8 * q;
          u32x4 rows[12];
#pragma unroll
          for (int i = 0; i < 12; ++i) { const int t = tok0 - 2 + i; const u32x4 z = {0u, 0u, 0u, 0u};
              rows[i] = (t >= lo && t < hi) ? *(const u32x4*)(XBC + (size_t)(seq0 + t0c + t) * 2048 + chcol) : z; }
          u32x4 outp[8];
          conv_unit(rows, c.in[I_CONVW], c.in[I_CONVB], chcol, outp);
          LAS unsigned char* dst = (pass == 0 ? XT + (8 * q) * XPITCH : BT + (8 * q) * XPITCH) + sg * 16;
#pragma unroll
          for (int j = 0; j < 8; ++j) *(LAS u32x4*)(dst + j * XPITCH) = outp[j];
          if (pass == 0 && !isctx) { bf16* xg = (bf16*)(c.ws + WS_RE) + ((size_t)((b * 64 + (cc - 2)) * 4 + g) * 256 + 8 * q) * 128 + tok0;
#pragma unroll
              for (int j = 0; j < 8; ++j) *(u32x4*)(xg + j * 128) = outp[j]; }
      } }
    __syncthreads();
    { const int fr = lane & 15, fq = lane >> 4;
      unsigned char* stbase = isctx ? c.ws + WS_HC + (size_t)((b * 2 + cc) * 16) * 2 * 8192 : (unsigned char*)c.out + (size_t)((b * 64 + (cc - 2)) * 16) * 2 * 8192;
#pragma unroll 1
      for (int dr = 0; dr < 8; ++dr) { const int d = dr >> 2, r = dr & 3, hd = g * 4 + r;
          f32x4 acc[4];
#pragma unroll
          for (int pt = 0; pt < 4; ++pt) acc[pt] = (f32x4){0.f, 0.f, 0.f, 0.f};
#pragma unroll
          for (int ks = 0; ks < 4; ++ks) {
              const u32x4 araw = *(const LAS u32x4*)(BT + (16 * w + fr) * XPITCH + (32 * ks + 8 * fq) * 2);
              const f32x4 wl = *(const LAS f32x4*)(WT + dr * 128 + 32 * ks + 8 * fq), wh = *(const LAS f32x4*)(WT + dr * 128 + 32 * ks + 8 * fq + 4);
              float af[8]; unpack8(araw, af);
              u32x4 as; as.x = pk2(af[0] * wl.x, af[1] * wl.y); as.y = pk2(af[2] * wl.z, af[3] * wl.w); as.z = pk2(af[4] * wh.x, af[5] * wh.y); as.w = pk2(af[6] * wh.z, af[7] * wh.w);
              const bf16x8_t afrag = __builtin_bit_cast(bf16x8_t, as);
#pragma unroll
              for (int pt = 0; pt < 4; ++pt) { const bf16x8_t bfrag = *(const LAS bf16x8_t*)(XT + (r * 64 + 16 * pt + fr) * XPITCH + (32 * ks + 8 * fq) * 2);
                  acc[pt] = __builtin_amdgcn_mfma_f32_16x16x32_bf16(afrag, bfrag, acc[pt], 0, 0, 0); }
          }
          unsigned char* dst = stbase + (size_t)(hd * 2 + d) * 8192;
#pragma unroll
          for (int pt = 0; pt < 4; ++pt) *(unsigned*)(dst + (16 * pt + fr) * 128 + 16 * w + 4 * fq) = pk4_fp8(acc[pt][0], acc[pt][1], acc[pt][2], acc[pt][3], STSCALE);
      } }
    __syncthreads();
}

__device__ __forceinline__ void shortconv_row(const Ctx& c, int row64) {
    bf16* ZG = (bf16*)(c.ws + WS_RA); const bf16* GCV = (const bf16*)(c.ws + WS_RC); const float* sw = c.in[I_SCCONVW]; const float* sg = c.in[I_SCNORMG];
    const int p0 = c.wave * 8, ch0 = c.lane * 16; const size_t mbase = (size_t)row64 * 64;
    float w0[16], w1[16], w2[16], gn[16];
#pragma unroll
    for (int j = 0; j < 16; j += 4) { const f32x4 a = *(const f32x4*)(sw + ch0 + j), b = *(const f32x4*)(sw + 1024 + ch0 + j), d = *(const f32x4*)(sw + 2048 + ch0 + j), e = *(const f32x4*)(sg + ch0 + j);
        w0[j] = a.x; w0[j + 1] = a.y; w0[j + 2] = a.z; w0[j + 3] = a.w; w1[j] = b.x; w1[j + 1] = b.y; w1[j + 2] = b.z; w1[j + 3] = b.w;
        w2[j] = d.x; w2[j + 1] = d.y; w2[j + 2] = d.z; w2[j + 3] = d.w; gn[j] = e.x; gn[j + 1] = e.y; gn[j + 2] = e.z; gn[j + 3] = e.w; }
#define SC_LOAD(dst, tt_) { const int t_ = (tt_) < 0 ? 0 : ((tt_) > 63 ? 63 : (tt_)); const bf16* gr = GCV + (mbase + t_) * 2048 + ch0; \
        dst[0] = *(const u32x4*)gr; dst[1] = *(const u32x4*)(gr + 8); dst[2] = *(const u32x4*)(gr + 1024); dst[3] = *(const u32x4*)(gr + 1032); }
#define SC_PROD(dst, raw, tt_) { float gf[16], vf[16]; unpack8(raw[0], gf); unpack8(raw[1], gf + 8); unpack8(raw[2], vf); unpack8(raw[3], vf + 8); \
        const float ok_ = ((tt_) >= 0 && (tt_) < 64) ? 1.f : 0.f; _Pragma("unroll") for (int j = 0; j < 16; ++j) dst[j] = gf[j] * vf[j] * ok_; }
    u32x4 ra[4], rb[4], gbr[2], gbn[2];
    float pm[16], pc[16], pn[16];
    SC_LOAD(ra, p0 - 1) SC_LOAD(rb, p0)
    SC_PROD(pm, ra, p0 - 1) SC_PROD(pc, rb, p0)
    SC_LOAD(ra, p0 + 1)
    { const bf16* gb = ZG + (mbase + p0) * 2048 + 1024 + ch0; gbr[0] = *(const u32x4*)gb; gbr[1] = *(const u32x4*)(gb + 8); }
#pragma unroll 1
    for (int i = 0; i < 8; ++i) { const int pos = p0 + i;
        SC_PROD(pn, ra, pos + 1)
        SC_LOAD(ra, pos + 2)
        { const int pq = (i < 7) ? pos + 1 : pos; const bf16* gb = ZG + (mbase + pq) * 2048 + 1024 + ch0; gbn[0] = *(const u32x4*)gb; gbn[1] = *(const u32x4*)(gb + 8); }
        float acc[16], bf[16]; unpack8(gbr[0], bf); unpack8(gbr[1], bf + 8); float ss = 0.f;
#pragma unroll
        for (int j = 0; j < 16; ++j) { acc[j] = (w0[j] * pm[j] + w1[j] * pc[j] + w2[j] * pn[j]) * bf[j]; ss += acc[j] * acc[j]; }
        const float rinv = rsqrtf(wave_sum(ss) * (1.f / 1024.f) + EPS);
        u32x4 o0, o1;
        o0.x = pk2(acc[0] * rinv * gn[0], acc[1] * rinv * gn[1]); o0.y = pk2(acc[2] * rinv * gn[2], acc[3] * rinv * gn[3]);
        o0.z = pk2(acc[4] * rinv * gn[4], acc[5] * rinv * gn[5]); o0.w = pk2(acc[6] * rinv * gn[6], acc[7] * rinv * gn[7]);
        o1.x = pk2(acc[8] * rinv * gn[8], acc[9] * rinv * gn[9]); o1.y = pk2(acc[10] * rinv * gn[10], acc[11] * rinv * gn[11]);
        o1.z = pk2(acc[12] * rinv * gn[12], acc[13] * rinv * gn[13]); o1.w = pk2(acc[14] * rinv * gn[14], acc[15] * rinv * gn[15]);
        if (FP8_GEMM2) { float y[16];
#pragma unroll
            for (int j = 0; j < 16; ++j) y[j] = acc[j] * rinv * gn[j] * YSCALE;
            u32x4 o;
            o.x = pk4_fp8(y[0], y[1], y[2], y[3], 1.f); o.y = pk4_fp8(y[4], y[5], y[6], y[7], 1.f); o.z = pk4_fp8(y[8], y[9], y[10], y[11], 1.f); o.w = pk4_fp8(y[12], y[13], y[14], y[15], 1.f);
            *(u32x4*)((unsigned char*)c.out + 64 * MiB + (mbase + pos) * 2048 + 1024 + ch0) = o;
        } else {
        bf16* gb = ZG + (mbase + pos) * 2048 + 1024 + ch0;
        *(u32x4*)gb = o0; *(u32x4*)(gb + 8) = o1; }
#pragma unroll
        for (int j = 0; j < 16; ++j) { pm[j] = pc[j]; pc[j] = pn[j]; }
        gbr[0] = gbn[0]; gbr[1] = gbn[1];
    }
#undef SC_LOAD
#undef SC_PROD
}

__device__ __forceinline__ void phase3f(const Ctx& c) {
    constexpr int NS1 = NB * 66 * 4;
    const int nx = NS1 % c.nblk, slot = (c.bid >> 3) & 3;
    int k = 0;
    for (int it = c.bid; it < NS1; it += c.nblk, ++k) { const int g = it & 3, t = it >> 2, cc = t % 66, b = t / 66; s1_item(c, b, cc, g); if (PROBE_DBL == 30) s1_item(c, b, cc, g);
        if (k == slot && c.bid >= nx) for (int j = c.bid - nx; j < ML / 64; j += c.nblk - nx) { shortconv_row(c, j); if (PROBE_DBL == 31) shortconv_row(c, j); } }
}

__device__ __forceinline__ void phase4f_(const Ctx& c, size_t woff) {
    unsigned char* ST = (unsigned char*)c.out; const unsigned char* STC = c.ws + WS_HC; const float* DEC = (const float*)(c.ws + WS_DEC);
    for (int idx = c.gtid; idx < NB * 16 * 2 * 64 * 16; idx += c.gsz) {
        const int n8 = idx & 15, p = (idx >> 4) & 63, d = (idx >> 10) & 1, hd = (idx >> 11) & 15, b = idx >> 15;
        const size_t inner = (size_t)((hd * 2 + d) * 64 + p) * 128 + n8 * 8;
        float h[8];
#pragma unroll
        for (int j = 0; j < 8; ++j) h[j] = 0.f;
#pragma unroll
        for (int s = 0; s < 2; ++s) { const int cc = d == 0 ? s : 1 - s;
            const float dec = DEC[((b * 66 + cc) * 16 + hd) * 2 + d];
            const u32x2 sv = *(const u32x2*)(STC + (size_t)(b * 2 + cc) * 16 * 2 * 8192 + inner); float sf[8]; un4_fp8(sv.x, sf); un4_fp8(sv.y, sf + 4);
#pragma unroll
            for (int j = 0; j < 8; ++j) h[j] = h[j] * dec + sf[j]; }
#pragma unroll 4
        for (int s = 0; s < 64; ++s) { const int cl = d == 0 ? s : 63 - s;
            const float dec = DEC[((b * 66 + 2 + cl) * 16 + hd) * 2 + d];
            unsigned char* ptr = ST + (size_t)(b * 64 + cl) * 16 * 2 * 8192 + inner;
            const u32x2 sv = *(const u32x2*)ptr; float sf[8]; un4_fp8(sv.x, sf); un4_fp8(sv.y, sf + 4);
            u32x2 o; o.x = pk4_fp8(h[0], h[1], h[2], h[3], 1.f); o.y = pk4_fp8(h[4], h[5], h[6], h[7], 1.f);
            *(u32x2*)(ptr + woff) = o;
#pragma unroll
            for (int j = 0; j < 8; ++j) h[j] = h[j] * dec + sf[j]; }
    }
}

__device__ __forceinline__ void phase4f(const Ctx& c) {
    if (PROBE_DBL == 4) phase4f_(c, (size_t)((c.ws + WS_RC) - (unsigned char*)c.out));
    phase4f_(c, 0);
}

__device__ __forceinline__ void s3_item(const Ctx& c, int b, int cl, int g, size_t zoff = 0) {
    LAS unsigned char* L = (LAS unsigned char*)c.lds;
    LAS unsigned char* CM = L;
    LAS unsigned char* BM = L + 128 * XPITCH;
    LAS unsigned char* XT = L + 256 * XPITCH;
    LAS float* TB = (LAS float*)(L + 256 * XPITCH + 65536);
    const bf16* XBC = (const bf16*)(c.ws + WS_RB); const float* DT = (const float*)(c.ws + WS_DT);
    const int tid = c.tid, lane = c.lane, w = c.wave, fr = lane & 15, fq = lane >> 4;
    const int m0 = b * SEQ + cl * 128;
    { const int d = w >> 2, r = w & 3, hd = g * 4 + r;
      const float A = -__expf(c.in[I_ALOG][d * 16 + hd]);
      const float dt0 = DT[(size_t)(m0 + lane) * 32 + d * 16 + hd], dt1 = DT[(size_t)(m0 + 64 + lane) * 32 + d * 16 + hd];
      const float a0 = dt0 * A * 1.44269504f, a1 = dt1 * A * 1.44269504f; float tot0, tot1;
      const float P0 = wave_scan_incl(a0, tot0); const float P1 = wave_scan_incl(a1, tot1) + tot0;
      LAS float* t = TB + r * 512 + d * 256;
      if (d == 0) { t[lane] = P0; t[64 + lane] = P1; } else { t[lane] = P0 - a0; t[64 + lane] = P1 - a1; }
      t[128 + lane] = dt0; t[128 + 64 + lane] = dt1;
      if (d == 1 && lane == 0) TB[2048 + r] = tot0 + tot1;
    }
    { const int sg = tid & 15, q = tid >> 4, tok0 = sg * 8;
      const int lo = tok0 & ~63, hi = lo + 64;
      const int chcol = q < 16 ? 1024 + g * 128 + 8 * q : 1536 + g * 128 + 8 * (q - 16);
      u32x4 rows[12];
#pragma unroll
      for (int i = 0; i < 12; ++i) { const int t = tok0 - 2 + i; const u32x4 z = {0u, 0u, 0u, 0u};
          rows[i] = (t >= lo && t < hi) ? *(const u32x4*)(XBC + (size_t)(m0 + t) * 2048 + chcol) : z; }
      u32x4 outp[8];
      conv_unit(rows, c.in[I_CONVW], c.in[I_CONVB], chcol, outp);
      LAS unsigned char* dst = (q < 16 ? BM + (8 * q) * 2 : CM + (8 * (q - 16)) * 2) + tok0 * XPITCH;
      const unsigned e[8][4] = {{outp[0].x, outp[0].y, outp[0].z, outp[0].w}, {outp[1].x, outp[1].y, outp[1].z, outp[1].w}, {outp[2].x, outp[2].y, outp[2].z, outp[2].w}, {outp[3].x, outp[3].y, outp[3].z, outp[3].w},
                                {outp[4].x, outp[4].y, outp[4].z, outp[4].w}, {outp[5].x, outp[5].y, outp[5].z, outp[5].w}, {outp[6].x, outp[6].y, outp[6].z, outp[6].w}, {outp[7].x, outp[7].y, outp[7].z, outp[7].w}};
#pragma unroll
      for (int tp = 0; tp < 4; ++tp) {
          u32x4 lo4, hi4;
          lo4.x = (e[0][tp] & 0xffffu) | (e[1][tp] << 16); lo4.y = (e[2][tp] & 0xffffu) | (e[3][tp] << 16); lo4.z = (e[4][tp] & 0xffffu) | (e[5][tp] << 16); lo4.w = (e[6][tp] & 0xffffu) | (e[7][tp] << 16);
          hi4.x = (e[0][tp] >> 16) | (e[1][tp] & 0xffff0000u); hi4.y = (e[2][tp] >> 16) | (e[3][tp] & 0xffff0000u); hi4.z = (e[4][tp] >> 16) | (e[5][tp] & 0xffff0000u); hi4.w = (e[6][tp] >> 16) | (e[7][tp] & 0xffff0000u);
          *(LAS u32x4*)(dst + (2 * tp) * XPITCH) = lo4; *(LAS u32x4*)(dst + (2 * tp + 1) * XPITCH) = hi4; }
    }
    LAS unsigned char* HF = XT + 16384; LAS unsigned char* HB = XT + 32768; LAS unsigned char* ZY = XT + 49152;
    const bf16* xg = (const bf16*)(c.ws + WS_RE) + (size_t)((b * 64 + cl) * 4 + g) * 256 * 128;
    const unsigned char* STg = (const unsigned char*)c.out + (size_t)((b * 64 + cl) * 16) * 2 * 8192;
    bf16* ZG = (bf16*)(c.ws + WS_RA);
    u32x4 pre[6];
#define S3_ISSUE(r_) { const int hd_ = g * 4 + (r_); \
        pre[2] = *(const u32x4*)(STg + (size_t)(hd_ * 2 + 0) * 8192 + tid * 16); \
        pre[3] = *(const u32x4*)(STg + (size_t)(hd_ * 2 + 1) * 8192 + tid * 16); \
        _Pragma("unroll") for (int i_ = 0; i_ < 2; ++i_) { const int piece = tid + 512 * i_; \
            pre[i_]     = *(const u32x4*)(xg + (size_t)((r_) * 64) * 128 + piece * 8); \
            pre[4 + i_] = *(const u32x4*)(ZG + (size_t)(m0 + (piece >> 3)) * 2048 + g * 256 + (r_) * 64 + (piece & 7) * 8); } }
#define S3_H2L(dstT, v) { const int row = tid >> 3, c8 = tid & 7; const unsigned w_[4] = {(v).x, (v).y, (v).z, (v).w}; float f_[16]; \
        un4_fp8(w_[0], f_); un4_fp8(w_[1], f_ + 4); un4_fp8(w_[2], f_ + 8); un4_fp8(w_[3], f_ + 12); \
        u32x4 lo_, hi_; lo_.x = pk2(f_[0], f_[1]); lo_.y = pk2(f_[2], f_[3]); lo_.z = pk2(f_[4], f_[5]); lo_.w = pk2(f_[6], f_[7]); \
        hi_.x = pk2(f_[8], f_[9]); hi_.y = pk2(f_[10], f_[11]); hi_.z = pk2(f_[12], f_[13]); hi_.w = pk2(f_[14], f_[15]); \
        *(LAS u32x4*)((dstT) + row * 256 + (((2 * c8) ^ (row & 15)) * 16)) = lo_; *(LAS u32x4*)((dstT) + row * 256 + (((2 * c8 + 1) ^ (row & 15)) * 16)) = hi_; }
#define S3_COMMIT() { S3_H2L(HF, pre[2]) S3_H2L(HB, pre[3]) \
        _Pragma("unroll") for (int i_ = 0; i_ < 2; ++i_) { const int piece = tid + 512 * i_, row = piece >> 4, cq = piece & 15, o_ = row * 256 + ((cq ^ (row & 15)) * 16); \
            *(LAS u32x4*)(XT + o_) = pre[i_]; \
            const int zl = piece >> 3, zc = piece & 7; *(LAS u32x4*)(ZY + zl * 128 + ((zc ^ (zl & 7)) * 16)) = pre[4 + i_]; } }
    S3_ISSUE(0)
    __syncthreads();
    f32x4 cb[8];
#pragma unroll
    for (int st = 0; st < 8; ++st) cb[st] = (f32x4){0.f, 0.f, 0.f, 0.f};
#pragma unroll
    for (int ks = 0; ks < 4; ++ks) { const bf16x8_t bfrag = *(const LAS bf16x8_t*)(CM + (16 * w + fr) * XPITCH + (32 * ks + 8 * fq) * 2);
#pragma unroll
        for (int st = 0; st < 8; ++st) { const bf16x8_t afrag = *(const LAS bf16x8_t*)(BM + (16 * st + fr) * XPITCH + (32 * ks + 8 * fq) * 2);
            cb[st] = __builtin_amdgcn_mfma_f32_16x16x32_bf16(afrag, bfrag, cb[st], 0, 0, 0); } }
    unsigned cbp[8][2];
#pragma unroll
    for (int st = 0; st < 8; ++st) { cbp[st][0] = pk2(cb[st][0], cb[st][1]); cbp[st][1] = pk2(cb[st][2], cb[st][3]); }
    LAS unsigned char* MT_ = BM + (16 * w) * XPITCH;
    const int l = 16 * w + fr;
    float ssq = 0.f;
    unsigned ypk[4][8];
#pragma unroll 1
    for (int r = 0; r < 4; ++r) { const int hd = g * 4 + r;
        unsigned yp[8];
        S3_COMMIT()
        __syncthreads();
        const LAS float* Pf = TB + r * 512, *dtf = TB + r * 512 + 128, *Pbx = TB + r * 512 + 256, *dtb = TB + r * 512 + 384;
        const float Pf_l = Pf[l], Pbx_l = Pbx[l], dsk = c.in[I_DSKIP][hd];
#pragma unroll 1
        for (int rep_ = 0; rep_ < (PROBE_DBL == 51 ? 2 : 1); ++rep_)
#pragma unroll
        for (int st = 0; st < 8; ++st) { const int s0 = 16 * st + 4 * fq;
            float mv[4];
            if (st < w) { const f32x4 pfs = *(const LAS f32x4*)(Pf + s0), dfs = *(const LAS f32x4*)(dtf + s0);
#pragma unroll
                for (int e = 0; e < 4; ++e) { const float cbv = (e & 1) ? __uint_as_float(cbp[st][e >> 1] & 0xffff0000u) : __uint_as_float(cbp[st][e >> 1] << 16);
                    mv[e] = cbv * (__builtin_amdgcn_exp2f(Pf_l - pfs[e]) * dfs[e]); }
            } else if (st > w) { const f32x4 pbs = *(const LAS f32x4*)(Pbx + s0), dbs = *(const LAS f32x4*)(dtb + s0);
#pragma unroll
                for (int e = 0; e < 4; ++e) { const float cbv = (e & 1) ? __uint_as_float(cbp[st][e >> 1] & 0xffff0000u) : __uint_as_float(cbp[st][e >> 1] << 16);
                    mv[e] = cbv * (__builtin_amdgcn_exp2f(pbs[e] - Pbx_l) * dbs[e]); }
            } else { const f32x4 pfs = *(const LAS f32x4*)(Pf + s0), dfs = *(const LAS f32x4*)(dtf + s0), pbs = *(const LAS f32x4*)(Pbx + s0), dbs = *(const LAS f32x4*)(dtb + s0);
#pragma unroll
                for (int e = 0; e < 4; ++e) { const int s = s0 + e;
                    const float cf = __builtin_amdgcn_exp2f(fminf(Pf_l - pfs[e], 0.f)) * dfs[e];
                    const float cbw = __builtin_amdgcn_exp2f(fminf(pbs[e] - Pbx_l, 0.f)) * dbs[e];
                    float co = s < l ? cf : (s > l ? cbw : cf + cbw);
                    const float cbv = (e & 1) ? __uint_as_float(cbp[st][e >> 1] & 0xffff0000u) : __uint_as_float(cbp[st][e >> 1] << 16);
                    mv[e] = cbv * co + (s == l ? dsk : 0.f); } }
            u32x2 o; o.x = pk2(mv[0], mv[1]); o.y = pk2(mv[2], mv[3]);
            *(LAS u32x2*)(MT_ + fr * XPITCH + s0 * 2) = o; }
        asm volatile("s_waitcnt lgkmcnt(0)" ::: "memory");
        if (r < 3) S3_ISSUE(r + 1)
        f32x4 yd[4], yo[4];
#pragma unroll
        for (int pt = 0; pt < 4; ++pt) { yd[pt] = (f32x4){0.f, 0.f, 0.f, 0.f}; yo[pt] = yd[pt]; }
#pragma unroll
        for (int ks = 0; ks < 4; ++ks) {
            const bf16x8_t mfrag = *(const LAS bf16x8_t*)(MT_ + fr * XPITCH + (32 * ks + 8 * fq) * 2);
#pragma unroll
            for (int pt = 0; pt < 4; ++pt) {
                const bf16x8_t xfrag = *(const LAS bf16x8_t*)(XT + (16 * pt + fr) * 256 + (((4 * ks + fq) ^ fr) * 16));
                yd[pt] = __builtin_amdgcn_mfma_f32_16x16x32_bf16(xfrag, mfrag, yd[pt], 0, 0, 0); }
            asm volatile("" ::: "memory"); }
        const float ef = __builtin_amdgcn_exp2f(Pf_l) * (1.f / STSCALE), eb = __builtin_amdgcn_exp2f(TB[2048 + r] - Pbx_l) * (1.f / STSCALE);
#pragma unroll
        for (int ks = 0; ks < 4; ++ks) {
            const bf16x8_t cfrag = *(const LAS bf16x8_t*)(CM + (16 * w + fr) * XPITCH + (32 * ks + 8 * fq) * 2);
#pragma unroll
            for (int pt = 0; pt < 4; ++pt) { const bf16x8_t hff = *(const LAS bf16x8_t*)(HF + (16 * pt + fr) * 256 + (((4 * ks + fq) ^ fr) * 16));
                yo[pt] = __builtin_amdgcn_mfma_f32_16x16x32_bf16(hff, cfrag, yo[pt], 0, 0, 0); }
            asm volatile("" ::: "memory"); }
#pragma unroll
        for (int pt = 0; pt < 4; ++pt) { yd[pt] = yd[pt] + yo[pt] * ef; yo[pt] = (f32x4){0.f, 0.f, 0.f, 0.f}; }
#pragma unroll
        for (int ks = 0; ks < 4; ++ks) {
            const bf16x8_t cfrag = *(const LAS bf16x8_t*)(CM + (16 * w + fr) * XPITCH + (32 * ks + 8 * fq) * 2);
#pragma unroll
            for (int pt = 0; pt < 4; ++pt) { const bf16x8_t hbf = *(const LAS bf16x8_t*)(HB + (16 * pt + fr) * 256 + (((4 * ks + fq) ^ fr) * 16));
                yo[pt] = __builtin_amdgcn_mfma_f32_16x16x32_bf16(hbf, cfrag, yo[pt], 0, 0, 0); }
            asm volatile("" ::: "memory"); }
#pragma unroll
        for (int pt = 0; pt < 4; ++pt) {
            const u32x2 zw = *(const LAS u32x2*)(ZY + l * 128 + (((2 * pt + (fq >> 1)) ^ (l & 7)) * 16) + (fq & 1) * 8);
            const float zz[4] = {__uint_as_float(zw.x << 16), __uint_as_float(zw.x & 0xffff0000u), __uint_as_float(zw.y << 16), __uint_as_float(zw.y & 0xffff0000u)};
            float y[4];
#pragma unroll
            for (int e = 0; e < 4; ++e) { y[e] = (yd[pt][e] + eb * yo[pt][e]) * silu_f(zz[e]); ssq += y[e] * y[e]; }
            yp[2 * pt] = pk2(y[0], y[1]); yp[2 * pt + 1] = pk2(y[2], y[3]); }
        if (r == 0) { _Pragma("unroll") for (int k = 0; k < 8; ++k) ypk[0][k] = yp[k]; } else if (r == 1) { _Pragma("unroll") for (int k = 0; k < 8; ++k) ypk[1][k] = yp[k]; }
        else if (r == 2) { _Pragma("unroll") for (int k = 0; k < 8; ++k) ypk[2][k] = yp[k]; } else { _Pragma("unroll") for (int k = 0; k < 8; ++k) ypk[3][k] = yp[k]; }
        __syncthreads();
    }
#undef S3_ISSUE
#undef S3_COMMIT
#undef S3_H2L
    { const unsigned u = __builtin_bit_cast(unsigned, ssq); auto r1 = __builtin_amdgcn_permlane16_swap(u, u, false, false); ssq = __builtin_bit_cast(float, (unsigned)r1[0]) + __builtin_bit_cast(float, (unsigned)r1[1]); }
    { const unsigned u = __builtin_bit_cast(unsigned, ssq); auto r2 = __builtin_amdgcn_permlane32_swap(u, u, false, false); ssq = __builtin_bit_cast(float, (unsigned)r2[0]) + __builtin_bit_cast(float, (unsigned)r2[1]); }
    const float rinv = rsqrtf(ssq * (1.f / 256.f) + EPS);
    const float* ng = c.in[I_SSDNORMG];
#pragma unroll
    for (int r = 0; r < 4; ++r)
#pragma unroll
        for (int pt = 0; pt < 4; ++pt) { const int ch = g * 256 + r * 64 + 16 * pt + 4 * fq; const f32x4 gg = *(const f32x4*)(ng + ch);
            const unsigned a0 = ypk[r][2 * pt], a1 = ypk[r][2 * pt + 1];
            if (FP8_GEMM2) { const float rs = rinv * YSCALE;
                const unsigned o8 = (unsigned)__builtin_amdgcn_cvt_pk_fp8_f32(__uint_as_float(a1 << 16) * rs * gg.z, __uint_as_float(a1 & 0xffff0000u) * rs * gg.w,
                    __builtin_amdgcn_cvt_pk_fp8_f32(__uint_as_float(a0 << 16) * rs * gg.x, __uint_as_float(a0 & 0xffff0000u) * rs * gg.y, 0, false), true);
                *(LAS unsigned*)(XT + r * 8192 + l * 64 + 16 * pt + 4 * fq) = o8;
            } else {
            u32x2 o; o.x = pk2(__uint_as_float(a0 << 16) * rinv * gg.x, __uint_as_float(a0 & 0xffff0000u) * rinv * gg.y);
            o.y = pk2(__uint_as_float(a1 << 16) * rinv * gg.z, __uint_as_float(a1 & 0xffff0000u) * rinv * gg.w);
            *(LAS u32x2*)(XT + r * 16384 + l * 128 + (((2 * pt + (fq >> 1)) ^ (l & 7)) * 16) + (fq & 1) * 8) = o; }
            asm volatile("" ::: "memory"); }
    __syncthreads();
    if (FP8_GEMM2) { unsigned char* AQ = (unsigned char*)c.out + 64 * MiB + zoff;
#pragma unroll
        for (int i = 0; i < 4; ++i) { const int piece = tid + 512 * i, zl = piece >> 4, r = (piece >> 2) & 3, zc = piece & 3;
            const u32x4 v = *(const LAS u32x4*)(XT + r * 8192 + zl * 64 + zc * 16);
            *(u32x4*)(AQ + (size_t)(m0 + zl) * 2048 + g * 256 + r * 64 + zc * 16) = v; }
    } else {
#pragma unroll
    for (int i = 0; i < 8; ++i) { const int piece = tid + 512 * i, r = piece >> 10, zl = (piece >> 3) & 127, zc = piece & 7;
        const u32x4 v = *(const LAS u32x4*)(XT + r * 16384 + zl * 128 + ((zc ^ (zl & 7)) * 16));
        *(u32x4*)(ZG + zoff + (size_t)(m0 + zl) * 2048 + g * 256 + r * 64 + zc * 8) = v; } }
    __syncthreads();
}
__device__ __forceinline__ void phase5f(const Ctx& c) {
    for (int it = c.bid; it < NB * 64 * 4; it += c.nblk) { const int g = it & 3, t = it >> 2, cl = t & 63, b = t >> 6;  s3_item(c, b, cl, g, PROBE_DBL == 5 ? (size_t)c.qsel * ((WS_RC - WS_RA) / 2) : (size_t)0); }
}

__device__ __forceinline__ void phase6(const Ctx& c) {
    EpiPlainT e{(bf16*)(c.ws + WS_RC), 1024};
    static_assert(YSCALE == 16.f && WOSCALE == 64.f, "EpiPlainT::SCA / SCB undo these");
    pg8::Gemm g{FP8_GEMM2 ? (const bf16*)((const unsigned char*)c.out + 64 * MiB) : (const bf16*)(c.ws + WS_RA), (const bf16*)(c.ws + WS_WOUT), ML, 1024, FP8_GEMM2 ? 1024 : 2048};
    pg8::StaticOrder S; S.init(ML, 1024, c.nblk, c.bid, G2_WGM);
    pg8::gemm_phase<EpiPlainT, pg8::StaticOrder, true, FP8_SP2, FP8_TPL != 0>((LAS unsigned char*)c.lds, g, S, e);
}

__device__ __forceinline__ unsigned pk8_fp4(const f32x4& a0, const f32x4& a1, float scale) {
    const float av[8] = {a0.x, a0.y, a0.z, a0.w, a1.x, a1.y, a1.z, a1.w};
    unsigned code = 0u;
#pragma unroll
    for (int j = 0; j < 8; ++j) { const float m = fabsf(av[j]) * scale;
        const unsigned mi = (unsigned)(m > 0.25f) + (unsigned)(m > 0.75f) + (unsigned)(m > 1.25f) + (unsigned)(m > 1.75f) + (unsigned)(m > 2.5f) + (unsigned)(m > 3.5f) + (unsigned)(m > 5.f);
        code |= (mi | (av[j] < 0.f ? 8u : 0u)) << (4 * j); }
    return code;
}
__device__ __forceinline__ void phase7(const Ctx& c) {
    const bf16* MIX = (const bf16*)(c.ws + WS_RC); bf16* H2 = (bf16*)(c.ws + WS_RB); unsigned char* XQ = c.ws + WS_RB + 64 * MiB;
    bf16* X1 = (bf16*)(c.ws + WS_X1); const float* MOD = (const float*)(c.ws + WS_MOD);
    const float* gpost = c.in[I_GPOSTMIX]; const float* gpre = c.in[I_GPREFFN];
    u32x2 mwN[4]; f32x4 xvN[4];
#define P7_LOAD(m_) { _Pragma("unroll") for (int j = 0; j < 4; ++j) { const int col = 4 * c.lane + 256 * j; mwN[j] = *(const u32x2*)(MIX + (size_t)(m_) * 1024 + col); xvN[j] = *(const f32x4*)(c.in[I_X] + (size_t)(m_) * DM + col); } }
    if (c.gw < ML) P7_LOAD(c.gw)
    for (int m = c.gw; m < ML; m += c.ngw) {
        const int b = m / SEQ; const float* mv = MOD + b * NMOD;
        u32x2 mw[4]; f32x4 xv4[4];
#pragma unroll
        for (int j = 0; j < 4; ++j) { mw[j] = mwN[j]; xv4[j] = xvN[j]; }
        { const int mn = (m + c.ngw < ML) ? m + c.ngw : m; P7_LOAD(mn) }
        float mx[16], x1[16]; float ss = 0.f;
#pragma unroll
        for (int j = 0; j < 4; ++j) { const u32x2 w = mw[j];
            mx[4 * j] = __uint_as_float(w.x << 16); mx[4 * j + 1] = __uint_as_float(w.x & 0xffff0000u); mx[4 * j + 2] = __uint_as_float(w.y << 16); mx[4 * j + 3] = __uint_as_float(w.y & 0xffff0000u);
            ss += mx[4 * j] * mx[4 * j] + mx[4 * j + 1] * mx[4 * j + 1] + mx[4 * j + 2] * mx[4 * j + 2] + mx[4 * j + 3] * mx[4 * j + 3]; }
        const float rinv = rsqrtf(wave_sum(ss) * (1.f / DM) + EPS);
        float ss2 = 0.f;
#pragma unroll
        for (int j = 0; j < 4; ++j) { const int col = 4 * c.lane + 256 * j;
            const f32x4 xv = xv4[j], gg = *(const f32x4*)(gpost + col), gt = *(const f32x4*)(mv + MOD_GT1 + col);
            f32x4 o; o.x = xv.x + gt.x * (mx[4 * j] * rinv * gg.x); o.y = xv.y + gt.y * (mx[4 * j + 1] * rinv * gg.y);
            o.z = xv.z + gt.z * (mx[4 * j + 2] * rinv * gg.z); o.w = xv.w + gt.w * (mx[4 * j + 3] * rinv * gg.w);
            u32x2 ob; ob.x = pk2(o.x, o.y); ob.y = pk2(o.z, o.w);
            *(u32x2*)(X1 + (size_t)m * DM + col) = ob;
            x1[4 * j] = o.x; x1[4 * j + 1] = o.y; x1[4 * j + 2] = o.z; x1[4 * j + 3] = o.w;
            ss2 += o.x * o.x + o.y * o.y + o.z * o.z + o.w * o.w; }
        const float rinv2 = rsqrtf(wave_sum(ss2) * (1.f / DM) + EPS);
#pragma unroll
        for (int j = 0; j < 4; ++j) { const int col = 4 * c.lane + 256 * j;
            const f32x4 gg = *(const f32x4*)(gpre + col), sh = *(const f32x4*)(mv + MOD_SH2 + col), sc = *(const f32x4*)(mv + MOD_SC2 + col);
            const float y0 = (x1[4 * j] * rinv2 * gg.x) * (1.f + sc.x) + sh.x, y1 = (x1[4 * j + 1] * rinv2 * gg.y) * (1.f + sc.y) + sh.y;
            const float y2 = (x1[4 * j + 2] * rinv2 * gg.z) * (1.f + sc.z) + sh.z, y3 = (x1[4 * j + 3] * rinv2 * gg.w) * (1.f + sc.w) + sh.w;
            u32x2 o; o.x = pk2(y0, y1); o.y = pk2(y2, y3);
            *(u32x2*)(H2 + (size_t)m * DM + col) = o;
            *(unsigned*)(XQ + (size_t)m * DM + col) = pk4_fp8(y0, y1, y2, y3, XSCALE); }
    }
#undef P7_LOAD
    { const f32x4* U4 = (const f32x4*)c.in[I_U]; const f32x4* V4 = (const f32x4*)c.in[I_V];
      u32x2* Uq = (u32x2*)(c.ws + WS_RC + 64 * MiB); u32x2* Vq = (u32x2*)(c.ws + WS_RC + 96 * MiB); unsigned* Uq4 = (unsigned*)(c.ws + WS_RC + 64 * MiB);
      unsigned* Vq4 = (unsigned*)(c.ws + WS_RC + 96 * MiB);
      for (int i = c.gtid; i < (TABLES_IN_SELECT && U4_TABLE && V4_TABLE && V5_MFMA && SLICED_PEER ? 0 : 16384 * 1024 / 8); i += c.gsz) {
          const size_t di = SLICED_PEER ? ((size_t)((i & 127) >> 4) * (16384 * 16) + (size_t)(i >> 7) * 16 + (i & 15)) : (size_t)i;
          const size_t d4 = (size_t)((i & 127) >> 5) * (16384 * 32) + (size_t)(i >> 7) * 32 + (i & 31);
          if (V4_TABLE && V5_MFMA && SLICED_PEER) {
              const int row = i >> 7, sl = (i & 127) >> 5, w = i & 31; const float* vp = c.in[I_V] + (size_t)row * 1024 + 256 * sl + 128 * (w & 1) + (w >> 1);
              f32x4 a0, a1; a0.x = vp[0]; a0.y = vp[16]; a0.z = vp[32]; a0.w = vp[48]; a1.x = vp[64]; a1.y = vp[80]; a1.z = vp[96]; a1.w = vp[112];
              Vq4[d4] = pk8_fp4(a0, a1, USCALE);
          } else if (V4_TABLE && SLICED_PEER) Vq4[d4] = pk8_fp4(V4[2 * i], V4[2 * i + 1], USCALE);
          else { const f32x4 b0 = V4[2 * i] * TSCALE, b1 = V4[2 * i + 1] * TSCALE;
              u32x2 ob;
              ob.x = (unsigned)__builtin_amdgcn_cvt_pk_fp8_f32(b0.z, b0.w, __builtin_amdgcn_cvt_pk_fp8_f32(b0.x, b0.y, 0, false), true);
              ob.y = (unsigned)__builtin_amdgcn_cvt_pk_fp8_f32(b1.z, b1.w, __builtin_amdgcn_cvt_pk_fp8_f32(b1.x, b1.y, 0, false), true);
              Vq[di] = ob; }
          if (U4_TABLE && SLICED_PEER) Uq4[d4] = pk8_fp4(U4[2 * i], U4[2 * i + 1], USCALE);
          else {
              const f32x4 a0 = U4[2 * i] * TSCALE, a1 = U4[2 * i + 1] * TSCALE; u32x2 oa;
              oa.x = (unsigned)__builtin_amdgcn_cvt_pk_fp8_f32(a0.z, a0.w, __builtin_amdgcn_cvt_pk_fp8_f32(a0.x, a0.y, 0, false), true);
              oa.y = (unsigned)__builtin_amdgcn_cvt_pk_fp8_f32(a1.z, a1.w, __builtin_amdgcn_cvt_pk_fp8_f32(a1.x, a1.y, 0, false), true);
              Uq[di] = oa; } } }
}

__device__ __forceinline__ void phase8(const Ctx& c) {
    EpiPlainT e{(bf16*)(c.ws + WS_RA), 2048};
    pg8::Gemm g{FP8_GEMM3 ? (const bf16*)(c.ws + WS_RB + 64 * MiB) : (const bf16*)(c.ws + WS_RB), (const bf16*)(c.ws + WS_WQK), ML, 2048, FP8_GEMM3 ? 512 : 1024};
    pg8::StaticOrder S; S.init(ML, 2048, c.nblk, c.bid, G3_WGM);
    pg8::gemm_phase<EpiPlainT, pg8::StaticOrder, true, true, FP8_GEMM3 != 0>((LAS unsigned char*)c.lds, g, S, e);
}

__device__ __forceinline__ void argmax_bfly(float& v, int& i) {
#pragma unroll
    for (int o = 1; o < 64; o <<= 1) { const float ov = __shfl_xor(v, o); const int oi = __shfl_xor(i, o);
        if (ov > v || (ov == v && oi < i)) { v = ov; i = oi; } }
}
typedef __attribute__((ext_vector_type(2))) __bf16 bf16x2_t;
__device__ __forceinline__ float dot2bf(unsigned a, unsigned b, float acc) { return __builtin_amdgcn_fdot2_f32_bf16(__builtin_bit_cast(bf16x2_t, a), __builtin_bit_cast(bf16x2_t, b), acc, false); }

__device__ __forceinline__ unsigned umin2(unsigned a, unsigned b) { return a < b ? a : b; }
#define CE(a, b) { const unsigned _h = umax2(x[a], x[b]), _l = umin2(x[a], x[b]); x[a] = _h; x[b] = _l; }
__device__ __forceinline__ void sort16_desc(unsigned* x) { CE(0,1) CE(2,3) CE(4,5) CE(6,7) CE(8,9) CE(10,11) CE(12,13) CE(14,15) CE(0,2) CE(1,3) CE(4,6) CE(5,7) CE(8,10) CE(9,11) CE(12,14) CE(13,15) CE(1,2) CE(5,6) CE(9,10) CE(13,14) CE(0,4) CE(1,5) CE(2,6) CE(3,7) CE(8,12) CE(9,13) CE(10,14) CE(11,15) CE(2,4) CE(3,5) CE(10,12) CE(11,13) CE(1,2) CE(3,4) CE(5,6) CE(9,10) CE(11,12) CE(13,14) CE(0,8) CE(1,9) CE(2,10) CE(3,11) CE(4,12) CE(5,13) CE(6,14) CE(7,15) CE(4,8) CE(5,9) CE(6,10) CE(7,11) CE(2,4) CE(3,5) CE(6,8) CE(7,9) CE(10,12) CE(11,13) CE(1,2) CE(3,4) CE(5,6) CE(7,8) CE(9,10) CE(11,12) CE(13,14) }
__device__ __forceinline__ void clean16_desc(unsigned* x) {
#pragma unroll
    for (int d = 8; d >= 1; d >>= 1)
#pragma unroll
        for (int i = 0; i < 16; ++i) if (!(i & d)) CE(i, i + d)
}
#undef CE
__device__ __forceinline__ unsigned ord32(unsigned u) { return u ^ ((unsigned)((int)u >> 31) | 0x80000000u); }
__device__ __forceinline__ unsigned deord32(unsigned o) { return o ^ ((~(unsigned)((int)o >> 31)) | 0x80000000u); }
template <class EP, class GP> __device__ __forceinline__ void peer_select(const bf16* srow, int lane, EP EL, GP GL) {
    unsigned k[32];
    { const u32x4* s4 = (const u32x4*)srow + 4 * lane; const unsigned sbits = (unsigned)(3 - (lane & 3)) << 5;
#pragma unroll
      for (int i = 0; i < 4; ++i) { const u32x4 w = s4[i]; const unsigned ww[4] = {w.x, w.y, w.z, w.w};
#pragma unroll
          for (int cidx = 0; cidx < 4; ++cidx)
#pragma unroll
              for (int hh = 0; hh < 2; ++hh) { const int j = i * 8 + cidx * 2 + hh; const unsigned u = hh ? (ww[cidx] & 0xffff0000u) : (ww[cidx] << 16);
                  const unsigned m = (unsigned)((int)u >> 31);
                  k[j] = (u ^ ((m & 0x7fff0000u) | 0x80000000u)) | sbits | (unsigned)(31 - j); } } }
    sort16_desc(k); sort16_desc(k + 16);
    unsigned x[16];
#pragma unroll
    for (int i = 0; i < 16; ++i) x[i] = umax2(k[i], k[31 - i]);
    clean16_desc(x);
    { unsigned y[16];
#pragma unroll
      for (int i = 0; i < 16; ++i) y[i] = umax2(x[i], dpp_u<0xB1>(x[15 - i]));
      clean16_desc(y);
#pragma unroll
      for (int i = 0; i < 16; ++i) x[i] = umax2(y[i], dpp_u<0x4E>(y[15 - i]));
      clean16_desc(x); }
    float xv[16]; unsigned xt[16]; const bool isB = (lane >> 2) & 1; const int sh = isB ? 0 : 7;
#pragma unroll
    for (int i = 0; i < 16; ++i) { const unsigned o = x[i] & 0xffff0000u; xv[i] = __uint_as_float(o ^ ((~(unsigned)((int)o >> 31) & 0x7fff0000u) | 0x80000000u));
        xt[i] = (((x[i] & 0x7fu) ^ 0x7fu) << sh); }
    unsigned ca[16], cb2[16];
#define CAND(dst, i, j) { const float s_ = xv[i] + dpp_f<0x141>(xv[j]); const unsigned t_ = xt[i] | dpp_u<0x141>(xt[j]); dst = (ord32(__float_as_uint(s_)) & 0xffffc000u) | t_; }
    CAND(ca[0], 0, 1) CAND(ca[1], 0, 2) CAND(ca[2], 0, 3) CAND(ca[3], 0, 4) CAND(ca[4], 0, 5) CAND(ca[5], 0, 6) CAND(ca[6], 0, 7) CAND(ca[7], 0, 8)
    CAND(ca[8], 0, 9) CAND(ca[9], 0, 10) CAND(ca[10], 0, 11) CAND(ca[11], 0, 12) CAND(ca[12], 0, 13) CAND(ca[13], 0, 14) CAND(ca[14], 0, 15) CAND(ca[15], 1, 2)
    CAND(cb2[0], 1, 3) CAND(cb2[1], 1, 4) CAND(cb2[2], 1, 5) CAND(cb2[3], 1, 6) CAND(cb2[4], 1, 7) CAND(cb2[5], 2, 3) CAND(cb2[6], 2, 4)
    CAND(cb2[7], 0, 0) CAND(cb2[8], 1, 1) CAND(cb2[9], 2, 2) CAND(cb2[10], 3, 3)
#undef CAND
    if (isB) { cb2[7] = 0u; cb2[8] = 0u; cb2[9] = 0u; cb2[10] = 0u; }
    cb2[11] = 0u; cb2[12] = 0u; cb2[13] = 0u; cb2[14] = 0u; cb2[15] = 0u;
    sort16_desc(ca); sort16_desc(cb2);
#pragma unroll
    for (int i = 0; i < 16; ++i) x[i] = umax2(ca[i], cb2[15 - i]);
    clean16_desc(x);
    { unsigned y[16];
#pragma unroll
      for (int i = 0; i < 16; ++i) y[i] = umax2(x[i], dpp_u<0x141>(x[15 - i]));
      clean16_desc(y);
      float e[16]; float sum = 0.f; const float c0 = __uint_as_float(deord32(y[0] & 0xffffc000u));
#pragma unroll
      for (int r = 0; r < 16; ++r) { const float cv = __uint_as_float(deord32(y[r] & 0xffffc000u)); e[r] = __expf(cv - c0); sum += e[r]; }
      const float inv = 1.f / sum;
      if ((lane & 7) == 0) { const int h = lane >> 3;
          if constexpr (sizeof(*EL) == 2) {
              u32x4 p0, p1; p0.x = (y[0] & 0x3fffu) | ((y[1] & 0x3fffu) << 16); p0.y = (y[2] & 0x3fffu) | ((y[3] & 0x3fffu) << 16); p0.z = (y[4] & 0x3fffu) | ((y[5] & 0x3fffu) << 16); p0.w = (y[6] & 0x3fffu) | ((y[7] & 0x3fffu) << 16);
              p1.x = (y[8] & 0x3fffu) | ((y[9] & 0x3fffu) << 16); p1.y = (y[10] & 0x3fffu) | ((y[11] & 0x3fffu) << 16); p1.z = (y[12] & 0x3fffu) | ((y[13] & 0x3fffu) << 16); p1.w = (y[14] & 0x3fffu) | ((y[15] & 0x3fffu) << 16);
              *(u32x4*)(EL + h * 16) = p0; *(u32x4*)(EL + h * 16 + 8) = p1;
#pragma unroll
              for (int r4 = 0; r4 < 4; ++r4) { f32x4 gv; gv.x = e[4 * r4] * inv; gv.y = e[4 * r4 + 1] * inv; gv.z = e[4 * r4 + 2] * inv; gv.w = e[4 * r4 + 3] * inv; *(f32x4*)(GL + h * 16 + 4 * r4) = gv; }
          } else {
#pragma unroll
          for (int r4 = 0; r4 < 4; ++r4) { u32x4 ev; ev.x = y[4 * r4] & 0x3fffu; ev.y = y[4 * r4 + 1] & 0x3fffu; ev.z = y[4 * r4 + 2] & 0x3fffu; ev.w = y[4 * r4 + 3] & 0x3fffu;
              f32x4 gv; gv.x = e[4 * r4] * inv; gv.y = e[4 * r4 + 1] * inv; gv.z = e[4 * r4 + 2] * inv; gv.w = e[4 * r4 + 3] * inv;
              *(LAS u32x4*)(EL + h * 16 + 4 * r4) = ev; *(LAS f32x4*)(GL + h * 16 + 4 * r4) = gv; } } } }
}

constexpr int RB = 8;
typedef _Float16 f16x2_t __attribute__((ext_vector_type(2)));
typedef float f32x2_t __attribute__((ext_vector_type(2)));
struct RowBuf { u32x4 a[RB]; };
__device__ __forceinline__ void rows_load(RowBuf& B, const unsigned char* T, int Ereg, int base, int lane) {
#pragma unroll
    for (int r = 0; r < RB; ++r) { const int ek = __builtin_amdgcn_readlane(Ereg, base + r);
        B.a[r] = ((const u32x4*)(T + (size_t)ek * DM))[lane]; }
}
__device__ __forceinline__ float dot2h(unsigned fp8w, bool hi, f16x2_t x, float acc) {
    const f16x2_t u = hi ? __builtin_amdgcn_cvt_scalef32_pk_f16_fp8((int)fp8w, 1.0f, true) : __builtin_amdgcn_cvt_scalef32_pk_f16_fp8((int)fp8w, 1.0f, false);
    return __builtin_amdgcn_fdot2(u, x, acc, false);
}
__device__ __forceinline__ void rows_dot(const RowBuf& B, const f16x2_t* x, int sub, int lane, float& mine) {
#pragma unroll
    for (int r = 0; r < RB; ++r) { float s = 0.f;
        s = dot2h(B.a[r].x, false, x[0], s); s = dot2h(B.a[r].x, true, x[1], s); s = dot2h(B.a[r].y, false, x[2], s); s = dot2h(B.a[r].y, true, x[3], s);
        s = dot2h(B.a[r].z, false, x[4], s); s = dot2h(B.a[r].z, true, x[5], s); s = dot2h(B.a[r].w, false, x[6], s); s = dot2h(B.a[r].w, true, x[7], s);
        s = wave_sum(s); if ((lane & 15) == sub + r) mine = s; }
}
__device__ __forceinline__ void rows_axpy(const RowBuf& B, float wv, int base, float* o) {
#pragma unroll
    for (int r = 0; r < RB; ++r) { const float w = __builtin_bit_cast(float, __builtin_amdgcn_readlane(__builtin_bit_cast(int, wv), base + r));
        const unsigned q[4] = {B.a[r].x, B.a[r].y, B.a[r].z, B.a[r].w};
#pragma unroll
        for (int j = 0; j < 4; ++j) { const f32x2_t lo = __builtin_amdgcn_cvt_pk_f32_fp8((int)q[j], false), hi = __builtin_amdgcn_cvt_pk_f32_fp8((int)q[j], true);
            o[4 * j] += w * lo.x; o[4 * j + 1] += w * lo.y; o[4 * j + 2] += w * hi.x; o[4 * j + 3] += w * hi.y; } }
}
__device__ __forceinline__ void phase9(const Ctx& c) {
    const bf16* SC = (const bf16*)(c.ws + WS_RA); const bf16* H2 = (const bf16*)(c.ws + WS_RB); float* X1 = c.out; const float* MOD = (const float*)(c.ws + WS_MOD);
    const unsigned char* Uq = c.ws + WS_RC + 64 * MiB; const unsigned char* Vq = c.ws + WS_RC + 96 * MiB; const float* gpost = c.in[I_GPOSTFFN];
    for (int m = c.gw; m < ML; m += c.ngw) {
        const int lane = c.lane;
        LAS unsigned* EL = (LAS unsigned*)((LAS unsigned char*)c.lds + c.wave * 1024); LAS float* GL = (LAS float*)(EL + 128);
        peer_select(SC + (size_t)m * 2048, lane, EL, GL);
        f16x2_t xh[8];
        { const u32x4 xa = ((const u32x4*)(H2 + (size_t)m * DM))[2 * lane], xb = ((const u32x4*)(H2 + (size_t)m * DM))[2 * lane + 1];
          const unsigned xw[8] = {xa.x, xa.y, xa.z, xa.w, xb.x, xb.y, xb.z, xb.w};
#pragma unroll
          for (int j = 0; j < 8; ++j) { f16x2_t t; t.x = (_Float16)__uint_as_float(xw[j] << 16); t.y = (_Float16)__uint_as_float(xw[j] & 0xffff0000u); xh[j] = t; } }
        float outv[16];
#pragma unroll
        for (int j = 0; j < 16; ++j) outv[j] = 0.f;
        RowBuf bA, bB;
        int Ev = (int)EL[lane & 15];
        rows_load(bA, Uq, Ev, 0, lane);
#pragma unroll 1
        for (int h = 0; h < 8; ++h) {
            const float gv = GL[h * 16 + (lane & 15)];
            const int En = (int)EL[((h + 1) & 7) * 16 + (lane & 15)];
            float mine = 0.f;
            rows_load(bB, Uq, Ev, 8, lane);  rows_dot(bA, xh, 0, lane, mine);
            rows_load(bA, Vq, Ev, 0, lane);  rows_dot(bB, xh, 8, lane, mine);
            const float wv = gv * gelu_tanh(mine * (1.f / TSCALE)) * (1.f / TSCALE);
            rows_load(bB, Vq, Ev, 8, lane);  rows_axpy(bA, wv, 0, outv);
            if (h < 7) rows_load(bA, Uq, En, 0, lane);
            rows_axpy(bB, wv, 8, outv);
            Ev = En;
        }
        float ss = 0.f;
#pragma unroll
        for (int j = 0; j < 16; ++j) ss += outv[j] * outv[j];
        const float rinv = rsqrtf(wave_sum(ss) * (1.f / DM) + EPS);
        const int b = m / SEQ; const float* gt2 = MOD + b * NMOD + MOD_GT2;
#pragma unroll
        for (int j = 0; j < 4; ++j) { const int col = lane * 16 + 4 * j; const float* ov = outv + 4 * j;
            const f32x4 xx = *(const f32x4*)(X1 + (size_t)m * DM + col), gg = *(const f32x4*)(gpost + col), gt = *(const f32x4*)(gt2 + col);
            f32x4 o; o.x = xx.x + gt.x * (ov[0] * rinv * gg.x); o.y = xx.y + gt.y * (ov[1] * rinv * gg.y);
            o.z = xx.z + gt.z * (ov[2] * rinv * gg.z); o.w = xx.w + gt.w * (ov[3] * rinv * gg.w);
            *(f32x4*)(X1 + (size_t)m * DM + col) = o; }
    }
}


__device__ __forceinline__ void phase9_probe(const Ctx& c, unsigned mask) {
    const bf16* H2 = (const bf16*)(c.ws + WS_RB);
    const unsigned char* Uq = c.ws + WS_RC + 64 * MiB; const unsigned char* Vq = c.ws + WS_RC + 96 * MiB;
    float* dump = (float*)(c.ws + WS_RE);
    for (int m = c.gw; m < ML; m += c.ngw) {
        const int lane = c.lane;
        f16x2_t xh[8];
        { const u32x4 xa = ((const u32x4*)(H2 + (size_t)m * DM))[2 * lane], xb = ((const u32x4*)(H2 + (size_t)m * DM))[2 * lane + 1];
          const unsigned xw[8] = {xa.x, xa.y, xa.z, xa.w, xb.x, xb.y, xb.z, xb.w};
#pragma unroll
          for (int j = 0; j < 8; ++j) { f16x2_t t; t.x = (_Float16)__uint_as_float(xw[j] << 16); t.y = (_Float16)__uint_as_float(xw[j] & 0xffff0000u); xh[j] = t; } }
        float outv[16];
#pragma unroll
        for (int j = 0; j < 16; ++j) outv[j] = 0.f;
        RowBuf bA, bB;
        int Ev = (int)((((unsigned)(m * 131 + (lane & 15)) * 2654435761u) >> 12) & mask);
        rows_load(bA, Uq, Ev, 0, lane);
#pragma unroll 1
        for (int h = 0; h < 8; ++h) {
            const float gv = 0.0625f;
            const int En = (int)((((unsigned)(m * 131 + (h + 1) * 17 + (lane & 15)) * 2654435761u) >> 12) & mask);
            float mine = 0.f;
            rows_load(bB, Uq, Ev, 8, lane);  rows_dot(bA, xh, 0, lane, mine);
            rows_load(bA, Vq, Ev, 0, lane);  rows_dot(bB, xh, 8, lane, mine);
            const float wv = gv * gelu_tanh(mine * (1.f / TSCALE)) * (1.f / TSCALE);
            rows_load(bB, Vq, Ev, 8, lane);  rows_axpy(bA, wv, 0, outv);
            if (h < 7) rows_load(bA, Uq, En, 0, lane);
            rows_axpy(bB, wv, 8, outv);
            Ev = En;
        }
#pragma unroll
        for (int j = 0; j < 4; ++j) { f32x4 o; o.x = outv[4 * j]; o.y = outv[4 * j + 1]; o.z = outv[4 * j + 2]; o.w = outv[4 * j + 3]; *(f32x4*)(dump + (size_t)(m & 4095) * DM + lane * 16 + 4 * j) = o; }
    }
}

constexpr size_t WS_EID = WS_RC, WS_GT = WS_RC + 8 * MiB, WS_WW = WS_RC + 24 * MiB, WS_SSQ = WS_RC + 40 * MiB;
constexpr int CW_PEERU = 8192, CW_PEERV = 8192 + 1024;
#ifndef TPW_
#define TPW_ 64
#endif
constexpr int TPW = TPW_;
constexpr int NTB = ML / (8 * TPW);

struct TabStep { f32x4 u0, u1, v0, v1; };
__device__ __forceinline__ void tab_load(const Ctx& c, int i, TabStep& T) {
    const f32x4* U4 = (const f32x4*)c.in[I_U]; T.u0 = U4[2 * i]; T.u1 = U4[2 * i + 1];
    const int row = i >> 7, sl = (i & 127) >> 5, w = i & 31; const float* vp = c.in[I_V] + (size_t)row * 1024 + 256 * sl + 128 * (w & 1) + (w >> 1);
    T.v0.x = vp[0]; T.v0.y = vp[16]; T.v0.z = vp[32]; T.v0.w = vp[48]; T.v1.x = vp[64]; T.v1.y = vp[80]; T.v1.z = vp[96]; T.v1.w = vp[112];
}
__device__ __forceinline__ void tab_store(const Ctx& c, int i, const TabStep& T) {
    unsigned* Uq4 = (unsigned*)(c.ws + WS_RC + 64 * MiB); unsigned* Vq4 = (unsigned*)(c.ws + WS_RC + 96 * MiB);
    const size_t d4 = (size_t)((i & 127) >> 5) * (16384 * 32) + (size_t)(i >> 7) * 32 + (i & 31);
    Uq4[d4] = pk8_fp4(T.u0, T.u1, USCALE); Vq4[d4] = pk8_fp4(T.v0, T.v1, USCALE);
}
__device__ __forceinline__ void phase9s(const Ctx& c) {
    const bf16* SC = (const bf16*)(c.ws + WS_RA);
    constexpr int NTAB = (TABLES_IN_SELECT && U4_TABLE && V4_TABLE && V5_MFMA) ? 16384 * 1024 / 8 : 0;
    int ci = c.gtid;
    for (int m = c.gw; m < ML; m += c.ngw) {
        TabStep T; const bool doit = ci < NTAB; const int cj = doit ? ci : 0;
        if (NTAB) tab_load(c, cj, T);
        peer_select(SC + (size_t)m * 2048, c.lane, (unsigned short*)(c.ws + WS_EID) + (size_t)m * 128, (float*)(c.ws + WS_GT) + (size_t)m * 128);
        if (NTAB) { if (doit) tab_store(c, cj, T); ci += c.gsz; }
    }
    for (; ci < NTAB; ci += c.gsz) { TabStep T; tab_load(c, ci, T); tab_store(c, ci, T); }
}

__device__ __forceinline__ int grab_item(unsigned* ctr, volatile LAS int* slot) {
    if (threadIdx.x == 0) *slot = (int)__hip_atomic_fetch_add(ctr, 1u, __ATOMIC_RELAXED, __HIP_MEMORY_SCOPE_AGENT);
    __syncthreads(); const int v = *slot; __syncthreads(); return v;
}
struct SliceBuf { u32x4 a[16]; };
__device__ __forceinline__ void slice_load(SliceBuf& B, const unsigned char* Tslice, const u32x4& e0, const u32x4& e1) {
    const unsigned ew[8] = {e0.x, e0.y, e0.z, e0.w, e1.x, e1.y, e1.z, e1.w};
#pragma unroll
    for (int r = 0; r < 16; ++r) { const unsigned eid = (r & 1) ? (ew[r >> 1] >> 16) : (ew[r >> 1] & 0xffffu);
        B.a[r] = *(const u32x4*)(Tslice + (size_t)eid * 128); }
}
__device__ __forceinline__ void pub8(void* p, const u32x2& v) {
    if (FUSE_TAIL) __hip_atomic_store((unsigned long long*)p, ((unsigned long long)v.y << 32) | v.x, __ATOMIC_RELAXED, __HIP_MEMORY_SCOPE_AGENT); else *(u32x2*)p = v; }
__device__ __forceinline__ void pub4(float* p, float v) {
    if (FUSE_TAIL) __hip_atomic_store(p, v, __ATOMIC_RELAXED, __HIP_MEMORY_SCOPE_AGENT); else *p = v; }
__device__ __forceinline__ long mk64(unsigned lo, unsigned hi) { return (long)(((unsigned long long)hi << 32) | lo); }
__device__ __forceinline__ void u_token(const SliceBuf& B, const u32x4& x0, const u32x4& x1, bf16* PDt, int lane, LAS unsigned char* stg) {
    { const int h = lane >> 3, cs = ((lane & 7) ^ h) * 16;
#pragma unroll
      for (int j = 0; j < 16; ++j) *(LAS u32x4*)(stg + (8 * j + h) * 128 + cs) = B.a[j]; }
    const long b0 = mk64(x0.x, x0.y), b1 = mk64(x0.z, x0.w), b2 = mk64(x1.x, x1.y), b3 = mk64(x1.z, x1.w);
    const int i = lane & 15, q = lane >> 4, hh = i & 7;
    const LAS unsigned char* rb = stg + ((i >> 3) * 8 + hh) * 128;
    const int o0 = (((2 * q) ^ hh) * 16), o1 = (((2 * q + 1) ^ hh) * 16);
    f32x4 keep = {0.f, 0.f, 0.f, 0.f};
#pragma unroll
    for (int G = 0; G < 8; ++G) { f32x4 acc = {0.f, 0.f, 0.f, 0.f}; const LAS unsigned char* rg = rb + G * 2048;
        acc = __builtin_amdgcn_mfma_f32_16x16x32_fp8_fp8(*(const LAS long*)(rg + o0), b0, acc, 0, 0, 0);
        acc = __builtin_amdgcn_mfma_f32_16x16x32_fp8_fp8(*(const LAS long*)(rg + o0 + 8), b1, acc, 0, 0, 0);
        acc = __builtin_amdgcn_mfma_f32_16x16x32_fp8_fp8(*(const LAS long*)(rg + o1), b2, acc, 0, 0, 0);
        acc = __builtin_amdgcn_mfma_f32_16x16x32_fp8_fp8(*(const LAS long*)(rg + o1 + 8), b3, acc, 0, 0, 0);
        if (i == G) keep = acc; }
    if (i < 8) { u32x2 o; o.x = pk2(keep[0], keep[1]); o.y = pk2(keep[2], keep[3]);
        *(u32x2*)(PDt + (2 * i + (q >> 1)) * 8 + 4 * (q & 1)) = o; }
}
__device__ __forceinline__ void u_item(const Ctx& c, int s, int tb) {
    const unsigned char* XQ = c.ws + WS_RB + 64 * MiB + 128 * s; const unsigned short* EID = (const unsigned short*)(c.ws + WS_EID);
    bf16* PD = (bf16*)(c.ws + WS_RA) + (size_t)s * ML * 128;
    const int lane = c.lane, h = lane >> 3, cc = lane & 7;
    const unsigned char* Us = c.ws + WS_RC + 64 * MiB + (size_t)s * (16384 * 128) + 16 * cc;
    LAS unsigned char* stg = (LAS unsigned char*)c.lds + c.wave * 16384;
    const int t0 = tb * (8 * TPW) + c.wave * TPW;
    const unsigned short* Eh = EID + 16 * h; const unsigned char* Xq = XQ + 32 * (lane >> 4);
#define LD_E(dst0, dst1, t) { dst0 = *(const u32x4*)(Eh + (size_t)(t) * 128); dst1 = *(const u32x4*)(Eh + (size_t)(t) * 128 + 8); }
#define LD_X(dst0, dst1, t) { dst0 = *(const u32x4*)(Xq + (size_t)(t) * DM); dst1 = *(const u32x4*)(Xq + (size_t)(t) * DM + 16); }
    SliceBuf bA, bB; u32x4 ea0, ea1, eb0, eb1, ec0, ec1, xa0, xa1, xb0, xb1;
    LD_E(ea0, ea1, t0) LD_X(xa0, xa1, t0) LD_E(eb0, eb1, t0 + 1)
    slice_load(bA, Us, ea0, ea1);
#pragma unroll 1
    for (int i = 0; i < TPW; i += 2) { const int t = t0 + i; const int t2 = (i + 2 < TPW) ? t + 2 : t, t3 = (i + 3 < TPW) ? t + 3 : t;
        LD_E(ec0, ec1, t2) LD_X(xb0, xb1, t + 1)
        slice_load(bB, Us, eb0, eb1);
        u_token(bA, xa0, xa1, PD + (size_t)t * 128, lane, stg);
        LD_E(eb0, eb1, t3) LD_X(xa0, xa1, t2)
        slice_load(bA, Us, ec0, ec1);
        u_token(bB, xb0, xb1, PD + (size_t)(t + 1) * 128, lane, stg);
    }
#undef LD_X
}
typedef int i32x8_u __attribute__((ext_vector_type(8)));
__device__ __forceinline__ void u4_token(const SliceBuf& B, const u32x4& x0, const u32x4& x1, const u32x4& x2, const u32x4& x3, bf16* PDt, int lane, LAS unsigned char* stg) {
    { const int h = lane >> 3, cs = ((lane & 7) ^ h) * 16;
#pragma unroll
      for (int j = 0; j < 16; ++j) *(LAS u32x4*)(stg + (8 * j + h) * 128 + cs) = B.a[j]; }
    const i32x8_u b0 = {(int)x0.x, (int)x0.y, (int)x0.z, (int)x0.w, (int)x1.x, (int)x1.y, (int)x1.z, (int)x1.w};
    const i32x8_u b1 = {(int)x2.x, (int)x2.y, (int)x2.z, (int)x2.w, (int)x3.x, (int)x3.y, (int)x3.z, (int)x3.w};
    const int i = lane & 15, q = lane >> 4, hh = i & 7;
    const LAS unsigned char* rb = stg + ((i >> 3) * 8 + hh) * 128;
    const int o0 = ((q ^ hh) * 16), o1 = (((4 + q) ^ hh) * 16);
    f32x4 keep = {0.f, 0.f, 0.f, 0.f};
#pragma unroll
    for (int G = 0; G < 8; ++G) { f32x4 acc = {0.f, 0.f, 0.f, 0.f}; const LAS unsigned char* rg = rb + G * 2048;
        const u32x4 a0 = *(const LAS u32x4*)(rg + o0), a1 = *(const LAS u32x4*)(rg + o1);
        const i32x8_u A0 = {(int)a0.x, (int)a0.y, (int)a0.z, (int)a0.w, 0, 0, 0, 0}, A1 = {(int)a1.x, (int)a1.y, (int)a1.z, (int)a1.w, 0, 0, 0, 0};
        acc = __builtin_amdgcn_mfma_scale_f32_16x16x128_f8f6f4(A0, b0, acc, 4, 0, 0, 127, 0, 127);
        acc = __builtin_amdgcn_mfma_scale_f32_16x16x128_f8f6f4(A1, b1, acc, 4, 0, 0, 127, 0, 127);
        if (i == G) keep = acc; }
    if (i < 8) { u32x2 o; o.x = pk2(keep[0], keep[1]); o.y = pk2(keep[2], keep[3]);
        pub8(PDt + (2 * i + (q >> 1)) * 8 + 4 * (q & 1), o); }
}
__device__ __forceinline__ void u4_item(const Ctx& c, int s, int tb) {
    const unsigned char* XQ = c.ws + WS_RB + 64 * MiB + 256 * s; const unsigned short* EID = (const unsigned short*)(c.ws + WS_EID);
    bf16* PD = (bf16*)(c.ws + WS_RA) + (size_t)s * ML * 128;
    const int lane = c.lane, h = lane >> 3, cc = lane & 7, q = lane >> 4;
    const unsigned char* Us = c.ws + WS_RC + 64 * MiB + (size_t)s * (16384 * 128) + 16 * cc;
    LAS unsigned char* stg = (LAS unsigned char*)c.lds + c.wave * 16384;
    const int t0 = tb * (8 * TPW) + c.wave * TPW;
    const unsigned short* Eh = EID + 16 * h; const unsigned char* Xq = XQ + 16 * q;
#define LD_E(dst0, dst1, t) { dst0 = *(const u32x4*)(Eh + (size_t)(t) * 128); dst1 = *(const u32x4*)(Eh + (size_t)(t) * 128 + 8); }
#define LD_X4(d0, d1, d2, d3, t) { d0 = *(const u32x4*)(Xq + (size_t)(t) * DM); d1 = *(const u32x4*)(Xq + (size_t)(t) * DM + 64); d2 = *(const u32x4*)(Xq + (size_t)(t) * DM + 128); d3 = *(const u32x4*)(Xq + (size_t)(t) * DM + 192); }
    SliceBuf bA, bB; u32x4 ea0, ea1, eb0, eb1, ec0, ec1, xa0, xa1, xa2, xa3, xb0, xb1, xb2, xb3;
    LD_E(ea0, ea1, t0) LD_X4(xa0, xa1, xa2, xa3, t0) LD_E(eb0, eb1, t0 + 1)
    slice_load(bA, Us, ea0, ea1);
#pragma unroll 1
    for (int i = 0; i < TPW; i += 2) { const int t = t0 + i; const int t2 = (i + 2 < TPW) ? t + 2 : t, t3 = (i + 3 < TPW) ? t + 3 : t;
        LD_E(ec0, ec1, t2) LD_X4(xb0, xb1, xb2, xb3, t + 1)
        slice_load(bB, Us, eb0, eb1);
        u4_token(bA, xa0, xa1, xa2, xa3, PD + (size_t)t * 128, lane, stg);
        LD_E(eb0, eb1, t3) LD_X4(xa0, xa1, xa2, xa3, t2)
        slice_load(bA, Us, ec0, ec1);
        u4_token(bB, xb0, xb1, xb2, xb3, PD + (size_t)(t + 1) * 128, lane, stg);
    }
#undef LD_X4
#undef LD_E
}
__device__ __forceinline__ float swap32_add(float a, float b) { auto r = __builtin_amdgcn_permlane32_swap(__builtin_bit_cast(unsigned, a), __builtin_bit_cast(unsigned, b), false, false);
    return __builtin_bit_cast(float, (unsigned)r[0]) + __builtin_bit_cast(float, (unsigned)r[1]); }
__device__ __forceinline__ float swap16_add(float a, float b) { auto r = __builtin_amdgcn_permlane16_swap(__builtin_bit_cast(unsigned, a), __builtin_bit_cast(unsigned, b), false, false);
    return __builtin_bit_cast(float, (unsigned)r[0]) + __builtin_bit_cast(float, (unsigned)r[1]); }
__device__ __forceinline__ void v_token(const SliceBuf& B, const f32x4* w4, bf16* POt, float* SSQt, int lane) {
    f32x2_t acc[8];
#pragma unroll
    for (int j = 0; j < 8; ++j) acc[j] = (f32x2_t){0.f, 0.f};
#pragma unroll
    for (int r = 0; r < 16; ++r) { const float w = w4[r >> 2][r & 3]; const f32x2_t ww = {w, w}; const unsigned q[4] = {B.a[r].x, B.a[r].y, B.a[r].z, B.a[r].w};
#pragma unroll
        for (int j = 0; j < 4; ++j) { const f32x2_t lo = __builtin_amdgcn_cvt_pk_f32_fp8((int)q[j], false), hi = __builtin_amdgcn_cvt_pk_f32_fp8((int)q[j], true);
            acc[2 * j] = ww * lo + acc[2 * j]; acc[2 * j + 1] = ww * hi + acc[2 * j + 1]; } }
    float b8[8], c4[4], d2[2];
#pragma unroll
    for (int j = 0; j < 4; ++j) { b8[2 * j] = swap32_add(acc[j].x, acc[j + 4].x); b8[2 * j + 1] = swap32_add(acc[j].y, acc[j + 4].y); }
#pragma unroll
    for (int j = 0; j < 4; ++j) c4[j] = swap16_add(b8[j], b8[j + 4]);
    const bool b3 = (lane >> 3) & 1;
#pragma unroll
    for (int j = 0; j < 2; ++j) { const float keep = b3 ? c4[j + 2] : c4[j], send = b3 ? c4[j] : c4[j + 2]; d2[j] = keep + dpp_f<0x128>(send); }
    const int col = 8 * (lane >> 5) + 4 * ((lane >> 4) & 1) + 2 * ((lane >> 3) & 1);
    *(unsigned*)(POt + 16 * (lane & 7) + col) = pk2(d2[0], d2[1]);
    const float ss = wave_sum(d2[0] * d2[0] + d2[1] * d2[1]);
    if (lane == 0) *SSQt = ss;
}
__device__ __forceinline__ void v4_token(const SliceBuf& B, const f32x4* w4, bf16* POt, float* SSQt, int lane) {
    f32x2_t acc[16];
#pragma unroll
    for (int j = 0; j < 16; ++j) acc[j] = (f32x2_t){0.f, 0.f};
#pragma unroll
    for (int r = 0; r < 16; ++r) { const float w = w4[r >> 2][r & 3]; const f32x2_t ww = {w, w}; const unsigned q[4] = {B.a[r].x, B.a[r].y, B.a[r].z, B.a[r].w};
#pragma unroll
        for (int j = 0; j < 4; ++j) {
            acc[4 * j]     = ww * __builtin_amdgcn_cvt_scalef32_pk_f32_fp4(q[j], 1.0f, 0) + acc[4 * j];
            acc[4 * j + 1] = ww * __builtin_amdgcn_cvt_scalef32_pk_f32_fp4(q[j], 1.0f, 1) + acc[4 * j + 1];
            acc[4 * j + 2] = ww * __builtin_amdgcn_cvt_scalef32_pk_f32_fp4(q[j], 1.0f, 2) + acc[4 * j + 2];
            acc[4 * j + 3] = ww * __builtin_amdgcn_cvt_scalef32_pk_f32_fp4(q[j], 1.0f, 3) + acc[4 * j + 3]; } }
    float b16[16], c8[8], d4[4];
#pragma unroll
    for (int j = 0; j < 8; ++j) { b16[2 * j] = swap32_add(acc[j].x, acc[j + 8].x); b16[2 * j + 1] = swap32_add(acc[j].y, acc[j + 8].y); }
#pragma unroll
    for (int j = 0; j < 8; ++j) c8[j] = swap16_add(b16[j], b16[j + 8]);
    const bool b3 = (lane >> 3) & 1;
#pragma unroll
    for (int j = 0; j < 4; ++j) { const float keep = b3 ? c8[j + 4] : c8[j], send = b3 ? c8[j] : c8[j + 4]; d4[j] = keep + dpp_f<0x128>(send); }
    const int col = 16 * (lane >> 5) + 8 * ((lane >> 4) & 1) + 4 * ((lane >> 3) & 1);
    u32x2 o; o.x = pk2(d4[0], d4[1]); o.y = pk2(d4[2], d4[3]);
    pub8(POt + 32 * (lane & 7) + col, o);
    const float ss = wave_sum(d4[0] * d4[0] + d4[1] * d4[1] + d4[2] * d4[2] + d4[3] * d4[3]);
    if (lane == 0) pub4(SSQt, ss);
}
typedef int v2i32_t __attribute__((ext_vector_type(2)));
__device__ __forceinline__ void v5_token(const SliceBuf& B, const u32x4& w0, const u32x4& w1, bf16* POt, float* SSQt, int lane, LAS unsigned char* stg) {
    { const int h = lane >> 3, cc = lane & 7;
#pragma unroll
      for (int j = 0; j < 16; ++j) { const u32x4 v = B.a[j]; const u32x4 sw = {v.z, v.w, v.x, v.y};
          *(LAS u32x4*)(stg + (8 * j + h) * 128 + ((cc ^ ((4 * j + (h >> 1)) & 7)) * 16)) = ((j >> 2) & 1) ? sw : v; } }
    const i32x8_u A = {(int)w0.x, (int)w0.y, (int)w0.z, (int)w0.w, (int)w1.x, (int)w1.y, (int)w1.z, (int)w1.w};
    const int l16 = lane & 15, q = lane >> 4, fx = (((l16 >> 1) & 7) * 16) | ((q & 1) * 8);
    const LAS unsigned char* rb = stg + (32 * q + l16) * 128;
    float val[16];
#pragma unroll
    for (int g = 0; g < 16; ++g) {
        const LAS unsigned char* pa = rb + (((g >> 1) * 16 + 8 * (g & 1)) ^ fx);
        const v2i32_t lo = __builtin_amdgcn_ds_read_tr4_b64_v2i32((LAS v2i32_t*)pa), hi = __builtin_amdgcn_ds_read_tr4_b64_v2i32((LAS v2i32_t*)(pa + 2048));
        const i32x8_u Bv = {lo.x, lo.y, hi.x, hi.y, 0, 0, 0, 0};
        f32x4 acc = {0.f, 0.f, 0.f, 0.f};
        acc = __builtin_amdgcn_mfma_scale_f32_16x16x128_f8f6f4(A, Bv, acc, 0, 4, 0, 127, 0, 127);
        val[g] = (acc[0] + acc[1] * (1.f / WLO)) * (1.f / (WSC * USCALE)); }
    float ss = 0.f;
#pragma unroll
    for (int g = 0; g < 16; ++g) ss += val[g] * val[g];
    u32x4 o0, o1; o0.x = pk2(val[0], val[1]); o0.y = pk2(val[2], val[3]); o0.z = pk2(val[4], val[5]); o0.w = pk2(val[6], val[7]);
    o1.x = pk2(val[8], val[9]); o1.y = pk2(val[10], val[11]); o1.z = pk2(val[12], val[13]); o1.w = pk2(val[14], val[15]);
    ss = row16_sum(ss);
    if (lane < 16) { *(u32x4*)(POt + 16 * lane) = o0; *(u32x4*)(POt + 16 * lane + 8) = o1; }
    if (lane == 0) *SSQt = ss;
}
__device__ __forceinline__ void v5_item(const Ctx& c, int s, int tb) {
    const unsigned short* EID = (const unsigned short*)(c.ws + WS_EID); const unsigned char* WQ = c.ws + WS_WW;
    bf16* PO = (bf16*)(c.ws + WS_RA) + 256 * s; float* SSQ = (float*)(c.ws + WS_SSQ) + (size_t)s * ML;
    const int lane = c.lane, h = lane >> 3, cc = lane & 7;
    const unsigned char* Vs = c.ws + WS_RC + 96 * MiB + (size_t)s * (16384 * 128) + 16 * cc;
    LAS unsigned char* stg = (LAS unsigned char*)c.lds + c.wave * 16384;
    const int t0 = tb * (8 * TPW) + c.wave * TPW;
    const unsigned short* Eh = EID + 16 * h; const unsigned char* Wl = WQ + 128 * (lane & 1) + 32 * (lane >> 4);
#define LD_E(dst0, dst1, t) { dst0 = *(const u32x4*)(Eh + (size_t)(t) * 128); dst1 = *(const u32x4*)(Eh + (size_t)(t) * 128 + 8); }
#define LD_A(dst0, dst1, t) { dst0 = *(const u32x4*)(Wl + (size_t)(t) * 256); dst1 = *(const u32x4*)(Wl + (size_t)(t) * 256 + 16); }
    SliceBuf bA, bB; u32x4 ea0, ea1, eb0, eb1, ec0, ec1, wa0, wa1, wb0, wb1;
    LD_E(ea0, ea1, t0) LD_A(wa0, wa1, t0) LD_E(eb0, eb1, t0 + 1)
    slice_load(bA, Vs, ea0, ea1);
#pragma unroll 1
    for (int i = 0; i < TPW; i += 2) { const int t = t0 + i; const int t2 = (i + 2 < TPW) ? t + 2 : t, t3 = (i + 3 < TPW) ? t + 3 : t;
        LD_E(ec0, ec1, t2) LD_A(wb0, wb1, t + 1)
        slice_load(bB, Vs, eb0, eb1);
        v5_token(bA, wa0, wa1, PO + (size_t)t * DM, SSQ + t, lane, stg);
        LD_E(eb0, eb1, t3) LD_A(wa0, wa1, t2)
        slice_load(bA, Vs, ec0, ec1);
        v5_token(bB, wb0, wb1, PO + (size_t)(t + 1) * DM, SSQ + t + 1, lane, stg);
    }
#undef LD_A
#undef LD_E
}
#ifndef LD_E
#define LD_E(dst0, dst1, t) { dst0 = *(const u32x4*)(Eh + (size_t)(t) * 128); dst1 = *(const u32x4*)(Eh + (size_t)(t) * 128 + 8); }
#endif
__device__ __forceinline__ void v_item(const Ctx& c, int s, int tb) {
    const unsigned short* EID = (const unsigned short*)(c.ws + WS_EID); const float* WW = (const float*)(c.ws + WS_WW);
    bf16* PO = (bf16*)(c.ws + WS_RA) + (V4_TABLE ? 256 : 128) * s; float* SSQ = (float*)(c.ws + WS_SSQ) + (size_t)s * ML;
    const int lane = c.lane, h = lane >> 3, cc = lane & 7;
    const unsigned char* Vs = c.ws + WS_RC + 96 * MiB + (size_t)s * (16384 * 128) + 16 * cc;
    const int t0 = tb * (8 * TPW) + c.wave * TPW;
    const unsigned short* Eh = EID + 16 * h; const float* Wh = WW + 16 * h;
#define LD_W(dst, t) { _Pragma("unroll") for (int j_ = 0; j_ < 4; ++j_) dst[j_] = *(const f32x4*)(Wh + (size_t)(t) * 128 + 4 * j_); }
    SliceBuf bA, bB; u32x4 ea0, ea1, eb0, eb1, ec0, ec1; f32x4 wa[4], wb[4];
    LD_E(ea0, ea1, t0) LD_W(wa, t0) LD_E(eb0, eb1, t0 + 1)
    slice_load(bA, Vs, ea0, ea1);
#pragma unroll 1
    for (int i = 0; i < TPW; i += 2) { const int t = t0 + i; const int t2 = (i + 2 < TPW) ? t + 2 : t, t3 = (i + 3 < TPW) ? t + 3 : t;
        LD_E(ec0, ec1, t2) LD_W(wb, t + 1)
        slice_load(bB, Vs, eb0, eb1);
        if (V4_TABLE) v4_token(bA, wa, PO + (size_t)t * DM, SSQ + t, lane); else v_token(bA, wa, PO + (size_t)t * DM, SSQ + t, lane);
        LD_E(eb0, eb1, t3) LD_W(wa, t2)
        slice_load(bA, Vs, ec0, ec1);
        if (V4_TABLE) v4_token(bB, wb, PO + (size_t)(t + 1) * DM, SSQ + t + 1, lane); else v_token(bB, wb, PO + (size_t)(t + 1) * DM, SSQ + t + 1, lane);
    }
#undef LD_W
#undef LD_E
}
__device__ __forceinline__ void reduce_range(const Ctx& c, int i0, int i1, int st);
__device__ __forceinline__ void final_range(const Ctx& c, int m0, int m1, int st, float* dst);
__device__ __forceinline__ void final_block(const Ctx& c, int m0, int nrows);
constexpr int CW_FINU = 10240, CW_FINV = 11264;
__device__ __forceinline__ bool arrive_last(unsigned* cnt, unsigned need, volatile LAS int* flag) {
    asm volatile("s_waitcnt vmcnt(0)" ::: "memory");
    __syncthreads();
    if (threadIdx.x == 0) {
        const unsigned old = __hip_atomic_fetch_add(cnt, 1u, __ATOMIC_RELAXED, __HIP_MEMORY_SCOPE_AGENT);
        const int last = (old == need - 1u);
        if (last) { __builtin_amdgcn_fence(__ATOMIC_ACQUIRE, "agent"); asm volatile("s_waitcnt vmcnt(0)" ::: "memory"); }
        *flag = last;
    }
    __syncthreads(); const int v = *flag; __syncthreads(); return v != 0;
}
template <int WHICH> __device__ __forceinline__ void slice_pass(const Ctx& c) {
    unsigned* ctr = (unsigned*)(c.ws + WS_CTL) + (WHICH == 0 ? CW_PEERU : CW_PEERV) + 32 * c.qsel;
    unsigned* fin = (unsigned*)(c.ws + WS_CTL) + (WHICH == 0 ? CW_FINU : CW_FINV) + 512 * c.qsel;
    volatile LAS int* slot = (volatile LAS int*)((LAS unsigned char*)c.lds + MISC_OFF + 64);
    const int xcc = (int)(xb_xcc_id() & 7u);
    constexpr int NS = ((WHICH == 0 && U4_TABLE) || (WHICH == 1 && V4_TABLE)) ? 4 : 8;
    for (int so = 0; so < NS; ++so) { const int s = (xcc + so) & (NS - 1);
        for (;;) { const int tb = grab_item(ctr + 64 * s, slot); if (tb >= NTB) break;
            if (WHICH == 0) { if (U4_TABLE) u4_item(c, s, tb); else u_item(c, s, tb); } else { if (V5_MFMA) v5_item(c, s, tb); else v_item(c, s, tb); }
            if (FUSE_TAIL) { if (arrive_last(fin + tb, (unsigned)NS, slot + 1)) {
                if (WHICH == 0) reduce_range(c, tb * (8 * TPW * 32) + c.tid, (tb + 1) * (8 * TPW * 32), 512);
                else final_block(c, tb * (8 * TPW), 8 * TPW); } } } }
}
__device__ __forceinline__ void phase10(const Ctx& c) { slice_pass<0>(c); }
__device__ __forceinline__ void reduce_range(const Ctx& c, int i0, int i1, int st) {
    const bf16* PD = (const bf16*)(c.ws + WS_RA); const float* GT = (const float*)(c.ws + WS_GT); float* WW = (float*)(c.ws + WS_WW);
    const float sc = U4_TABLE ? 1.f / (USCALE * XSCALE) : 1.f / (TSCALE * XSCALE);
#pragma unroll 4
    for (int idx = i0; idx < i1; idx += st) { const int t = idx >> 5, m = idx & 31, j = m >> 1, h0 = 4 * (m & 1);
        f32x4 s = {0.f, 0.f, 0.f, 0.f};
#pragma unroll
        for (int q = 0; q < (U4_TABLE ? 4 : 8); ++q) { const u32x2 w = ((const u32x2*)(PD + (size_t)q * ML * 128))[idx];
            s.x += __uint_as_float(w.x << 16); s.y += __uint_as_float(w.x & 0xffff0000u); s.z += __uint_as_float(w.y << 16); s.w += __uint_as_float(w.y & 0xffff0000u); }
        if (V5_MFMA) {
            float a[4], r[4];
#pragma unroll
            for (int e = 0; e < 4; ++e) a[e] = GT[(size_t)t * 128 + 16 * (h0 + e) + j] * gelu_tanh(s[e] * sc) * WSC;
            const unsigned hi = (unsigned)__builtin_amdgcn_cvt_pk_fp8_f32(a[2], a[3], __builtin_amdgcn_cvt_pk_fp8_f32(a[0], a[1], 0, false), true);
            const f32x2_t d0 = __builtin_amdgcn_cvt_pk_f32_fp8((int)hi, false), d1 = __builtin_amdgcn_cvt_pk_f32_fp8((int)hi, true);
            r[0] = (a[0] - d0.x) * WLO; r[1] = (a[1] - d0.y) * WLO; r[2] = (a[2] - d1.x) * WLO; r[3] = (a[3] - d1.y) * WLO;
            const unsigned lo = (unsigned)__builtin_amdgcn_cvt_pk_fp8_f32(r[2], r[3], __builtin_amdgcn_cvt_pk_fp8_f32(r[0], r[1], 0, false), true);
            unsigned char* wq = (unsigned char*)WW + (size_t)t * 256 + 32 * ((m >> 2) & 3) + 16 * (m >> 4) + 4 * (m & 3);
            *(unsigned*)wq = hi; *(unsigned*)(wq + 128) = lo;
        } else {
#pragma unroll
        for (int e = 0; e < 4; ++e) { const int k = 16 * (h0 + e) + j; WW[(size_t)t * 128 + k] = GT[(size_t)t * 128 + k] * gelu_tanh(s[e] * sc) * (V4_TABLE ? 1.f / USCALE : 1.f / TSCALE); } } }
}
__device__ __forceinline__ void phase11(const Ctx& c) { reduce_range(c, c.gtid, ML * 128 / 4, c.gsz); }
__device__ __forceinline__ void phase12(const Ctx& c) { slice_pass<1>(c); }
__device__ __forceinline__ void final_range(const Ctx& c, int m0, int m1, int st, float* dst = nullptr) {
    const bf16* PO = (const bf16*)(c.ws + WS_RA); const float* SSQ = (const float*)(c.ws + WS_SSQ); float* X1 = c.out; const bf16* X1b = (const bf16*)(c.ws + WS_X1); const float* MOD = (const float*)(c.ws + WS_MOD);
    const float* gpost = c.in[I_GPOSTFFN]; float* O = dst ? dst : X1;
    for (int m = m0; m < m1; m += 2 * st) {
        const int mb = (m + st < m1) ? m + st : m;
        float ssa = 0.f, ssb = 0.f; u32x2 pwa[4], pwb[4], xwa[4], xwb[4];
#pragma unroll
        for (int q = 0; q < (V4_TABLE ? 4 : 8); ++q) { ssa += SSQ[(size_t)q * ML + m]; ssb += SSQ[(size_t)q * ML + mb]; }
#pragma unroll
        for (int j = 0; j < 4; ++j) { const int col = 4 * c.lane + 256 * j;
            pwa[j] = *(const u32x2*)(PO + (size_t)m * DM + col); xwa[j] = *(const u32x2*)(X1b + (size_t)m * DM + col);
            pwb[j] = *(const u32x2*)(PO + (size_t)mb * DM + col); xwb[j] = *(const u32x2*)(X1b + (size_t)mb * DM + col); }
        const float rinva = rsqrtf(ssa * (1.f / DM) + EPS), rinvb = rsqrtf(ssb * (1.f / DM) + EPS);
        const float* gt2a = MOD + (m / SEQ) * NMOD + MOD_GT2; const float* gt2b = MOD + (mb / SEQ) * NMOD + MOD_GT2;
#pragma unroll
        for (int j = 0; j < 4; ++j) { const int col = 4 * c.lane + 256 * j;
            const f32x4 gg = *(const f32x4*)(gpost + col), gta = *(const f32x4*)(gt2a + col), gtb = *(const f32x4*)(gt2b + col);
            f32x4 po, xx;
            po.x = __uint_as_float(pwa[j].x << 16); po.y = __uint_as_float(pwa[j].x & 0xffff0000u); po.z = __uint_as_float(pwa[j].y << 16); po.w = __uint_as_float(pwa[j].y & 0xffff0000u);
            xx.x = __uint_as_float(xwa[j].x << 16); xx.y = __uint_as_float(xwa[j].x & 0xffff0000u); xx.z = __uint_as_float(xwa[j].y << 16); xx.w = __uint_as_float(xwa[j].y & 0xffff0000u);
            *(f32x4*)(O + (size_t)m * DM + col) = xx + gta * (po * rinva * gg);
            po.x = __uint_as_float(pwb[j].x << 16); po.y = __uint_as_float(pwb[j].x & 0xffff0000u); po.z = __uint_as_float(pwb[j].y << 16); po.w = __uint_as_float(pwb[j].y & 0xffff0000u);
            xx.x = __uint_as_float(xwb[j].x << 16); xx.y = __uint_as_float(xwb[j].x & 0xffff0000u); xx.z = __uint_as_float(xwb[j].y << 16); xx.w = __uint_as_float(xwb[j].y & 0xffff0000u);
            *(f32x4*)(O + (size_t)mb * DM + col) = xx + gtb * (po * rinvb * gg); }
    }
}
__device__ __forceinline__ void phase13(const Ctx& c) { if (PROBE_DBL == 13) final_range(c, c.gw, ML, c.ngw, (float*)(c.ws + WS_RB)); final_range(c, c.gw, ML, c.ngw); }
__device__ __forceinline__ void final_block(const Ctx& c, int m0, int nrows) {
    const bf16* PO = (const bf16*)(c.ws + WS_RA); const float* SSQ = (const float*)(c.ws + WS_SSQ); float* X1 = c.out; const float* MOD = (const float*)(c.ws + WS_MOD);
    const float* gpost = c.in[I_GPOSTFFN]; const float* gt2 = MOD + (m0 / SEQ) * NMOD + MOD_GT2;
    f32x4 gg[4];
#pragma unroll
    for (int j = 0; j < 4; ++j) { const int col = 4 * c.lane + 256 * j; gg[j] = *(const f32x4*)(gpost + col) * *(const f32x4*)(gt2 + col); }
    for (int r0 = c.wave; r0 < nrows; r0 += 32) {
        float ss[4]; u32x2 pw[4][4]; f32x4 xx[4][4];
#pragma unroll
        for (int r = 0; r < 4; ++r) { const int m = m0 + r0 + 8 * r; ss[r] = 0.f;
#pragma unroll
            for (int q = 0; q < (V4_TABLE ? 4 : 8); ++q) ss[r] += SSQ[(size_t)q * ML + m];
#pragma unroll
            for (int j = 0; j < 4; ++j) { const int col = 4 * c.lane + 256 * j; pw[r][j] = *(const u32x2*)(PO + (size_t)m * DM + col); xx[r][j] = *(const f32x4*)(X1 + (size_t)m * DM + col); } }
#pragma unroll
        for (int r = 0; r < 4; ++r) { const int m = m0 + r0 + 8 * r; const float rinv = rsqrtf(ss[r] * (1.f / DM) + EPS);
#pragma unroll
            for (int j = 0; j < 4; ++j) { const int col = 4 * c.lane + 256 * j; f32x4 po;
                po.x = __uint_as_float(pw[r][j].x << 16); po.y = __uint_as_float(pw[r][j].x & 0xffff0000u); po.z = __uint_as_float(pw[r][j].y << 16); po.w = __uint_as_float(pw[r][j].y & 0xffff0000u);
                *(f32x4*)(X1 + (size_t)m * DM + col) = xx[r][j] + gg[j] * (po * rinv); } }
    }
}

constexpr int NPHASE = SLICED_PEER ? (FUSE_TAIL ? 12 : 14) : 10;
__global__ void __launch_bounds__(512, 2) mega(Args args) {
    extern __shared__ __attribute__((aligned(16))) unsigned char lds[];
    Ctx c; c.in = args.in; c.out = args.out; c.ws = args.ws; c.lds = lds;
    c.tid = threadIdx.x; c.lane = c.tid & 63; c.wave = __builtin_amdgcn_readfirstlane(c.tid >> 6);
    c.qsel = 0; c.bid = blockIdx.x; c.nblk = gridDim.x; c.gw = c.bid * 8 + c.wave; c.ngw = c.nblk * 8; c.gtid = c.bid * 512 + c.tid; c.gsz = c.nblk * 512;
    volatile LAS unsigned* MISC = (volatile LAS unsigned*)((LAS unsigned char*)lds + MISC_OFF);
    if (c.tid < 32) MISC[c.tid] = 0u;
    __syncthreads();
    const int lo = args.ph_lo, hi = args.ph_hi;
    XcdBarrier bar; bar.bar = (unsigned*)(args.ws + WS_CTL) + CW_BAR; bar.x = 0; bar.st = nullptr;
    if (hi - lo > 1) bar = xcd_barrier_post((unsigned*)(args.ws + WS_CTL) + CW_BAR, MISC + 8);
#define PHASE(k, fn) if (lo <= (k) && (k) < hi) { if (PROBE_DBL == 5 && (k) == 5) { c.qsel = 1; fn(c); c.qsel = 0; xcd_barrier(bar); } fn(c); if (PROBE_DBL == (k) && (k) != 4 && (k) != 13 && (k) != 5) { xcd_barrier(bar); c.qsel = 1; fn(c); c.qsel = 0; } if ((k) + 1 < hi) { xcd_barrier(bar); if (PROBE_DBL == 99) xcd_barrier(bar); } }
    PHASE(0, phase0)
    PHASE(1, phase1)
    PHASE(2, phase2)
#if FAST_SSD
    PHASE(3, phase3f)
    PHASE(4, phase4f)
    PHASE(5, phase5f)
#else
    PHASE(3, phase3)
    PHASE(4, phase4)
    PHASE(5, phase5)
#endif
    PHASE(6, phase6)
    PHASE(7, phase7)
    PHASE(8, phase8)
    if (PROBE_DBL == 90 || PROBE_DBL == 91) { if (lo <= 8 && 8 < hi) { phase9_probe(c, PROBE_DBL == 90 ? 0x3ffu : 0x3fffu); xcd_barrier(bar); } }
#if SLICED_PEER && FUSE_TAIL
    PHASE(9, phase9s)
    PHASE(10, phase10)
    PHASE(11, phase12)
#elif SLICED_PEER
    PHASE(9, phase9s)
    PHASE(10, phase10)
    PHASE(11, phase11)
    PHASE(12, phase12)
    PHASE(13, phase13)
#else
    PHASE(9, phase9)
#endif
#undef PHASE
}

extern "C" void kernel_launch(void* const* d_in, const int* in_sizes, int n_in, void* d_out, int out_size, void* d_ws, size_t ws_size, hipStream_t stream) {
    static int grid = 0;
    if (grid == 0) {
        if (n_in != 24 || out_size != ML * DM || ws_size < WS_END) { fprintf(stderr, "kernel_launch: unexpected shapes n_in %d out %d ws %zu\n", n_in, out_size, ws_size); grid = -1; return; }
        int dev = 0, cus = 0;
        if (hipGetDevice(&dev) != hipSuccess || hipDeviceGetAttribute(&cus, hipDeviceAttributeMultiprocessorCount, dev) != hipSuccess) { grid = -1; return; }
        if (hipFuncSetAttribute((const void*)mega, hipFuncAttributeMaxDynamicSharedMemorySize, LDS_BYTES) != hipSuccess) { fprintf(stderr, "kernel_launch: hipFuncSetAttribute failed\n"); grid = -1; return; }
        int per_cu = 0;
        if (hipOccupancyMaxActiveBlocksPerMultiprocessor(&per_cu, (const void*)mega, 512, LDS_BYTES) != hipSuccess || per_cu < 1) fprintf(stderr, "kernel_launch: occupancy query says %d\n", per_cu);
        (void)hipGetLastError();
        grid = cus;
    }
    if (grid < 0) return;
    (void)hipMemsetAsync((char*)d_ws + WS_CTL, 0, CTL_ZERO_BYTES, stream);
    Args a{};
    for (int i = 0; i < 24; ++i) a.in[i] = (const float*)d_in[i];
    a.out = (float*)d_out; a.ws = (unsigned char*)d_ws;
#if N_LAUNCH_PER_PHASE
    for (int p = 0; p < NPHASE; ++p) { a.ph_lo = p; a.ph_hi = p + 1; hipLaunchKernelGGL(mega, dim3(grid), dim3(512), LDS_BYTES, stream, a); }
#else
    a.ph_lo = 0; a.ph_hi = NPHASE; hipLaunchKernelGGL(mega, dim3(grid), dim3(512), LDS_BYTES, stream, a);
#endif
}
```

```cpp
#include <hip/hip_runtime.h>
#include <cstdio>
#include <cstdint>

#define LAS __attribute__((address_space(3)))
typedef unsigned short bf16;
typedef float f32x4 __attribute__((ext_vector_type(4)));
typedef unsigned u32x4 __attribute__((ext_vector_type(4)));
typedef unsigned u32x2 __attribute__((ext_vector_type(2)));

#ifndef G2_WGM
#define G2_WGM 8
#endif
#ifndef G3_WGM
#define G3_WGM 8
#endif
#ifndef G1_WGM
#define G1_WGM 2
#endif
#ifndef U4_TABLE
#define U4_TABLE 1
#endif
#ifndef SLICED_PEER
#define SLICED_PEER 1
#endif
#ifndef PROBE_DBL
#define PROBE_DBL -1
#endif
#ifndef FAST_SSD
#define FAST_SSD 1
#endif
#ifndef N_LAUNCH_PER_PHASE
#define N_LAUNCH_PER_PHASE 0
#endif

constexpr int NB = 4, SEQ = 8192, DM = 1024, CTXL = 256;
constexpr int ML = NB * SEQ, MC = NB * CTXL, MT = ML + MC;
constexpr int N1 = 6400, NMOD = 6144;
constexpr int HEADS = 16, GROUPS = 4;
constexpr float EPS = 1e-6f;
constexpr float STSCALE = 64.f;
constexpr float XSCALE = 16.f;
constexpr float USCALE = 64.f;
#ifndef V4_TABLE
#define V4_TABLE 1
#endif
#ifndef V5_MFMA
#define V5_MFMA 1
#endif
#ifndef FP8_GEMM2
#define FP8_GEMM2 1
#endif
#ifndef TABLES_IN_SELECT
#define TABLES_IN_SELECT 0
#endif
#ifndef FP8_GEMM3
#define FP8_GEMM3 0
#endif
#ifndef FP8_GEMM1
#define FP8_GEMM1 1
#endif
#ifndef G1_ALIGN
#define G1_ALIGN true
#endif
#ifndef FP8_SP2
#define FP8_SP2 true
#endif
#ifndef FP8_TPL
#define FP8_TPL FP8_GEMM2
#endif
#ifndef FUSE_TAIL
#define FUSE_TAIL 0
#endif
constexpr float WSC = 256.f, WLO = 16.f;
constexpr float YSCALE = 16.f, WOSCALE = 64.f, HSCALE = 16.f, WISCALE = 64.f;
constexpr float TSCALE = 32.f;
constexpr int MOD_SH1 = 0, MOD_SC1 = 1024, MOD_GT1 = 2048, MOD_SH2 = 3072, MOD_SC2 = 4096, MOD_GT2 = 5120;

constexpr size_t MiB = 1u << 20;
constexpr size_t WS_CTL = 0, CTL_ZERO_BYTES = 64 * 1024;
constexpr size_t WS_MOD = 1 * MiB;
constexpr size_t WS_DEC = 1 * MiB + 512 * 1024;
constexpr size_t WS_HC = 2 * MiB;
constexpr size_t WS_WIN = 6 * MiB;
constexpr size_t WS_WOUT = 19 * MiB;
constexpr size_t WS_WQK = 23 * MiB;
constexpr size_t WS_DT = 27 * MiB;
constexpr size_t WS_RA = 32 * MiB;
constexpr size_t WS_RB = 160 * MiB;
constexpr size_t WS_RC = 292 * MiB;
constexpr size_t WS_RE = 420 * MiB;
constexpr size_t WS_END = 484 * MiB;
constexpr size_t WS_X1 = WS_RE;
constexpr int CW_BAR = 1024;

constexpr int LDS_BYTES = 147456;
constexpr int MISC_OFF = LDS_BYTES - 128;

__device__ __forceinline__ float bf2f(bf16 b) { return __uint_as_float(((unsigned)b) << 16); }
__device__ __forceinline__ bf16 f2bf(float f) { unsigned u = __float_as_uint(f); return (bf16)((u + 0x7fffu + ((u >> 16) & 1u)) >> 16); }
__device__ __forceinline__ unsigned pk2(float lo, float hi) { return (unsigned)f2bf(lo) | ((unsigned)f2bf(hi) << 16); }
__device__ __forceinline__ float silu_f(float x) { return x / (1.f + __expf(-x)); }
__device__ __forceinline__ float softplus_f(float x) { return x > 20.f ? x : log1pf(__expf(x)); }
__device__ __forceinline__ float gelu_tanh(float x) { const float u = 0.7978845608028654f * (x + 0.044715f * x * x * x); return 0.5f * x * (1.f + tanhf(u)); }
template <int CTRL> __device__ __forceinline__ float dpp_f(float v) { return __builtin_bit_cast(float, __builtin_amdgcn_update_dpp(0, __builtin_bit_cast(int, v), CTRL, 0xf, 0xf, true)); }
template <int CTRL> __device__ __forceinline__ unsigned dpp_u(unsigned v) { return (unsigned)__builtin_amdgcn_update_dpp(0, (int)v, CTRL, 0xf, 0xf, true); }
__device__ __forceinline__ float row16_sum(float v) { v += dpp_f<0xB1>(v); v += dpp_f<0x4E>(v); v += dpp_f<0x141>(v); v += dpp_f<0x140>(v); return v; }
__device__ __forceinline__ float wave_sum(float v) {
    v = row16_sum(v);
    { const unsigned u = __builtin_bit_cast(unsigned, v); auto r = __builtin_amdgcn_permlane16_swap(u, u, false, false); v = __builtin_bit_cast(float, (unsigned)r[0]) + __builtin_bit_cast(float, (unsigned)r[1]); }
    { const unsigned u = __builtin_bit_cast(unsigned, v); auto r = __builtin_amdgcn_permlane32_swap(u, u, false, false); v = __builtin_bit_cast(float, (unsigned)r[0]) + __builtin_bit_cast(float, (unsigned)r[1]); }
    return v;
}
__device__ __forceinline__ unsigned umax2(unsigned a, unsigned b) { return a > b ? a : b; }
__device__ __forceinline__ unsigned wave_umax(unsigned v) {
    v = umax2(v, dpp_u<0xB1>(v)); v = umax2(v, dpp_u<0x4E>(v)); v = umax2(v, dpp_u<0x141>(v)); v = umax2(v, dpp_u<0x140>(v));
    { auto r = __builtin_amdgcn_permlane16_swap(v, v, false, false); v = umax2((unsigned)r[0], (unsigned)r[1]); }
    { auto r = __builtin_amdgcn_permlane32_swap(v, v, false, false); v = umax2((unsigned)r[0], (unsigned)r[1]); }
    return v;
}

#define XB_TMO      128
#define XB_XCNT(j)  (256  + 64 * (j))
#define XB_XSUB(j)  (1280 + 64 * (j))
#define XB_XGEN(j)  (2304 + 64 * (j))
#define XB_TOP      3328
#define XB_TOPGEN   3392
#define XCD_BAR_WORDS 3456
#define XB_SPIN_CAP (1u << 22)
__device__ __forceinline__ unsigned xb_ld(unsigned* p)              { return __hip_atomic_load(p, __ATOMIC_RELAXED, __HIP_MEMORY_SCOPE_AGENT); }
__device__ __forceinline__ unsigned xb_add(unsigned* p, unsigned v) { return __hip_atomic_fetch_add(p, v, __ATOMIC_RELAXED, __HIP_MEMORY_SCOPE_AGENT); }
__device__ __forceinline__ unsigned xb_xcc_id() { return (unsigned)__builtin_amdgcn_s_getreg((3 << 11) | 20) & 0xFu; }
#define XB_SPIN(cond, bar) do { unsigned _sp = 0; while (cond) { __builtin_amdgcn_s_sleep(1); \
    if ((++_sp & 255u) == 0u) { if (xb_ld(&(bar)[XB_TMO])) break; if (_sp > XB_SPIN_CAP) { atomicAdd(&(bar)[XB_TMO], 1u); break; } } } } while (0)
struct XcdBarrier { unsigned* bar; unsigned x; volatile LAS unsigned* st; };
__device__ __forceinline__ XcdBarrier xcd_barrier_post(unsigned* bar, volatile LAS unsigned* st) {
    XcdBarrier b; b.bar = bar; b.x = xb_xcc_id(); b.st = st;
    if (threadIdx.x == 0) (void)xb_add(&bar[XB_XCNT(b.x)], 1u);
    return b;
}
__device__ __forceinline__ void xcd_barrier_complete(unsigned* bar, unsigned x, unsigned& nloc, unsigned& nx) {
    const unsigned G = gridDim.x * gridDim.y * gridDim.z;
    unsigned sum, cnt, mine, sp = 0u;
    for (;;) {
        sum = 0u; cnt = 0u; mine = 0u;
#pragma unroll
        for (unsigned j = 0; j < 16; ++j) { const unsigned c = xb_ld(&bar[XB_XCNT(j)]); sum += c; cnt += (c > 0u) ? 1u : 0u; mine = (j == x) ? c : mine; }
        if (sum == G) break;
        __builtin_amdgcn_s_sleep(1);
        if ((++sp & 255u) == 0u) { if (xb_ld(&bar[XB_TMO])) break; if (sp > XB_SPIN_CAP) { atomicAdd(&bar[XB_TMO], 1u); break; } }
    }
    nloc = mine > 0u ? mine : 1u; nx = cnt > 0u ? cnt : 1u;
}
__device__ __forceinline__ void xcd_barrier(const XcdBarrier& b) {
    asm volatile("s_waitcnt vmcnt(0)" ::: "memory");
    __syncthreads();
    if (threadIdx.x == 0) {
        unsigned* bar = b.bar;
        __builtin_amdgcn_s_waitcnt(0);
        unsigned nloc = b.st[0], nx = b.st[1];
        if (nloc == 0u) { xcd_barrier_complete(bar, b.x, nloc, nx); b.st[0] = nloc; b.st[1] = nx; }
        const unsigned old = xb_add(&bar[XB_XSUB(b.x)], 1u);
        const unsigned gen = old / nloc;
        if (old + 1u == (gen + 1u) * nloc) {
            __builtin_amdgcn_fence(__ATOMIC_RELEASE, "agent");
            asm volatile("s_waitcnt vmcnt(0)" ::: "memory");
            const unsigned og = xb_add(&bar[XB_TOP], 1u);
            const unsigned tg = og / nx;
            if (og + 1u == (tg + 1u) * nx) xb_add(&bar[XB_TOPGEN], 1u);
            else XB_SPIN(xb_ld(&bar[XB_TOPGEN]) == tg, bar);
            __builtin_amdgcn_fence(__ATOMIC_ACQUIRE, "agent");
            xb_add(&bar[XB_XGEN(b.x)], 1u);
            asm volatile("s_waitcnt vmcnt(0)" ::: "memory");
        } else {
            XB_SPIN(xb_ld(&bar[XB_XGEN(b.x)]) == gen, bar);
            __builtin_amdgcn_fence(__ATOMIC_ACQUIRE, "agent");
            asm volatile("s_waitcnt vmcnt(0)" ::: "memory");
        }
    }
    __syncthreads();
}

namespace pg8 {
#define PG8_LAS __attribute__((address_space(3)))
typedef unsigned short bf16_t;
typedef short bf16x8 __attribute__((ext_vector_type(8)));
typedef float f32x4 __attribute__((ext_vector_type(4)));
typedef unsigned u32x4 __attribute__((ext_vector_type(4)));
constexpr int BM = 256, BK = 64, HALF = 128, HTB = HALF * BK * 2  , STAGE_BYTES = 8 * HTB, NXCD = 8, WGM = 8;

__host__ __device__ __forceinline__ int lds_byte(int r, int c) { const int st = (r >> 4) * 2 + (c >> 5), rr = r & 15, cc = c & 31, ob = rr * 64 + cc * 2; return st * 1024 + (ob ^ (((ob >> 9) & 1) << 5)); }
__host__ __device__ __forceinline__ void stage_rc(int b, int& R, int& C) { const int st = b / 1024, sb = b % 1024, swz = sb ^ (((sb >> 9) & 1) << 5); R = (st >> 1) * 16 + swz / 64; C = (st & 1) * 32 + (swz % 64) / 2; }
__host__ __device__ __forceinline__ int perm32(int rho) { const int n = rho >> 4, i = rho & 15; return 8 * (i >> 2) + 4 * n + (i & 3); }

struct Unit { int pm, pn; };
struct Gemm { const bf16_t* A; const bf16_t* Bt; int M, N, K; };

struct StaticOrder {
    int nM, nN, nwg, G, c, wgm;
    __host__ __device__ void init(int M, int N, int G_, int c_, int wgm_ = WGM) { nM = M / BM; nN = N / BM; nwg = nM * nN; G = G_; c = c_; wgm = wgm_; }
    __host__ __device__ bool next(int i, Unit& u) const {
        const long L = (long)i * G + c; if (L >= nwg) return false;
        int wgid = (int)L; { const int q = nwg / NXCD, r = nwg % NXCD, xcd = wgid % NXCD, off = wgid / NXCD; wgid = (xcd < r ? xcd * (q + 1) : r * (q + 1) + (xcd - r) * q) + off; }
        const int nig = wgm * nN, gid = wgid / nig, fm = gid * wgm, gsz = (nM - fm) < wgm ? (nM - fm) : wgm;
        u.pm = fm + ((wgid % nig) % gsz); u.pn = (wgid % nig) / gsz; return true;
    }
    __device__ __forceinline__ void a_ready(const Unit&) const {}
    __device__ __forceinline__ void done(const Unit&) const {}
};

__device__ __forceinline__ unsigned cvt_pk_bf16(float lo, float hi) { unsigned r; asm volatile("v_cvt_pk_bf16_f32 %0, %1, %2" : "=v"(r) : "v"(lo), "v"(hi)); return r; }
template <class Epi, class Sched, bool ALIGN_EPI = false, bool SP2 = false, bool FP8 = false>
__device__ __forceinline__ void gemm_phase(PG8_LAS unsigned char* lds, const Gemm g, const Sched& S, const Epi& E) {
    const int tid = threadIdx.x, wid = __builtin_amdgcn_readfirstlane(tid >> 6), lane = tid & 63, wr = wid >> 2, wc = wid & 3, fr = lane & 15, fq = lane >> 4;
    const int K = g.K, nt = K / BK;
    unsigned voffA[2], voffB[2];
#pragma unroll
    for (int i = 0; i < 2; ++i) { int R, C; stage_rc(tid * 16 + i * 8192, R, C); const int Rb = Epi::PERM ? ((R & ~31) + perm32(R & 31)) : R;
        voffA[i] = (unsigned)(R * K + C) * 2u; voffB[i] = (unsigned)(Rb * K + C) * 2u; }
    const size_t kstep = (size_t)(BK * 2);
    const size_t hstep = (size_t)HALF * K * 2;
    const size_t tstep = 2 * hstep;
    const unsigned ldsw = (unsigned)wid * 1024u;
    const int aoff = lds_byte(wr * 64 + fr, fq * 8), boff = lds_byte(wc * 32 + fr, fq * 8);
#define PG8_SA(b, h) (((b) * 2 + (h)) * HTB)
#define PG8_SB(b, h) ((4 + (b) * 2 + (h)) * HTB)
#define PG8_STAGE(bufoff, gbase, voff) do { _Pragma("unroll") for (int _i = 0; _i < 2; ++_i) \
        __builtin_amdgcn_global_load_lds((const unsigned*)((const char*)(gbase) + (voff)[_i]), (PG8_LAS unsigned*)(lds + (bufoff) + ldsw + _i * 8192), 16, 0, 0); } while (0)
#define PG8_LDA(dst, b, h) do { _Pragma("unroll") for (int m = 0; m < 4; ++m) { if constexpr (FP8) { \
            const i32x4_ lo_ = *(const PG8_LAS i32x4_*)(lds + PG8_SA(b, h) + aoff + m * 2048), hi_ = *(const PG8_LAS i32x4_*)(lds + PG8_SA(b, h) + aoff + m * 2048 + 1024); \
            dst.wf[m] = __builtin_shufflevector(lo_, hi_, 0, 1, 2, 3, 4, 5, 6, 7); } \
        else { _Pragma("unroll") for (int k = 0; k < 2; ++k) dst.hf[m][k] = *(const PG8_LAS bf16x8*)(lds + PG8_SA(b, h) + aoff + m * 2048 + k * 1024); } } } while (0)
#define PG8_LDB(dst, b, h) do { _Pragma("unroll") for (int n = 0; n < 2; ++n) { if constexpr (FP8) { \
            const i32x4_ lo_ = *(const PG8_LAS i32x4_*)(lds + PG8_SB(b, h) + boff + n * 2048), hi_ = *(const PG8_LAS i32x4_*)(lds + PG8_SB(b, h) + boff + n * 2048 + 1024); \
            dst.wf[n] = __builtin_shufflevector(lo_, hi_, 0, 1, 2, 3, 4, 5, 6, 7); } \
        else { _Pragma("unroll") for (int k = 0; k < 2; ++k) dst.hf[n][k] = *(const PG8_LAS bf16x8*)(lds + PG8_SB(b, h) + boff + n * 2048 + k * 1024); } } } while (0)
#define PG8_MMA(ai, bj, At, Bt) do { __builtin_amdgcn_s_setprio(1); \
        if constexpr (FP8) { _Pragma("unroll") for (int m = 0; m < 4; ++m) _Pragma("unroll") for (int n = 0; n < 2; ++n) \
                asm volatile("v_mfma_scale_f32_16x16x128_f8f6f4 %0, %1, %2, %0, %3, %4 op_sel_hi:[0,0,0]" : "+v"(acc[ai][bj][m][n]) : "v"(Bt.wf[n]), "v"(At.wf[m]), "v"(scb_), "v"(sca_)); } \
        else { _Pragma("unroll") for (int m = 0; m < 4; ++m) _Pragma("unroll") for (int n = 0; n < 2; ++n) _Pragma("unroll") for (int k = 0; k < 2; ++k) \
            acc[ai][bj][m][n] = __builtin_amdgcn_mfma_f32_16x16x32_bf16(Bt.hf[n][k], At.hf[m][k], acc[ai][bj][m][n], 0, 0, 0); } \
        __builtin_amdgcn_s_setprio(0); } while (0)
#define PG8_WAIT_V(n) asm volatile("s_waitcnt vmcnt(" #n ")" ::: "memory")
#define PG8_WAIT_L(n) asm volatile("s_waitcnt lgkmcnt(" #n ")" ::: "memory")
#define PG8_BAR __builtin_amdgcn_s_barrier()
#define PG8_SCHED __builtin_amdgcn_sched_barrier(0)
    Unit cur, nxt; int ui = 0;
    if (!S.next(0, cur)) return;
    f32x4 acc[2][2][4][2];
#pragma unroll
    for (int a = 0; a < 2; ++a)
#pragma unroll
        for (int b = 0; b < 2; ++b)
#pragma unroll
            for (int m = 0; m < 4; ++m)
#pragma unroll
                for (int n = 0; n < 2; ++n) acc[a][b][m][n] = (f32x4){0.f, 0.f, 0.f, 0.f};
    typedef int i32x4_ __attribute__((ext_vector_type(4))); typedef int i32x8_ __attribute__((ext_vector_type(8)));
    struct FragA_ { bf16x8 hf[4][2]; i32x8_ wf[4]; }; struct FragB_ { bf16x8 hf[2][2]; i32x8_ wf[2]; };
    int sca_ = 127, scb_ = 127; if constexpr (FP8) { sca_ = Epi::SCA; scb_ = Epi::SCB; }
    FragA_ At; FragB_ B0, B1;
    const char* cA = (const char*)g.A + (size_t)cur.pm * tstep; const char* cB = (const char*)g.Bt + (size_t)cur.pn * tstep;
    S.a_ready(cur);
    if constexpr (SP2) {
        PG8_STAGE(PG8_SB(0, 0), cB, voffB); PG8_STAGE(PG8_SB(0, 1), cB + hstep, voffB); PG8_STAGE(PG8_SA(0, 0), cA, voffA); PG8_STAGE(PG8_SA(0, 1), cA + hstep, voffA);
        if (wr == 1) PG8_BAR;
        PG8_WAIT_V(2); PG8_BAR;
        PG8_STAGE(PG8_SB(1, 0), cB + kstep, voffB); PG8_STAGE(PG8_SA(1, 0), cA + kstep, voffA); PG8_STAGE(PG8_SB(1, 1), cB + hstep + kstep, voffB);
        PG8_WAIT_V(6); PG8_BAR;
    } else {
        PG8_STAGE(PG8_SB(0, 0), cB, voffB); PG8_STAGE(PG8_SA(0, 0), cA, voffA); PG8_STAGE(PG8_SB(0, 1), cB + hstep, voffB); PG8_STAGE(PG8_SA(0, 1), cA + hstep, voffA);
        if (wr == 1) PG8_BAR;
        PG8_WAIT_V(4); PG8_BAR;
        PG8_STAGE(PG8_SB(1, 0), cB + kstep, voffB); PG8_STAGE(PG8_SA(1, 0), cA + kstep, voffA); PG8_STAGE(PG8_SB(1, 1), cB + hstep + kstep, voffB);
        PG8_WAIT_V(6); PG8_BAR;
    }
    for (;;) {
        const bool has_next = S.next(ui + 1, nxt);
        const char* nA = has_next ? (const char*)g.A + (size_t)nxt.pm * tstep : cA; const char* nB = has_next ? (const char*)g.Bt + (size_t)nxt.pn * tstep : cB;
        for (int t = 0; t < nt; t += 2) {
            const bool last = (t == nt - 2);
            const char* a1 = cA + (size_t)(t + 1) * kstep;
            const char* a2 = last ? nA : cA + (size_t)(t + 2) * kstep; const char* b2 = last ? nB : cB + (size_t)(t + 2) * kstep;
            const char* a3 = a2 + kstep; const char* b3 = b2 + kstep;
            if (last && has_next) S.a_ready(nxt);
            if constexpr (SP2) {
            PG8_LDB(B0, 0, 0); PG8_LDB(B1, 0, 1); PG8_SCHED; PG8_LDA(At, 0, 0); PG8_STAGE(PG8_SA(1, 1), a1 + hstep, voffA);
            PG8_WAIT_V(8); PG8_WAIT_L(0); PG8_BAR; PG8_MMA(0, 0, At, B0); PG8_MMA(0, 1, At, B1); PG8_BAR; PG8_SCHED;
            PG8_LDA(At, 0, 1); PG8_STAGE(PG8_SB(0, 0), b2, voffB); PG8_STAGE(PG8_SB(0, 1), b2 + hstep, voffB); PG8_STAGE(PG8_SA(0, 0), a2, voffA);
            PG8_WAIT_V(8); PG8_WAIT_L(0); PG8_BAR; PG8_MMA(1, 0, At, B0); PG8_MMA(1, 1, At, B1); PG8_BAR; PG8_SCHED;
            PG8_LDB(B0, 1, 0); PG8_LDB(B1, 1, 1); PG8_SCHED; PG8_LDA(At, 1, 0); PG8_STAGE(PG8_SA(0, 1), a2 + hstep, voffA);
            PG8_WAIT_V(8); PG8_WAIT_L(0); PG8_BAR; PG8_MMA(0, 0, At, B0); PG8_MMA(0, 1, At, B1); PG8_BAR; PG8_SCHED;
            PG8_LDA(At, 1, 1); PG8_STAGE(PG8_SB(1, 0), b3, voffB); PG8_STAGE(PG8_SB(1, 1), b3 + hstep, voffB); PG8_STAGE(PG8_SA(1, 0), a3, voffA);
            PG8_WAIT_V(8); PG8_WAIT_L(0); PG8_BAR; PG8_MMA(1, 0, At, B0); PG8_MMA(1, 1, At, B1); PG8_BAR; PG8_SCHED;
            } else {
            PG8_LDB(B0, 0, 0); PG8_SCHED; PG8_LDA(At, 0, 0); PG8_STAGE(PG8_SA(1, 1), a1 + hstep, voffA);
            PG8_WAIT_L(8); PG8_BAR; PG8_WAIT_L(0); PG8_MMA(0, 0, At, B0); PG8_BAR; PG8_SCHED;
            PG8_LDB(B1, 0, 1); PG8_STAGE(PG8_SB(0, 0), b2, voffB);
            PG8_BAR; PG8_WAIT_L(0); PG8_MMA(0, 1, At, B1); PG8_BAR;
            PG8_LDA(At, 0, 1); PG8_STAGE(PG8_SA(0, 0), a2, voffA);
            PG8_BAR; PG8_WAIT_L(0); PG8_MMA(1, 0, At, B0); PG8_BAR; PG8_SCHED;
            PG8_STAGE(PG8_SB(0, 1), b2 + hstep, voffB);
            PG8_WAIT_V(6); PG8_BAR; PG8_MMA(1, 1, At, B1); PG8_BAR;
            PG8_LDB(B0, 1, 0); PG8_SCHED; PG8_LDA(At, 1, 0); PG8_STAGE(PG8_SA(0, 1), a2 + hstep, voffA);
            PG8_WAIT_L(8); PG8_BAR; PG8_WAIT_L(0); PG8_MMA(0, 0, At, B0); PG8_BAR; PG8_SCHED;
            PG8_LDB(B1, 1, 1); PG8_STAGE(PG8_SB(1, 0), b3, voffB);
            PG8_BAR; PG8_WAIT_L(0); PG8_MMA(0, 1, At, B1); PG8_BAR;
            PG8_LDA(At, 1, 1); PG8_STAGE(PG8_SA(1, 0), a3, voffA);
            PG8_BAR; PG8_WAIT_L(0); PG8_MMA(1, 0, At, B0); PG8_BAR; PG8_SCHED;
            PG8_STAGE(PG8_SB(1, 1), b3 + hstep, voffB);
            PG8_WAIT_V(6); PG8_BAR; PG8_MMA(1, 1, At, B1); PG8_BAR;
            }
        }
        if constexpr (ALIGN_EPI) { if (wr == 0) PG8_BAR; }
        if constexpr (FP8) asm volatile("s_nop 15\n\ts_nop 15" ::: "memory");
        if constexpr (!Epi::AFTER_DRAIN) { E(acc, cur, wr, wc, fr, fq); S.done(cur); }
        if (!has_next) break;
#pragma unroll
        for (int a = 0; a < 2; ++a)
#pragma unroll
            for (int b = 0; b < 2; ++b)
#pragma unroll
                for (int m = 0; m < 4; ++m)
#pragma unroll
                    for (int n = 0; n < 2; ++n) acc[a][b][m][n] = (f32x4){0.f, 0.f, 0.f, 0.f};
        cur = nxt; cA = nA; cB = nB; ++ui;
        if constexpr (ALIGN_EPI) { if (wr == 1) PG8_BAR; }
    }
    PG8_WAIT_V(0);
    if constexpr (!ALIGN_EPI) { if (wr == 0) PG8_BAR; }
    PG8_BAR;
    if constexpr (Epi::AFTER_DRAIN) { E.fused(acc, cur, wr, wc, fr, fq, lds, wid, lane); S.done(cur); }
#undef PG8_SA
#undef PG8_SB
#undef PG8_STAGE
#undef PG8_LDA
#undef PG8_LDB
#undef PG8_MMA
#undef PG8_WAIT_V
#undef PG8_WAIT_L
#undef PG8_BAR
#undef PG8_SCHED
}
}

struct Args { const float* in[24]; float* out; unsigned char* ws; int ph_lo, ph_hi; };
struct Ctx {
    const float* const* in; float* out; unsigned char* ws; unsigned char* lds;
    int tid, lane, wave, gw, ngw, gtid, gsz, bid, nblk, qsel;
};
enum { I_X = 0, I_C, I_CTX, I_CCTX, I_WADA, I_BADA, I_GPREMIX, I_GPOSTMIX, I_GPREFFN, I_GPOSTFFN, I_WIN, I_CONVW, I_CONVB, I_DTBIAS, I_ALOG, I_DSKIP,
       I_SSDNORMG, I_SCCONVW, I_SCNORMG, I_WOUT, I_WQ, I_KEYS, I_U, I_V };

__device__ __forceinline__ unsigned pk4_fp8(float a, float b, float c_, float d, float s) {
    a = fminf(fmaxf(a * s, -440.f), 440.f); b = fminf(fmaxf(b * s, -440.f), 440.f); c_ = fminf(fmaxf(c_ * s, -440.f), 440.f); d = fminf(fmaxf(d * s, -440.f), 440.f);
    return (unsigned)__builtin_amdgcn_cvt_pk_fp8_f32(c_, d, __builtin_amdgcn_cvt_pk_fp8_f32(a, b, 0, false), true);
}
__device__ __forceinline__ void transpose_item(const float* W, int K, int N, bf16* WT, int row_off, float* scr, int item, int lane) {
    const int nblk = N / 32, kb = item / nblk, nb = item % nblk, k0 = 64 * kb, n0 = 32 * nb;
#pragma unroll
    for (int i = 0; i < 8; ++i) { const int kk = 8 * i + (lane >> 3), c4 = (lane & 7) * 4; const f32x4 v = *(const f32x4*)(W + (size_t)(k0 + kk) * N + n0 + c4);
        float* d = scr + kk * 33 + c4; d[0] = v.x; d[1] = v.y; d[2] = v.z; d[3] = v.w; }
    asm volatile("s_waitcnt lgkmcnt(0)" ::: "memory");
    const int c = lane & 7;
#pragma unroll
    for (int j = 0; j < 4; ++j) { const int n = (lane >> 3) + 8 * j; const float* s = scr + (8 * c) * 33 + n;
        u32x4 o; o.x = pk2(s[0 * 33], s[1 * 33]); o.y = pk2(s[2 * 33], s[3 * 33]); o.z = pk2(s[4 * 33], s[5 * 33]); o.w = pk2(s[6 * 33], s[7 * 33]);
        *(u32x4*)(WT + (size_t)(row_off + n0 + n) * K + k0 + 8 * c) = o; }
    asm volatile("s_waitcnt lgkmcnt(0)" ::: "memory");
}

__device__ __forceinline__ void transpose_item_fp8(const float* W, int K, int N, unsigned char* WT, int row_off, float* scr, int item, int lane, float sc) {
    const int nblk = N / 32, kb = item / nblk, nb = item % nblk, k0 = 64 * kb, n0 = 32 * nb;
#pragma unroll
    for (int i = 0; i < 8; ++i) { const int kk = 8 * i + (lane >> 3), c4 = (lane & 7) * 4; const f32x4 v = *(const f32x4*)(W + (size_t)(k0 + kk) * N + n0 + c4);
        float* d = scr + kk * 33 + c4; d[0] = v.x; d[1] = v.y; d[2] = v.z; d[3] = v.w; }
    asm volatile("s_waitcnt lgkmcnt(0)" ::: "memory");
    const int c = lane & 7;
#pragma unroll
    for (int j = 0; j < 4; ++j) { const int n = (lane >> 3) + 8 * j; const float* s = scr + (8 * c) * 33 + n;
        u32x2 o;
        o.x = (unsigned)__builtin_amdgcn_cvt_pk_fp8_f32(s[2 * 33] * sc, s[3 * 33] * sc, __builtin_amdgcn_cvt_pk_fp8_f32(s[0 * 33] * sc, s[1 * 33] * sc, 0, false), true);
        o.y = (unsigned)__builtin_amdgcn_cvt_pk_fp8_f32(s[6 * 33] * sc, s[7 * 33] * sc, __builtin_amdgcn_cvt_pk_fp8_f32(s[4 * 33] * sc, s[5 * 33] * sc, 0, false), true);
        *(u32x2*)(WT + (size_t)(row_off + n0 + n) * K + k0 + 8 * c) = o; }
    asm volatile("s_waitcnt lgkmcnt(0)" ::: "memory");
}

__device__ __forceinline__ void phase0(const Ctx& c) {
    float* sct = (float*)c.lds;
    float* red = (float*)(c.lds + 20480);
    float* scr = (float*)(c.lds + 32768 + c.wave * 8704);
    const float* cvec = c.in[I_C]; const float* cctx = c.in[I_CCTX];
    for (int i = c.tid; i < 5 * 1024; i += 512) { const int v = i >> 10, k = i & 1023; const float x = v < 4 ? cvec[v * 1024 + k] : cctx[k]; sct[i] = silu_f(x); }
    __syncthreads();
    float* MOD = (float*)(c.ws + WS_MOD);
    const float* w_ada = c.in[I_WADA]; const float* b_ada = c.in[I_BADA];
    for (int item = c.bid; item < NMOD / 64; item += c.nblk) {
        const int j = item * 64 + c.lane; float acc[5] = {0.f, 0.f, 0.f, 0.f, 0.f};
        for (int k = c.wave * 128; k < c.wave * 128 + 128; ++k) { const float w = w_ada[(size_t)k * NMOD + j];
#pragma unroll
            for (int v = 0; v < 5; ++v) acc[v] += sct[v * 1024 + k] * w; }
#pragma unroll
        for (int v = 0; v < 5; ++v) red[(c.wave * 64 + c.lane) * 5 + v] = acc[v];
        __syncthreads();
        if (c.wave == 0) {
#pragma unroll
            for (int v = 0; v < 5; ++v) { float s = b_ada[j];
                for (int w8 = 0; w8 < 8; ++w8) s += red[(w8 * 64 + c.lane) * 5 + v];
                MOD[v * NMOD + j] = s; } }
        __syncthreads();
    }
    bf16* WinT = (bf16*)(c.ws + WS_WIN); bf16* WoutT = (bf16*)(c.ws + WS_WOUT); bf16* WqkT = (bf16*)(c.ws + WS_WQK);
    constexpr int NIN = 6176, I_IN = (1024 / 64) * (NIN / 32), I_OUT = (2048 / 64) * (1024 / 32);
    const bool split = c.nblk >= NMOD / 64 + 64; const int hb = split ? NMOD / 64 : 0;
    if (c.bid < hb) return;
    const int hgw = (c.bid - hb) * 8 + c.wave, hngw = (c.nblk - hb) * 8, hgtid = (c.bid - hb) * 512 + c.tid, hgsz = (c.nblk - hb) * 512;
    for (int it = hgw; it < I_IN + I_OUT; it += hngw) {
        if (it < I_IN) { const int nb = it % (NIN / 32); if (FP8_GEMM1) transpose_item_fp8(c.in[I_WIN], 1024, NIN, (unsigned char*)WinT, nb >= 97 ? 224 : 0, scr, it, c.lane, WISCALE); else transpose_item(c.in[I_WIN], 1024, NIN, WinT, nb >= 97 ? 224 : 0, scr, it, c.lane); }
        else if (FP8_GEMM2) transpose_item_fp8(c.in[I_WOUT], 2048, 1024, (unsigned char*)WoutT, 0, scr, it - I_IN, c.lane, WOSCALE);
        else transpose_item(c.in[I_WOUT], 2048, 1024, WoutT, 0, scr, it - I_IN, c.lane);
    }
    { u32x4* z = FP8_GEMM1 ? (u32x4*)((unsigned char*)WinT + (size_t)3104 * 1024) : (u32x4*)(WinT + (size_t)3104 * 1024); const u32x4 zz = {0u, 0u, 0u, 0u};
      for (int i = hgtid; i < 224 * 1024 / (FP8_GEMM1 ? 16 : 8); i += hgsz) z[i] = zz; }
    { typedef short bf16x8_l __attribute__((ext_vector_type(8)));
      const float* wq = c.in[I_WQ]; const float* keys = c.in[I_KEYS]; const int fr = c.lane & 15, fq = c.lane >> 4;
      for (int it = hgw; it < 16 * 64; it += hngw) { const int hp = it >> 6, kt = it & 63;
          bf16x8_l af[4];
#pragma unroll
          for (int ks = 0; ks < 4; ++ks) { const f32x4* a = (const f32x4*)(wq + (size_t)(16 * kt + fr) * 2048 + hp * 128 + 32 * ks + 8 * fq); const f32x4 a0 = a[0], a1 = a[1];
              u32x4 w; w.x = pk2(a0.x, a0.y); w.y = pk2(a0.z, a0.w); w.z = pk2(a1.x, a1.y); w.w = pk2(a1.z, a1.w); af[ks] = __builtin_bit_cast(bf16x8_l, w); }
#pragma unroll 2
          for (int nt = 0; nt < 8; ++nt) { f32x4 acc = {0.f, 0.f, 0.f, 0.f};
#pragma unroll
              for (int ks = 0; ks < 4; ++ks) { const f32x4* b = (const f32x4*)(keys + (size_t)(hp * 128 + 16 * nt + fr) * 128 + 32 * ks + 8 * fq); const f32x4 b0 = b[0], b1 = b[1];
                  u32x4 w; w.x = pk2(b0.x, b0.y); w.y = pk2(b0.z, b0.w); w.z = pk2(b1.x, b1.y); w.w = pk2(b1.z, b1.w);
                  acc = __builtin_amdgcn_mfma_f32_16x16x32_bf16(af[ks], __builtin_bit_cast(bf16x8_l, w), acc, 0, 0, 0); }
              if (FP8_GEMM3) *(unsigned*)((unsigned char*)WqkT + (size_t)(hp * 128 + 16 * nt + fr) * 1024 + 16 * kt + 4 * fq) = pk4_fp8(acc[0], acc[1], acc[2], acc[3], WISCALE);
              else { u32x2 o; o.x = pk2(acc[0], acc[1]); o.y = pk2(acc[2], acc[3]);
              *(u32x2*)(WqkT + (size_t)(hp * 128 + 16 * nt + fr) * 1024 + 16 * kt + 4 * fq) = o; } } } }
}

__device__ __forceinline__ void phase1(const Ctx& c) {
    bf16* H = (bf16*)c.out; const float* MOD = (const float*)(c.ws + WS_MOD); const float* g = c.in[I_GPREMIX];
    f32x4 xn[4];
#define P1_ROW(m_) ((m_) < ML ? c.in[I_X] + (size_t)(m_) * DM : c.in[I_CTX] + (size_t)((m_) - ML) * DM)
#define P1_LOAD(m_) { const f32x4* x4_ = (const f32x4*)P1_ROW(m_) + c.lane; _Pragma("unroll") for (int j = 0; j < 4; ++j) xn[j] = x4_[64 * j]; }
    if (c.gw < MT) P1_LOAD(c.gw)
    for (int m = c.gw; m < MT; m += c.ngw) {
        const int v = m < ML ? m / SEQ : 4;
        f32x4 xv[4]; float ss = 0.f;
#pragma unroll
        for (int j = 0; j < 4; ++j) { xv[j] = xn[j]; ss += xv[j].x * xv[j].x + xv[j].y * xv[j].y + xv[j].z * xv[j].z + xv[j].w * xv[j].w; }
        { const int mn = (m + c.ngw < MT) ? m + c.ngw : m; P1_LOAD(mn) }
        const float rinv = rsqrtf(wave_sum(ss) * (1.f / DM) + EPS);
        const float* mv = MOD + v * NMOD;
#pragma unroll
        for (int j = 0; j < 4; ++j) { const int col = 4 * c.lane + 256 * j;
            const f32x4 gg = *(const f32x4*)(g + col), sh = *(const f32x4*)(mv + MOD_SH1 + col), sc = *(const f32x4*)(mv + MOD_SC1 + col);
            const f32x4 y = (xv[j] * rinv * gg) * (1.f + sc) + sh;
            if (FP8_GEMM1) *(unsigned*)((unsigned char*)H + (size_t)m * DM + col) = pk4_fp8(y.x, y.y, y.z, y.w, HSCALE);
            else { u32x2 o; o.x = pk2(y.x, y.y); o.y = pk2(y.z, y.w);
            *(u32x2*)(H + (size_t)m * DM + col) = o; } }
    }
#undef P1_LOAD
#undef P1_ROW
}

template <class Epi>
__device__ __forceinline__ void naive_gemm(const Ctx& c, const bf16* A, const bf16* Bt, int M, int N, int K, const Epi& epi) {
    float* As = (float*)c.lds;
    float* Bs = (float*)(c.lds + 64 * 33 * 4);
    const int tn_count = N / 128, tiles = (M / 64) * tn_count;
    const int row = c.tid >> 3, cb = c.tid & 7;
    for (int tile = c.bid; tile < tiles; tile += c.nblk) {
        const int tm = tile / tn_count, tn = tile % tn_count;
        float acc[16];
#pragma unroll
        for (int j = 0; j < 16; ++j) acc[j] = 0.f;
        for (int k0 = 0; k0 < K; k0 += 32) {
            { const int r = c.tid >> 3, c4 = (c.tid & 7) * 4; const u32x2 v = *(const u32x2*)(A + (size_t)(tm * 64 + r) * K + k0 + c4);
              As[r * 33 + c4 + 0] = __uint_as_float(v.x << 16); As[r * 33 + c4 + 1] = __uint_as_float(v.x & 0xffff0000u);
              As[r * 33 + c4 + 2] = __uint_as_float(v.y << 16); As[r * 33 + c4 + 3] = __uint_as_float(v.y & 0xffff0000u); }
            { const int r = c.tid >> 2, c8 = (c.tid & 3) * 8; const u32x4 v = *(const u32x4*)(Bt + (size_t)(tn * 128 + r) * K + k0 + c8);
              float* d = Bs + r * 33 + c8;
              d[0] = __uint_as_float(v.x << 16); d[1] = __uint_as_float(v.x & 0xffff0000u); d[2] = __uint_as_float(v.y << 16); d[3] = __uint_as_float(v.y & 0xffff0000u);
              d[4] = __uint_as_float(v.z << 16); d[5] = __uint_as_float(v.z & 0xffff0000u); d[6] = __uint_as_float(v.w << 16); d[7] = __uint_as_float(v.w & 0xffff0000u); }
            __syncthreads();
#pragma unroll 8
            for (int kk = 0; kk < 32; ++kk) { const float a = As[row * 33 + kk];
#pragma unroll
                for (int j = 0; j < 16; ++j) acc[j] += a * Bs[(cb + 8 * j) * 33 + kk]; }
            __syncthreads();
        }
#pragma unroll
        for (int j = 0; j < 16; ++j) epi(tm * 64 + row, tn * 128 + cb + 8 * j, acc[j]);
    }
}


struct EpiG1 {
    static constexpr bool PERM = true, AFTER_DRAIN = false;
    static constexpr int SCA = 127 - 4, SCB = 127 - 6;
    bf16* ZG; bf16* XBC; float* DT; bf16* GCV; const float* dtb;
    __device__ __forceinline__ void operator()(const pg8::f32x4 (&acc)[2][2][4][2], const pg8::Unit& u, int wr, int wc, int fr, int fq) const {
        const int row0 = u.pm * 256 + wr * 64 + fr, pn = u.pn;
        if (pn == 12) {
            if (wc == 0) {
#pragma unroll
                for (int n = 0; n < 2; ++n) { const int col = 8 * fq + 4 * n; const f32x4 bv = *(const f32x4*)(dtb + col);
#pragma unroll
                    for (int ai = 0; ai < 2; ++ai)
#pragma unroll
                        for (int m = 0; m < 4; ++m) { const pg8::f32x4 v = acc[ai][0][m][n]; f32x4 o;
                            o.x = softplus_f(v[0] + bv.x); o.y = softplus_f(v[1] + bv.y); o.z = softplus_f(v[2] + bv.z); o.w = softplus_f(v[3] + bv.w);
                            *(f32x4*)(DT + (size_t)(row0 + ai * 128 + m * 16) * 32 + col) = o; } }
            }
            return;
        }
        const bool isx = (pn >= 4) & (pn < 12), isg = pn >= 17;
        const size_t boff = isx ? (WS_RB - WS_RA) : (isg ? (WS_RC - WS_RA) : (size_t)0);
        bf16* base = (bf16*)((unsigned char*)ZG + boff);
        const int colt = pn < 4 ? pn * 256 : (isx ? (pn - 4) * 256 : (isg ? (pn - 17) * 256 : 1024 + (pn - 13) * 256));
        if (!isx && u.pm >= 128) return;
        const int col0 = colt + wc * 32 + 8 * fq;
#pragma unroll
        for (int ai = 0; ai < 2; ++ai)
#pragma unroll
            for (int m = 0; m < 4; ++m) { bf16* rowp = base + (size_t)(row0 + ai * 128 + m * 16) * 2048 + col0;
#pragma unroll
                for (int bj = 0; bj < 2; ++bj) { const pg8::f32x4 v0 = acc[ai][bj][m][0], v1 = acc[ai][bj][m][1];
                    u32x4 w; w.x = pg8::cvt_pk_bf16(v0[0], v0[1]); w.y = pg8::cvt_pk_bf16(v0[2], v0[3]); w.z = pg8::cvt_pk_bf16(v1[0], v1[1]); w.w = pg8::cvt_pk_bf16(v1[2], v1[3]);
                    *(u32x4*)(rowp + bj * 128) = w; } }
    }
};
struct EpiPlainT {
    static constexpr bool PERM = true, AFTER_DRAIN = false;
    static constexpr int SCA = 127 - 4, SCB = 127 - 6;
    bf16* O; int ld;
    __device__ __forceinline__ void operator()(const pg8::f32x4 (&acc)[2][2][4][2], const pg8::Unit& u, int wr, int wc, int fr, int fq) const {
        const int row0 = u.pm * 256 + wr * 64 + fr, col0 = u.pn * 256 + wc * 32 + 8 * fq;
#pragma unroll
        for (int ai = 0; ai < 2; ++ai)
#pragma unroll
            for (int m = 0; m < 4; ++m) { bf16* rowp = O + (size_t)(row0 + ai * 128 + m * 16) * ld + col0;
#pragma unroll
                for (int bj = 0; bj < 2; ++bj) { const pg8::f32x4 v0 = acc[ai][bj][m][0], v1 = acc[ai][bj][m][1];
                    u32x4 w; w.x = pg8::cvt_pk_bf16(v0[0], v0[1]); w.y = pg8::cvt_pk_bf16(v0[2], v0[3]); w.z = pg8::cvt_pk_bf16(v1[0], v1[1]); w.w = pg8::cvt_pk_bf16(v1[2], v1[3]);
                    *(u32x4*)(rowp + bj * 128) = w; } }
    }
};
struct Order1 {
    pg8::StaticOrder so; int G, c;
    __device__ void init(int G_, int c_) { so.init(ML, N1, G_, c_, G1_WGM); G = G_; c = c_; }
    __device__ bool next(int i, pg8::Unit& u) const {
        const int L = i * G + c;
        if (L < 3200) return so.next(i, u);
        const int r = L - 3200; if (r >= 36) return false;
        u.pm = 128 + r / 9; u.pn = 4 + r % 9; return true;
    }
    __device__ __forceinline__ void a_ready(const pg8::Unit&) const {}
    __device__ __forceinline__ void done(const pg8::Unit&) const {}
};
struct Epi1 {
    bf16* ZG; bf16* XBC; float* DT; bf16* GCV; const float* dtb;
    __device__ __forceinline__ void operator()(int m, int n, float v) const {
        if (n < 1024) { if (m < ML) ZG[(size_t)m * 2048 + n] = f2bf(v); }
        else if (n < 3072) XBC[(size_t)m * 2048 + (n - 1024)] = f2bf(v);
        else if (n < 3104) DT[(size_t)m * 32 + (n - 3072)] = softplus_f(v + dtb[n - 3072]);
        else if (n < 3328) {}
        else if (n < 4352) { if (m < ML) ZG[(size_t)m * 2048 + 1024 + (n - 3328)] = f2bf(v); }
        else { if (m < ML) GCV[(size_t)m * 2048 + (n - 4352)] = f2bf(v); }
    }
};
struct EpiPlain { bf16* O; int ld; __device__ __forceinline__ void operator()(int m, int n, float v) const { O[(size_t)m * ld + n] = f2bf(v); } };

__device__ __forceinline__ void phase2(const Ctx& c) {
    EpiG1 e{(bf16*)(c.ws + WS_RA), (bf16*)(c.ws + WS_RB), (float*)(c.ws + WS_DT), (bf16*)(c.ws + WS_RC), c.in[I_DTBIAS]};
    pg8::Gemm g{(const bf16*)c.out, (const bf16*)(c.ws + WS_WIN), MT, N1, FP8_GEMM1 ? 512 : 1024};
    Order1 S; S.init(c.nblk, c.bid);
    pg8::gemm_phase<EpiG1, Order1, G1_ALIGN, true, FP8_GEMM1 != 0>((LAS unsigned char*)c.lds, g, S, e);
}

__device__ __forceinline__ void phase3(const Ctx& c) {
    bf16* XBC = (bf16*)(c.ws + WS_RB); const float* cw = c.in[I_CONVW]; const float* cbias = c.in[I_CONVB];
    for (int idx = c.gtid; idx < (ML / 64) * 2048; idx += c.gsz) {
        const int ch = idx & 2047, r64 = idx >> 11; bf16* base = XBC + (size_t)r64 * 64 * 2048 + ch;
        float u[64];
#pragma unroll
        for (int t = 0; t < 64; ++t) u[t] = bf2f(base[(size_t)t * 2048]);
        const float w0 = cw[ch], w1 = cw[2048 + ch], w2 = cw[4096 + ch], w3 = cw[6144 + ch], w4 = cw[8192 + ch], bb = cbias[ch];
#pragma unroll
        for (int t = 0; t < 64; ++t) {
            float o = bb + w2 * u[t];
            if (t >= 2) o += w0 * u[t - 2];
            if (t >= 1) o += w1 * u[t - 1];
            if (t <= 62) o += w3 * u[t + 1];
            if (t <= 61) o += w4 * u[t + 2];
            base[(size_t)t * 2048] = f2bf(silu_f(o));
        }
    }
    for (int idx = c.gtid; idx < NB * 2048; idx += c.gsz) {
        const int ch = idx & 2047, b = idx >> 11; bf16* base = XBC + (size_t)(ML + b * CTXL) * 2048 + ch;
        const float w0 = cw[ch], w1 = cw[2048 + ch], w2 = cw[4096 + ch], w3 = cw[6144 + ch], w4 = cw[8192 + ch], bb = cbias[ch];
        float um2 = 0.f, um1 = 0.f, u0 = bf2f(base[0]), up1 = bf2f(base[2048]), up2;
        for (int t = 0; t < CTXL; ++t) {
            up2 = (t + 2 < CTXL) ? bf2f(base[(size_t)(t + 2) * 2048]) : 0.f;
            const float o = bb + w0 * um2 + w1 * um1 + w2 * u0 + w3 * up1 + w4 * up2;
            base[(size_t)t * 2048] = f2bf(silu_f(o));
            um2 = um1; um1 = u0; u0 = up1; up1 = up2;
        }
    }
    { bf16* ZG = (bf16*)(c.ws + WS_RA); const bf16* GCV = (const bf16*)(c.ws + WS_RC); const float* sw = c.in[I_SCCONVW]; const float* sg = c.in[I_SCNORMG];
      for (int m = c.gw; m < ML; m += c.ngw) {
          const int pos = m & 63, ch0 = c.lane * 16;
          float acc[16];
#pragma unroll
          for (int j = 0; j < 16; ++j) acc[j] = 0.f;
#pragma unroll
          for (int k = 0; k < 3; ++k) { const int tt = pos + k - 1;
              if (tt >= 0 && tt < 64) { const bf16* gr = GCV + (size_t)(m + k - 1) * 2048 + ch0;
#pragma unroll
                  for (int j = 0; j < 16; ++j) acc[j] += sw[k * 1024 + ch0 + j] * (bf2f(gr[j]) * bf2f(gr[1024 + j])); } }
          bf16* gb = ZG + (size_t)m * 2048 + 1024 + ch0; float ss = 0.f;
#pragma unroll
          for (int j = 0; j < 16; ++j) { acc[j] *= bf2f(gb[j]); ss += acc[j] * acc[j]; }
          const float rinv = rsqrtf(wave_sum(ss) * (1.f / 1024.f) + EPS);
#pragma unroll
          for (int j = 0; j < 16; ++j) gb[j] = f2bf(acc[j] * rinv * sg[ch0 + j]);
      } }
    { f32x4* y = (f32x4*)c.out; const f32x4 z = {0.f, 0.f, 0.f, 0.f}; for (int i = c.gtid; i < ML * DM / 4; i += c.gsz) y[i] = z; }
}

__device__ __forceinline__ void phase4(const Ctx& c) {
    const bf16* XBC = (const bf16*)(c.ws + WS_RB); const float* DT = (const float*)(c.ws + WS_DT); float* Y = c.out;
    for (int idx = c.gtid; idx < 65536; idx += c.gsz) {
        const int nc = idx & 7, p = (idx >> 3) & 63, d = (idx >> 9) & 1, hd = (idx >> 10) & 15, b = idx >> 14, g = hd >> 2;
        const float A = -__expf(c.in[I_ALOG][d * 16 + hd]);
        float h[16];
#pragma unroll
        for (int j = 0; j < 16; ++j) h[j] = 0.f;
        for (int step = 0; step < CTXL + SEQ; ++step) {
            int row; bool lat = step >= CTXL;
            if (!lat) { const int t = d == 0 ? step : CTXL - 1 - step; row = ML + b * CTXL + t; }
            else { const int s2 = step - CTXL; const int t = d == 0 ? s2 : SEQ - 1 - s2; row = b * SEQ + t; }
            const float dt = DT[(size_t)row * 32 + d * 16 + hd]; const float dec = __expf(dt * A);
            const bf16* xr = XBC + (size_t)row * 2048;
            const float xv = bf2f(xr[hd * 64 + p]) * dt;
            const u32x4 b0 = *(const u32x4*)(xr + 1024 + g * 128 + nc * 16), b1 = *(const u32x4*)(xr + 1024 + g * 128 + nc * 16 + 8);
            const unsigned bw[8] = {b0.x, b0.y, b0.z, b0.w, b1.x, b1.y, b1.z, b1.w};
#pragma unroll
            for (int j = 0; j < 8; ++j) { h[2 * j] = h[2 * j] * dec + __uint_as_float(bw[j] << 16) * xv; h[2 * j + 1] = h[2 * j + 1] * dec + __uint_as_float(bw[j] & 0xffff0000u) * xv; }
            if (lat) {
                const u32x4 c0 = *(const u32x4*)(xr + 1536 + g * 128 + nc * 16), c1 = *(const u32x4*)(xr + 1536 + g * 128 + nc * 16 + 8);
                const unsigned cwv[8] = {c0.x, c0.y, c0.z, c0.w, c1.x, c1.y, c1.z, c1.w};
                float y = 0.f;
#pragma unroll
                for (int j = 0; j < 8; ++j) y += __uint_as_float(cwv[j] << 16) * h[2 * j] + __uint_as_float(cwv[j] & 0xffff0000u) * h[2 * j + 1];
                y += __shfl_xor(y, 1); y += __shfl_xor(y, 2); y += __shfl_xor(y, 4);
                if (nc == 0) atomicAdd(&Y[(size_t)row * 1024 + hd * 64 + p], y);
            }
        }
    }
}

__device__ __forceinline__ void phase5(const Ctx& c) {
    const bf16* XBC = (const bf16*)(c.ws + WS_RB); bf16* ZG = (bf16*)(c.ws + WS_RA); const float* Y = c.out;
    const float* dsk = c.in[I_DSKIP]; const float* ng = c.in[I_SSDNORMG];
    for (int it = c.gw; it < ML * 4; it += c.ngw) {
        const int m = it >> 2, g = it & 3, ch = g * 256 + c.lane * 4, hd = ch >> 6;
        const f32x4 yv = *(const f32x4*)(Y + (size_t)m * 1024 + ch);
        const u32x2 xw = *(const u32x2*)(XBC + (size_t)m * 2048 + ch), zw = *(const u32x2*)(ZG + (size_t)m * 2048 + ch);
        const float dk = dsk[hd];
        float y[4] = {yv.x, yv.y, yv.z, yv.w};
        const float xs[4] = {__uint_as_float(xw.x << 16), __uint_as_float(xw.x & 0xffff0000u), __uint_as_float(xw.y << 16), __uint_as_float(xw.y & 0xffff0000u)};
        const float zz[4] = {__uint_as_float(zw.x << 16), __uint_as_float(zw.x & 0xffff0000u), __uint_as_float(zw.y << 16), __uint_as_float(zw.y & 0xffff0000u)};
        float ss = 0.f;
#pragma unroll
        for (int j = 0; j < 4; ++j) { y[j] = (y[j] + dk * xs[j]) * silu_f(zz[j]); ss += y[j] * y[j]; }
        const float rinv = rsqrtf(wave_sum(ss) * (1.f / 256.f) + EPS);
        u32x2 o; o.x = pk2(y[0] * rinv * ng[ch], y[1] * rinv * ng[ch + 1]); o.y = pk2(y[2] * rinv * ng[ch + 2], y[3] * rinv * ng[ch + 3]);
        *(u32x2*)(ZG + (size_t)m * 2048 + ch) = o;
    }
}

typedef short bf16x8_t __attribute__((ext_vector_type(8)));
constexpr int XPITCH = 272;
__device__ __forceinline__ float fast_exp(float x) { return __expf(x); }
__device__ __forceinline__ float wave_scan_incl(float v, float& tot) {
    v += dpp_f<0x111>(v); v += dpp_f<0x112>(v); v += dpp_f<0x114>(v); v += dpp_f<0x118>(v);
    const float r0 = __builtin_bit_cast(float, __builtin_amdgcn_readlane(__builtin_bit_cast(int, v), 15));
    const float r1 = __builtin_bit_cast(float, __builtin_amdgcn_readlane(__builtin_bit_cast(int, v), 31));
    const float r2 = __builtin_bit_cast(float, __builtin_amdgcn_readlane(__builtin_bit_cast(int, v), 47));
    const float r3 = __builtin_bit_cast(float, __builtin_amdgcn_readlane(__builtin_bit_cast(int, v), 63));
    const int row = (int)(threadIdx.x & 63) >> 4;
    const float add = row == 0 ? 0.f : (row == 1 ? r0 : (row == 2 ? r0 + r1 : r0 + r1 + r2));
    tot = r0 + r1 + r2 + r3;
    return v + add;
}
__device__ __forceinline__ void unpack8(const u32x4& w, float* f) {
    f[0] = __uint_as_float(w.x << 16); f[1] = __uint_as_float(w.x & 0xffff0000u); f[2] = __uint_as_float(w.y << 16); f[3] = __uint_as_float(w.y & 0xffff0000u);
    f[4] = __uint_as_float(w.z << 16); f[5] = __uint_as_float(w.z & 0xffff0000u); f[6] = __uint_as_float(w.w << 16); f[7] = __uint_as_float(w.w & 0xffff0000u);
}
template <int J> __device__ __forceinline__ float row_elem(const u32x4& w) {
    const unsigned v = (J >> 1) == 0 ? w.x : ((J >> 1) == 1 ? w.y : ((J >> 1) == 2 ? w.z : w.w));
    return (J & 1) ? __uint_as_float(v & 0xffff0000u) : __uint_as_float(v << 16);
}
template <int J> __device__ __forceinline__ u32x4 conv_chan(const u32x4* rows, const float* cw, const float* cb, int chcol) {
    const float w0 = cw[chcol + J], w1 = cw[2048 + chcol + J], w2 = cw[4096 + chcol + J], w3 = cw[6144 + chcol + J], w4 = cw[8192 + chcol + J], bb = cb[chcol + J];
    float x[12];
#pragma unroll
    for (int i = 0; i < 12; ++i) x[i] = row_elem<J>(rows[i]);
    float o[8];
#pragma unroll
    for (int t = 0; t < 8; ++t) o[t] = silu_f(bb + w0 * x[t] + w1 * x[t + 1] + w2 * x[t + 2] + w3 * x[t + 3] + w4 * x[t + 4]);
    u32x4 q; q.x = pk2(o[0], o[1]); q.y = pk2(o[2], o[3]); q.z = pk2(o[4], o[5]); q.w = pk2(o[6], o[7]); return q;
}
__device__ __forceinline__ void conv_unit(const u32x4* rows, const float* cw, const float* cb, int chcol, u32x4* out) {
    out[0] = conv_chan<0>(rows, cw, cb, chcol); out[1] = conv_chan<1>(rows, cw, cb, chcol); out[2] = conv_chan<2>(rows, cw, cb, chcol); out[3] = conv_chan<3>(rows, cw, cb, chcol);
    out[4] = conv_chan<4>(rows, cw, cb, chcol); out[5] = conv_chan<5>(rows, cw, cb, chcol); out[6] = conv_chan<6>(rows, cw, cb, chcol); out[7] = conv_chan<7>(rows, cw, cb, chcol);
}


__device__ __forceinline__ void un4_fp8(unsigned w, float* f) {
    typedef float f32x2_u __attribute__((ext_vector_type(2)));
    const f32x2_u lo = __builtin_amdgcn_cvt_pk_f32_fp8((int)w, false), hi = __builtin_amdgcn_cvt_pk_f32_fp8((int)w, true);
    f[0] = lo.x; f[1] = lo.y; f[2] = hi.x; f[3] = hi.y;
}
__device__ __forceinline__ void s1_item(const Ctx& c, int b, int cc, int g) {
    LAS unsigned char* L = (LAS unsigned char*)c.lds;
    LAS unsigned char* XT = L;
    LAS unsigned char* BT = L + 256 * XPITCH;
    LAS float* WT = (LAS float*)(L + 384 * XPITCH);
    const bf16* XBC = (const bf16*)(c.ws + WS_RB); const float* DT = (const float*)(c.ws + WS_DT);
    const bool isctx = cc < 2;
    const int seq0 = isctx ? ML + b * CTXL : b * SEQ;
    const int t0c = isctx ? cc * 128 : (cc - 2) * 128;
    const int tid = c.tid, lane = c.lane, w = c.wave;
    { const int d = w >> 2, r = w & 3, hd = g * 4 + r;
      const float A = -__expf(c.in[I_ALOG][d * 16 + hd]);
      const float dt0 = DT[(size_t)(seq0 + t0c + lane) * 32 + d * 16 + hd], dt1 = DT[(size_t)(seq0 + t0c + 64 + lane) * 32 + d * 16 + hd];
      const float a0 = dt0 * A, a1 = dt1 * A; float tot0, tot1;
      const float P0 = wave_scan_incl(a0, tot0); const float P1 = wave_scan_incl(a1, tot1) + tot0; const float Ptot = tot0 + tot1;
      float w0, w1;
      if (d == 0) { w0 = dt0 * fast_exp(Ptot - P0); w1 = dt1 * fast_exp(Ptot - P1); }
      else { w0 = dt0 * fast_exp(P0 - a0); w1 = dt1 * fast_exp(P1 - a1); }
      WT[w * 128 + lane] = w0; WT[w * 128 + 64 + lane] = w1;
      if (lane == 0) ((float*)(c.ws + WS_DEC))[((b * 66 + cc) * 16 + hd) * 2 + d] = fast_exp(Ptot); }
    { const int sg = tid & 15, q = tid >> 4;
      const int tok0 = sg * 8;
      int lo, hi;
      if (isctx) { lo = -t0c; hi = CTXL - t0c; } else { lo = tok0 & ~63; hi = lo + 64; }
#pragma unroll 1
      for (int pass = 0; pass < 2; ++pass) {
          if (pass == 1 && q >= 16) break;
          const int chcol = pass == 0 ? g * 256 + 8 * q : 1024 + g * 128 + 8 * q;
          u32x4 rows[12];
#pragma unroll
          for (int i = 0; i < 12; ++i) { const int t = tok0 - 2 + i; const u32x4 z = {0u, 0u, 0u, 0u};
              rows[i] = (t >= lo && t < hi) ? *(const u32x4*)(XBC + (size_t)(seq0 + t0c + t) * 2048 + chcol) : z; }
          u32x4 outp[8];
          conv_unit(rows, c.in[I_CONVW], c.in[I_CONVB], chcol, outp);
          LAS unsigned char* dst = (pass == 0 ? XT + (8 * q) * XPITCH : BT + (8 * q) * XPITCH) + sg * 16;
#pragma unroll
          for (int j = 0; j < 8; ++j) *(LAS u32x4*)(dst + j * XPITCH) = outp[j];
          if (pass == 0 && !isctx) { bf16* xg = (bf16*)(c.ws + WS_RE) + ((size_t)((b * 64 + (cc - 2)) * 4 + g) * 256 + 8 * q) * 128 + tok0;
#pragma unroll
              for (int j = 0; j < 8; ++j) *(u32x4*)(xg + j * 128) = outp[j]; }
      } }
    __syncthreads();
    { const int fr = lane & 15, fq = lane >> 4;
      unsigned char* stbase = isctx ? c.ws + WS_HC + (size_t)((b * 2 + cc) * 16) * 2 * 8192 : (unsigned char*)c.out + (size_t)((b * 64 + (cc - 2)) * 16) * 2 * 8192;
#pragma unroll 1
      for (int dr = 0; dr < 8; ++dr) { const int d = dr >> 2, r = dr & 3, hd = g * 4 + r;
          f32x4 acc[4];
#pragma unroll
          for (int pt = 0; pt < 4; ++pt) acc[pt] = (f32x4){0.f, 0.f, 0.f, 0.f};
#pragma unroll
          for (int ks = 0; ks < 4; ++ks) {
              const u32x4 araw = *(const LAS u32x4*)(BT + (16 * w + fr) * XPITCH + (32 * ks + 8 * fq) * 2);
              const f32x4 wl = *(const LAS f32x4*)(WT + dr * 128 + 32 * ks + 8 * fq), wh = *(const LAS f32x4*)(WT + dr * 128 + 32 * ks + 8 * fq + 4);
              float af[8]; unpack8(araw, af);
              u32x4 as; as.x = pk2(af[0] * wl.x, af[1] * wl.y); as.y = pk2(af[2] * wl.z, af[3] * wl.w); as.z = pk2(af[4] * wh.x, af[5] * wh.y); as.w = pk2(af[6] * wh.z, af[7] * wh.w);
              const bf16x8_t afrag = __builtin_bit_cast(bf16x8_t, as);
#pragma unroll
              for (int pt = 0; pt < 4; ++pt) { const bf16x8_t bfrag = *(const LAS bf16x8_t*)(XT + (r * 64 + 16 * pt + fr) * XPITCH + (32 * ks + 8 * fq) * 2);
                  acc[pt] = __builtin_amdgcn_mfma_f32_16x16x32_bf16(afrag, bfrag, acc[pt], 0, 0, 0); }
          }
          unsigned char* dst = stbase + (size_t)(hd * 2 + d) * 8192;
#pragma unroll
          for (int pt = 0; pt < 4; ++pt) *(unsigned*)(dst + (16 * pt + fr) * 128 + 16 * w + 4 * fq) = pk4_fp8(acc[pt][0], acc[pt][1], acc[pt][2], acc[pt][3], STSCALE);
      } }
    __syncthreads();
}

__device__ __forceinline__ void shortconv_row(const Ctx& c, int row64) {
    bf16* ZG = (bf16*)(c.ws + WS_RA); const bf16* GCV = (const bf16*)(c.ws + WS_RC); const float* sw = c.in[I_SCCONVW]; const float* sg = c.in[I_SCNORMG];
    const int p0 = c.wave * 8, ch0 = c.lane * 16; const size_t mbase = (size_t)row64 * 64;
    float w0[16], w1[16], w2[16], gn[16];
#pragma unroll
    for (int j = 0; j < 16; j += 4) { const f32x4 a = *(const f32x4*)(sw + ch0 + j), b = *(const f32x4*)(sw + 1024 + ch0 + j), d = *(const f32x4*)(sw + 2048 + ch0 + j), e = *(const f32x4*)(sg + ch0 + j);
        w0[j] = a.x; w0[j + 1] = a.y; w0[j + 2] = a.z; w0[j + 3] = a.w; w1[j] = b.x; w1[j + 1] = b.y; w1[j + 2] = b.z; w1[j + 3] = b.w;
        w2[j] = d.x; w2[j + 1] = d.y; w2[j + 2] = d.z; w2[j + 3] = d.w; gn[j] = e.x; gn[j + 1] = e.y; gn[j + 2] = e.z; gn[j + 3] = e.w; }
#define SC_LOAD(dst, tt_) { const int t_ = (tt_) < 0 ? 0 : ((tt_) > 63 ? 63 : (tt_)); const bf16* gr = GCV + (mbase + t_) * 2048 + ch0; \
        dst[0] = *(const u32x4*)gr; dst[1] = *(const u32x4*)(gr + 8); dst[2] = *(const u32x4*)(gr + 1024); dst[3] = *(const u32x4*)(gr + 1032); }
#define SC_PROD(dst, raw, tt_) { float gf[16], vf[16]; unpack8(raw[0], gf); unpack8(raw[1], gf + 8); unpack8(raw[2], vf); unpack8(raw[3], vf + 8); \
        const float ok_ = ((tt_) >= 0 && (tt_) < 64) ? 1.f : 0.f; _Pragma("unroll") for (int j = 0; j < 16; ++j) dst[j] = gf[j] * vf[j] * ok_; }
    u32x4 ra[4], rb[4], gbr[2], gbn[2];
    float pm[16], pc[16], pn[16];
    SC_LOAD(ra, p0 - 1) SC_LOAD(rb, p0)
    SC_PROD(pm, ra, p0 - 1) SC_PROD(pc, rb, p0)
    SC_LOAD(ra, p0 + 1)
    { const bf16* gb = ZG + (mbase + p0) * 2048 + 1024 + ch0; gbr[0] = *(const u32x4*)gb; gbr[1] = *(const u32x4*)(gb + 8); }
#pragma unroll 1
    for (int i = 0; i < 8; ++i) { const int pos = p0 + i;
        SC_PROD(pn, ra, pos + 1)
        SC_LOAD(ra, pos + 2)
        { const int pq = (i < 7) ? pos + 1 : pos; const bf16* gb = ZG + (mbase + pq) * 2048 + 1024 + ch0; gbn[0] = *(const u32x4*)gb; gbn[1] = *(const u32x4*)(gb + 8); }
        float acc[16], bf[16]; unpack8(gbr[0], bf); unpack8(gbr[1], bf + 8); float ss = 0.f;
#pragma unroll
        for (int j = 0; j < 16; ++j) { acc[j] = (w0[j] * pm[j] + w1[j] * pc[j] + w2[j] * pn[j]) * bf[j]; ss += acc[j] * acc[j]; }
        const float rinv = rsqrtf(wave_sum(ss) * (1.f / 1024.f) + EPS);
        u32x4 o0, o1;
        o0.x = pk2(acc[0] * rinv * gn[0], acc[1] * rinv * gn[1]); o0.y = pk2(acc[2] * rinv * gn[2], acc[3] * rinv * gn[3]);
        o0.z = pk2(acc[4] * rinv * gn[4], acc[5] * rinv * gn[5]); o0.w = pk2(acc[6] * rinv * gn[6], acc[7] * rinv * gn[7]);
        o1.x = pk2(acc[8] * rinv * gn[8], acc[9] * rinv * gn[9]); o1.y = pk2(acc[10] * rinv * gn[10], acc[11] * rinv * gn[11]);
        o1.z = pk2(acc[12] * rinv * gn[12], acc[13] * rinv * gn[13]); o1.w = pk2(acc[14] * rinv * gn[14], acc[15] * rinv * gn[15]);
        if (FP8_GEMM2) { float y[16];
#pragma unroll
            for (int j = 0; j < 16; ++j) y[j] = acc[j] * rinv * gn[j] * YSCALE;
            u32x4 o;
            o.x = pk4_fp8(y[0], y[1], y[2], y[3], 1.f); o.y = pk4_fp8(y[4], y[5], y[6], y[7], 1.f); o.z = pk4_fp8(y[8], y[9], y[10], y[11], 1.f); o.w = pk4_fp8(y[12], y[13], y[14], y[15], 1.f);
            *(u32x4*)((unsigned char*)c.out + 64 * MiB + (mbase + pos) * 2048 + 1024 + ch0) = o;
        } else {
        bf16* gb = ZG + (mbase + pos) * 2048 + 1024 + ch0;
        *(u32x4*)gb = o0; *(u32x4*)(gb + 8) = o1; }
#pragma unroll
        for (int j = 0; j < 16; ++j) { pm[j] = pc[j]; pc[j] = pn[j]; }
        gbr[0] = gbn[0]; gbr[1] = gbn[1];
    }
#undef SC_LOAD
#undef SC_PROD
}

__device__ __forceinline__ void phase3f(const Ctx& c) {
    constexpr int NS1 = NB * 66 * 4;
    const int nx = NS1 % c.nblk, slot = (c.bid >> 3) & 3;
    int k = 0;
    for (int it = c.bid; it < NS1; it += c.nblk, ++k) { const int g = it & 3, t = it >> 2, cc = t % 66, b = t / 66; s1_item(c, b, cc, g); if (PROBE_DBL == 30) s1_item(c, b, cc, g);
        if (k == slot && c.bid >= nx) for (int j = c.bid - nx; j < ML / 64; j += c.nblk - nx) { shortconv_row(c, j); if (PROBE_DBL == 31) shortconv_row(c, j); } }
}

__device__ __forceinline__ void phase4f_(const Ctx& c, size_t woff) {
    unsigned char* ST = (unsigned char*)c.out; const unsigned char* STC = c.ws + WS_HC; const float* DEC = (const float*)(c.ws + WS_DEC);
    for (int idx = c.gtid; idx < NB * 16 * 2 * 64 * 16; idx += c.gsz) {
        const int n8 = idx & 15, p = (idx >> 4) & 63, d = (idx >> 10) & 1, hd = (idx >> 11) & 15, b = idx >> 15;
        const size_t inner = (size_t)((hd * 2 + d) * 64 + p) * 128 + n8 * 8;
        float h[8];
#pragma unroll
        for (int j = 0; j < 8; ++j) h[j] = 0.f;
#pragma unroll
        for (int s = 0; s < 2; ++s) { const int cc = d == 0 ? s : 1 - s;
            const float dec = DEC[((b * 66 + cc) * 16 + hd) * 2 + d];
            const u32x2 sv = *(const u32x2*)(STC + (size_t)(b * 2 + cc) * 16 * 2 * 8192 + inner); float sf[8]; un4_fp8(sv.x, sf); un4_fp8(sv.y, sf + 4);
#pragma unroll
            for (int j = 0; j < 8; ++j) h[j] = h[j] * dec + sf[j]; }
#pragma unroll 4
        for (int s = 0; s < 64; ++s) { const int cl = d == 0 ? s : 63 - s;
            const float dec = DEC[((b * 66 + 2 + cl) * 16 + hd) * 2 + d];
            unsigned char* ptr = ST + (size_t)(b * 64 + cl) * 16 * 2 * 8192 + inner;
            const u32x2 sv = *(const u32x2*)ptr; float sf[8]; un4_fp8(sv.x, sf); un4_fp8(sv.y, sf + 4);
            u32x2 o; o.x = pk4_fp8(h[0], h[1], h[2], h[3], 1.f); o.y = pk4_fp8(h[4], h[5], h[6], h[7], 1.f);
            *(u32x2*)(ptr + woff) = o;
#pragma unroll
            for (int j = 0; j < 8; ++j) h[j] = h[j] * dec + sf[j]; }
    }
}

__device__ __forceinline__ void phase4f(const Ctx& c) {
    if (PROBE_DBL == 4) phase4f_(c, (size_t)((c.ws + WS_RC) - (unsigned char*)c.out));
    phase4f_(c, 0);
}

__device__ __forceinline__ void s3_item(const Ctx& c, int b, int cl, int g, size_t zoff = 0) {
    LAS unsigned char* L = (LAS unsigned char*)c.lds;
    LAS unsigned char* CM = L;
    LAS unsigned char* BM = L + 128 * XPITCH;
    LAS unsigned char* XT = L + 256 * XPITCH;
    LAS float* TB = (LAS float*)(L + 256 * XPITCH + 65536);
    const bf16* XBC = (const bf16*)(c.ws + WS_RB); const float* DT = (const float*)(c.ws + WS_DT);
    const int tid = c.tid, lane = c.lane, w = c.wave, fr = lane & 15, fq = lane >> 4;
    const int m0 = b * SEQ + cl * 128;
    { const int d = w >> 2, r = w & 3, hd = g * 4 + r;
      const float A = -__expf(c.in[I_ALOG][d * 16 + hd]);
      const float dt0 = DT[(size_t)(m0 + lane) * 32 + d * 16 + hd], dt1 = DT[(size_t)(m0 + 64 + lane) * 32 + d * 16 + hd];
      const float a0 = dt0 * A * 1.44269504f, a1 = dt1 * A * 1.44269504f; float tot0, tot1;
      const float P0 = wave_scan_incl(a0, tot0); const float P1 = wave_scan_incl(a1, tot1) + tot0;
      LAS float* t = TB + r * 512 + d * 256;
      if (d == 0) { t[lane] = P0; t[64 + lane] = P1; } else { t[lane] = P0 - a0; t[64 + lane] = P1 - a1; }
      t[128 + lane] = dt0; t[128 + 64 + lane] = dt1;
      if (d == 1 && lane == 0) TB[2048 + r] = tot0 + tot1;
    }
#pragma unroll 1
    for (int rep_ = 0; rep_ < (PROBE_DBL == 55 ? 2 : 1); ++rep_)
    { const int sg = tid & 15, q = tid >> 4, tok0 = sg * 8;
      const int lo = tok0 & ~63, hi = lo + 64;
      const int chcol = q < 16 ? 1024 + g * 128 + 8 * q : 1536 + g * 128 + 8 * (q - 16);
      u32x4 rows[12];
#pragma unroll
      for (int i = 0; i < 12; ++i) { const int t = tok0 - 2 + i; const u32x4 z = {0u, 0u, 0u, 0u};
          rows[i] = (t >= lo && t < hi) ? *(const u32x4*)(XBC + (size_t)(m0 + t) * 2048 + chcol) : z; }
      u32x4 outp[8];
      conv_unit(rows, c.in[I_CONVW], c.in[I_CONVB], chcol, outp);
      LAS unsigned char* dst = (q < 16 ? BM + (8 * q) * 2 : CM + (8 * (q - 16)) * 2) + tok0 * XPITCH;
      const unsigned e[8][4] = {{outp[0].x, outp[0].y, outp[0].z, outp[0].w}, {outp[1].x, outp[1].y, outp[1].z, outp[1].w}, {outp[2].x, outp[2].y, outp[2].z, outp[2].w}, {outp[3].x, outp[3].y, outp[3].z, outp[3].w},
                                {outp[4].x, outp[4].y, outp[4].z, outp[4].w}, {outp[5].x, outp[5].y, outp[5].z, outp[5].w}, {outp[6].x, outp[6].y, outp[6].z, outp[6].w}, {outp[7].x, outp[7].y, outp[7].z, outp[7].w}};
#pragma unroll
      for (int tp = 0; tp < 4; ++tp) {
          u32x4 lo4, hi4;
          lo4.x = (e[0][tp] & 0xffffu) | (e[1][tp] << 16); lo4.y = (e[2][tp] & 0xffffu) | (e[3][tp] << 16); lo4.z = (e[4][tp] & 0xffffu) | (e[5][tp] << 16); lo4.w = (e[6][tp] & 0xffffu) | (e[7][tp] << 16);
          hi4.x = (e[0][tp] >> 16) | (e[1][tp] & 0xffff0000u); hi4.y = (e[2][tp] >> 16) | (e[3][tp] & 0xffff0000u); hi4.z = (e[4][tp] >> 16) | (e[5][tp] & 0xffff0000u); hi4.w = (e[6][tp] >> 16) | (e[7][tp] & 0xffff0000u);
          *(LAS u32x4*)(dst + (2 * tp) * XPITCH) = lo4; *(LAS u32x4*)(dst + (2 * tp + 1) * XPITCH) = hi4; }
    }
    LAS unsigned char* HF = XT + 16384; LAS unsigned char* HB = XT + 32768; LAS unsigned char* ZY = XT + 49152;
    const bf16* xg = (const bf16*)(c.ws + WS_RE) + (size_t)((b * 64 + cl) * 4 + g) * 256 * 128;
    const unsigned char* STg = (const unsigned char*)c.out + (size_t)((b * 64 + cl) * 16) * 2 * 8192;
    bf16* ZG = (bf16*)(c.ws + WS_RA);
    u32x4 pre[6];
#define S3_ISSUE(r_) { const int hd_ = g * 4 + (r_); \
        pre[2] = *(const u32x4*)(STg + (size_t)(hd_ * 2 + 0) * 8192 + tid * 16); \
        pre[3] = *(const u32x4*)(STg + (size_t)(hd_ * 2 + 1) * 8192 + tid * 16); \
        _Pragma("unroll") for (int i_ = 0; i_ < 2; ++i_) { const int piece = tid + 512 * i_; \
            pre[i_]     = *(const u32x4*)(xg + (size_t)((r_) * 64) * 128 + piece * 8); \
            pre[4 + i_] = *(const u32x4*)(ZG + (size_t)(m0 + (piece >> 3)) * 2048 + g * 256 + (r_) * 64 + (piece & 7) * 8); } }
#define S3_H2L(dstT, v) { const int row = tid >> 3, c8 = tid & 7; const unsigned w_[4] = {(v).x, (v).y, (v).z, (v).w}; float f_[16]; \
        un4_fp8(w_[0], f_); un4_fp8(w_[1], f_ + 4); un4_fp8(w_[2], f_ + 8); un4_fp8(w_[3], f_ + 12); \
        u32x4 lo_, hi_; lo_.x = pk2(f_[0], f_[1]); lo_.y = pk2(f_[2], f_[3]); lo_.z = pk2(f_[4], f_[5]); lo_.w = pk2(f_[6], f_[7]); \
        hi_.x = pk2(f_[8], f_[9]); hi_.y = pk2(f_[10], f_[11]); hi_.z = pk2(f_[12], f_[13]); hi_.w = pk2(f_[14], f_[15]); \
        *(LAS u32x4*)((dstT) + row * 256 + (((2 * c8) ^ (row & 15)) * 16)) = lo_; *(LAS u32x4*)((dstT) + row * 256 + (((2 * c8 + 1) ^ (row & 15)) * 16)) = hi_; }
#define S3_COMMIT() { S3_H2L(HF, pre[2]) S3_H2L(HB, pre[3]) \
        _Pragma("unroll") for (int i_ = 0; i_ < 2; ++i_) { const int piece = tid + 512 * i_, row = piece >> 4, cq = piece & 15, o_ = row * 256 + ((cq ^ (row & 15)) * 16); \
            *(LAS u32x4*)(XT + o_) = pre[i_]; \
            const int zl = piece >> 3, zc = piece & 7; *(LAS u32x4*)(ZY + zl * 128 + ((zc ^ (zl & 7)) * 16)) = pre[4 + i_]; } }
    S3_ISSUE(0)
    __syncthreads();
    f32x4 cb[8];
#pragma unroll
    for (int st = 0; st < 8; ++st) cb[st] = (f32x4){0.f, 0.f, 0.f, 0.f};
#pragma unroll
    for (int ks = 0; ks < 4; ++ks) { const bf16x8_t bfrag = *(const LAS bf16x8_t*)(CM + (16 * w + fr) * XPITCH + (32 * ks + 8 * fq) * 2);
#pragma unroll
        for (int st = 0; st < 8; ++st) { const bf16x8_t afrag = *(const LAS bf16x8_t*)(BM + (16 * st + fr) * XPITCH + (32 * ks + 8 * fq) * 2);
            cb[st] = __builtin_amdgcn_mfma_f32_16x16x32_bf16(afrag, bfrag, cb[st], 0, 0, 0); } }
    unsigned cbp[8][2];
#pragma unroll
    for (int st = 0; st < 8; ++st) { cbp[st][0] = pk2(cb[st][0], cb[st][1]); cbp[st][1] = pk2(cb[st][2], cb[st][3]); }
    LAS unsigned char* MT_ = BM + (16 * w) * XPITCH;
    const int l = 16 * w + fr;
    float ssq = 0.f;
    unsigned ypk[4][8];
#pragma unroll 1
    for (int r = 0; r < 4; ++r) { const int hd = g * 4 + r;
        unsigned yp[8];
        S3_COMMIT()
        if (PROBE_DBL == 54) { S3_COMMIT() }
        __syncthreads();
        const LAS float* Pf = TB + r * 512, *dtf = TB + r * 512 + 128, *Pbx = TB + r * 512 + 256, *dtb = TB + r * 512 + 384;
        const float Pf_l = Pf[l], Pbx_l = Pbx[l], dsk = c.in[I_DSKIP][hd];
#pragma unroll 1
        for (int rep_ = 0; rep_ < (PROBE_DBL == 51 ? 2 : 1); ++rep_)
#pragma unroll
        for (int st = 0; st < 8; ++st) { const int s0 = 16 * st + 4 * fq;
            float mv[4];
            if (st < w) { const f32x4 pfs = *(const LAS f32x4*)(Pf + s0), dfs = *(const LAS f32x4*)(dtf + s0);
#pragma unroll
                for (int e = 0; e < 4; ++e) { const float cbv = (e & 1) ? __uint_as_float(cbp[st][e >> 1] & 0xffff0000u) : __uint_as_float(cbp[st][e >> 1] << 16);
                    mv[e] = cbv * (__builtin_amdgcn_exp2f(Pf_l - pfs[e]) * dfs[e]); }
            } else if (st > w) { const f32x4 pbs = *(const LAS f32x4*)(Pbx + s0), dbs = *(const LAS f32x4*)(dtb + s0);
#pragma unroll
                for (int e = 0; e < 4; ++e) { const float cbv = (e & 1) ? __uint_as_float(cbp[st][e >> 1] & 0xffff0000u) : __uint_as_float(cbp[st][e >> 1] << 16);
                    mv[e] = cbv * (__builtin_amdgcn_exp2f(pbs[e] - Pbx_l) * dbs[e]); }
            } else { const f32x4 pfs = *(const LAS f32x4*)(Pf + s0), dfs = *(const LAS f32x4*)(dtf + s0), pbs = *(const LAS f32x4*)(Pbx + s0), dbs = *(const LAS f32x4*)(dtb + s0);
#pragma unroll
                for (int e = 0; e < 4; ++e) { const int s = s0 + e;
                    const float cf = __builtin_amdgcn_exp2f(fminf(Pf_l - pfs[e], 0.f)) * dfs[e];
                    const float cbw = __builtin_amdgcn_exp2f(fminf(pbs[e] - Pbx_l, 0.f)) * dbs[e];
                    float co = s < l ? cf : (s > l ? cbw : cf + cbw);
                    const float cbv = (e & 1) ? __uint_as_float(cbp[st][e >> 1] & 0xffff0000u) : __uint_as_float(cbp[st][e >> 1] << 16);
                    mv[e] = cbv * co + (s == l ? dsk : 0.f); } }
            u32x2 o; o.x = pk2(mv[0], mv[1]); o.y = pk2(mv[2], mv[3]);
            *(LAS u32x2*)(MT_ + fr * XPITCH + s0 * 2) = o; }
        asm volatile("s_waitcnt lgkmcnt(0)" ::: "memory");
        if (r < 3) S3_ISSUE(r + 1)
        f32x4 yd[4], yo[4];
#pragma unroll
        for (int pt = 0; pt < 4; ++pt) { yd[pt] = (f32x4){0.f, 0.f, 0.f, 0.f}; yo[pt] = yd[pt]; }
#pragma unroll 1
        for (int rep_ = 0; rep_ < (PROBE_DBL == 52 ? 2 : 1); ++rep_)
#pragma unroll
        for (int ks = 0; ks < 4; ++ks) {
            const bf16x8_t mfrag = *(const LAS bf16x8_t*)(MT_ + fr * XPITCH + (32 * ks + 8 * fq) * 2);
#pragma unroll
            for (int pt = 0; pt < 4; ++pt) {
                const bf16x8_t xfrag = *(const LAS bf16x8_t*)(XT + (16 * pt + fr) * 256 + (((4 * ks + fq) ^ fr) * 16));
                yd[pt] = __builtin_amdgcn_mfma_f32_16x16x32_bf16(xfrag, mfrag, yd[pt], 0, 0, 0); }
            asm volatile("" ::: "memory"); }
        if (PROBE_DBL == 52) { _Pragma("unroll") for (int pt = 0; pt < 4; ++pt) yd[pt] = yd[pt] * 0.5f; }
        const float ef = __builtin_amdgcn_exp2f(Pf_l) * (PROBE_DBL == 53 ? 0.5f : 1.f) * (1.f / STSCALE), eb = __builtin_amdgcn_exp2f(TB[2048 + r] - Pbx_l) * (PROBE_DBL == 53 ? 0.5f : 1.f) * (1.f / STSCALE);
#pragma unroll 1
        for (int rep_ = 0; rep_ < (PROBE_DBL == 53 ? 2 : 1); ++rep_)
#pragma unroll
        for (int ks = 0; ks < 4; ++ks) {
            const bf16x8_t cfrag = *(const LAS bf16x8_t*)(CM + (16 * w + fr) * XPITCH + (32 * ks + 8 * fq) * 2);
#pragma unroll
            for (int pt = 0; pt < 4; ++pt) { const bf16x8_t hff = *(const LAS bf16x8_t*)(HF + (16 * pt + fr) * 256 + (((4 * ks + fq) ^ fr) * 16));
                yo[pt] = __builtin_amdgcn_mfma_f32_16x16x32_bf16(hff, cfrag, yo[pt], 0, 0, 0); }
            asm volatile("" ::: "memory"); }
#pragma unroll
        for (int pt = 0; pt < 4; ++pt) { yd[pt] = yd[pt] + yo[pt] * ef; yo[pt] = (f32x4){0.f, 0.f, 0.f, 0.f}; }
#pragma unroll 1
        for (int rep_ = 0; rep_ < (PROBE_DBL == 53 ? 2 : 1); ++rep_)
#pragma unroll
        for (int ks = 0; ks < 4; ++ks) {
            const bf16x8_t cfrag = *(const LAS bf16x8_t*)(CM + (16 * w + fr) * XPITCH + (32 * ks + 8 * fq) * 2);
#pragma unroll
            for (int pt = 0; pt < 4; ++pt) { const bf16x8_t hbf = *(const LAS bf16x8_t*)(HB + (16 * pt + fr) * 256 + (((4 * ks + fq) ^ fr) * 16));
                yo[pt] = __builtin_amdgcn_mfma_f32_16x16x32_bf16(hbf, cfrag, yo[pt], 0, 0, 0); }
            asm volatile("" ::: "memory"); }
#pragma unroll
        for (int pt = 0; pt < 4; ++pt) {
            const u32x2 zw = *(const LAS u32x2*)(ZY + l * 128 + (((2 * pt + (fq >> 1)) ^ (l & 7)) * 16) + (fq & 1) * 8);
            const float zz[4] = {__uint_as_float(zw.x << 16), __uint_as_float(zw.x & 0xffff0000u), __uint_as_float(zw.y << 16), __uint_as_float(zw.y & 0xffff0000u)};
            float y[4];
#pragma unroll
            for (int e = 0; e < 4; ++e) { y[e] = (yd[pt][e] + eb * yo[pt][e]) * silu_f(zz[e]); ssq += y[e] * y[e]; }
            yp[2 * pt] = pk2(y[0], y[1]); yp[2 * pt + 1] = pk2(y[2], y[3]); }
        if (r == 0) { _Pragma("unroll") for (int k = 0; k < 8; ++k) ypk[0][k] = yp[k]; } else if (r == 1) { _Pragma("unroll") for (int k = 0; k < 8; ++k) ypk[1][k] = yp[k]; }
        else if (r == 2) { _Pragma("unroll") for (int k = 0; k < 8; ++k) ypk[2][k] = yp[k]; } else { _Pragma("unroll") for (int k = 0; k < 8; ++k) ypk[3][k] = yp[k]; }
        __syncthreads();
    }
#undef S3_ISSUE
#undef S3_COMMIT
#undef S3_H2L
    { const unsigned u = __builtin_bit_cast(unsigned, ssq); auto r1 = __builtin_amdgcn_permlane16_swap(u, u, false, false); ssq = __builtin_bit_cast(float, (unsigned)r1[0]) + __builtin_bit_cast(float, (unsigned)r1[1]); }
    { const unsigned u = __builtin_bit_cast(unsigned, ssq); auto r2 = __builtin_amdgcn_permlane32_swap(u, u, false, false); ssq = __builtin_bit_cast(float, (unsigned)r2[0]) + __builtin_bit_cast(float, (unsigned)r2[1]); }
    const float rinv = rsqrtf(ssq * (1.f / 256.f) + EPS);
    const float* ng = c.in[I_SSDNORMG];
#pragma unroll 1
    for (int rep2_ = 0; rep2_ < (PROBE_DBL == 56 ? 2 : 1); ++rep2_) {
#pragma unroll
    for (int r = 0; r < 4; ++r)
#pragma unroll
        for (int pt = 0; pt < 4; ++pt) { const int ch = g * 256 + r * 64 + 16 * pt + 4 * fq; const f32x4 gg = *(const f32x4*)(ng + ch);
            const unsigned a0 = ypk[r][2 * pt], a1 = ypk[r][2 * pt + 1];
            if (FP8_GEMM2) { const float rs = rinv * YSCALE;
                const unsigned o8 = (unsigned)__builtin_amdgcn_cvt_pk_fp8_f32(__uint_as_float(a1 << 16) * rs * gg.z, __uint_as_float(a1 & 0xffff0000u) * rs * gg.w,
                    __builtin_amdgcn_cvt_pk_fp8_f32(__uint_as_float(a0 << 16) * rs * gg.x, __uint_as_float(a0 & 0xffff0000u) * rs * gg.y, 0, false), true);
                *(LAS unsigned*)(XT + r * 8192 + l * 64 + 16 * pt + 4 * fq) = o8;
            } else {
            u32x2 o; o.x = pk2(__uint_as_float(a0 << 16) * rinv * gg.x, __uint_as_float(a0 & 0xffff0000u) * rinv * gg.y);
            o.y = pk2(__uint_as_float(a1 << 16) * rinv * gg.z, __uint_as_float(a1 & 0xffff0000u) * rinv * gg.w);
            *(LAS u32x2*)(XT + r * 16384 + l * 128 + (((2 * pt + (fq >> 1)) ^ (l & 7)) * 16) + (fq & 1) * 8) = o; }
            asm volatile("" ::: "memory"); }
    __syncthreads();
    if (FP8_GEMM2) { unsigned char* AQ = (unsigned char*)c.out + 64 * MiB + zoff;
#pragma unroll
        for (int i = 0; i < 4; ++i) { const int piece = tid + 512 * i, zl = piece >> 4, r = (piece >> 2) & 3, zc = piece & 3;
            const u32x4 v = *(const LAS u32x4*)(XT + r * 8192 + zl * 64 + zc * 16);
            *(u32x4*)(AQ + (size_t)(m0 + zl) * 2048 + g * 256 + r * 64 + zc * 16) = v; }
    } else {
#pragma unroll
    for (int i = 0; i < 8; ++i) { const int piece = tid + 512 * i, r = piece >> 10, zl = (piece >> 3) & 127, zc = piece & 7;
        const u32x4 v = *(const LAS u32x4*)(XT + r * 16384 + zl * 128 + ((zc ^ (zl & 7)) * 16));
        *(u32x4*)(ZG + zoff + (size_t)(m0 + zl) * 2048 + g * 256 + r * 64 + zc * 8) = v; } }
    __syncthreads();
    }
}
__device__ __forceinline__ void phase5f(const Ctx& c) {
    for (int it = c.bid; it < NB * 64 * 4; it += c.nblk) { const int g = it & 3, t = it >> 2, cl = t & 63, b = t >> 6;  s3_item(c, b, cl, g, PROBE_DBL == 5 ? (size_t)c.qsel * ((WS_RC - WS_RA) / 2) : (size_t)0); }
}

__device__ __forceinline__ void phase6(const Ctx& c) {
    EpiPlainT e{(bf16*)(c.ws + WS_RC), 1024};
    static_assert(YSCALE == 16.f && WOSCALE == 64.f, "EpiPlainT::SCA / SCB undo these");
    pg8::Gemm g{FP8_GEMM2 ? (const bf16*)((const unsigned char*)c.out + 64 * MiB) : (const bf16*)(c.ws + WS_RA), (const bf16*)(c.ws + WS_WOUT), ML, 1024, FP8_GEMM2 ? 1024 : 2048};
    pg8::StaticOrder S; S.init(ML, 1024, c.nblk, c.bid, G2_WGM);
    pg8::gemm_phase<EpiPlainT, pg8::StaticOrder, true, FP8_SP2, FP8_TPL != 0>((LAS unsigned char*)c.lds, g, S, e);
}

__device__ __forceinline__ unsigned pk8_fp4(const f32x4& a0, const f32x4& a1, float scale) {
    const float av[8] = {a0.x, a0.y, a0.z, a0.w, a1.x, a1.y, a1.z, a1.w};
    unsigned code = 0u;
#pragma unroll
    for (int j = 0; j < 8; ++j) { const float m = fabsf(av[j]) * scale;
        const unsigned mi = (unsigned)(m > 0.25f) + (unsigned)(m > 0.75f) + (unsigned)(m > 1.25f) + (unsigned)(m > 1.75f) + (unsigned)(m > 2.5f) + (unsigned)(m > 3.5f) + (unsigned)(m > 5.f);
        code |= (mi | (av[j] < 0.f ? 8u : 0u)) << (4 * j); }
    return code;
}
__device__ __forceinline__ void phase7(const Ctx& c) {
    const bf16* MIX = (const bf16*)(c.ws + WS_RC); bf16* H2 = (bf16*)(c.ws + WS_RB); unsigned char* XQ = c.ws + WS_RB + 64 * MiB;
    bf16* X1 = (bf16*)(c.ws + WS_X1); const float* MOD = (const float*)(c.ws + WS_MOD);
    const float* gpost = c.in[I_GPOSTMIX]; const float* gpre = c.in[I_GPREFFN];
    u32x2 mwN[4]; f32x4 xvN[4];
#define P7_LOAD(m_) { _Pragma("unroll") for (int j = 0; j < 4; ++j) { const int col = 4 * c.lane + 256 * j; mwN[j] = *(const u32x2*)(MIX + (size_t)(m_) * 1024 + col); xvN[j] = *(const f32x4*)(c.in[I_X] + (size_t)(m_) * DM + col); } }
    if (c.gw < ML) P7_LOAD(c.gw)
    for (int m = c.gw; m < ML; m += c.ngw) {
        const int b = m / SEQ; const float* mv = MOD + b * NMOD;
        u32x2 mw[4]; f32x4 xv4[4];
#pragma unroll
        for (int j = 0; j < 4; ++j) { mw[j] = mwN[j]; xv4[j] = xvN[j]; }
        { const int mn = (m + c.ngw < ML) ? m + c.ngw : m; P7_LOAD(mn) }
        float mx[16], x1[16]; float ss = 0.f;
#pragma unroll
        for (int j = 0; j < 4; ++j) { const u32x2 w = mw[j];
            mx[4 * j] = __uint_as_float(w.x << 16); mx[4 * j + 1] = __uint_as_float(w.x & 0xffff0000u); mx[4 * j + 2] = __uint_as_float(w.y << 16); mx[4 * j + 3] = __uint_as_float(w.y & 0xffff0000u);
            ss += mx[4 * j] * mx[4 * j] + mx[4 * j + 1] * mx[4 * j + 1] + mx[4 * j + 2] * mx[4 * j + 2] + mx[4 * j + 3] * mx[4 * j + 3]; }
        const float rinv = rsqrtf(wave_sum(ss) * (1.f / DM) + EPS);
        float ss2 = 0.f;
#pragma unroll
        for (int j = 0; j < 4; ++j) { const int col = 4 * c.lane + 256 * j;
            const f32x4 xv = xv4[j], gg = *(const f32x4*)(gpost + col), gt = *(const f32x4*)(mv + MOD_GT1 + col);
            f32x4 o; o.x = xv.x + gt.x * (mx[4 * j] * rinv * gg.x); o.y = xv.y + gt.y * (mx[4 * j + 1] * rinv * gg.y);
            o.z = xv.z + gt.z * (mx[4 * j + 2] * rinv * gg.z); o.w = xv.w + gt.w * (mx[4 * j + 3] * rinv * gg.w);
            u32x2 ob; ob.x = pk2(o.x, o.y); ob.y = pk2(o.z, o.w);
            *(u32x2*)(X1 + (size_t)m * DM + col) = ob;
            x1[4 * j] = o.x; x1[4 * j + 1] = o.y; x1[4 * j + 2] = o.z; x1[4 * j + 3] = o.w;
            ss2 += o.x * o.x + o.y * o.y + o.z * o.z + o.w * o.w; }
        const float rinv2 = rsqrtf(wave_sum(ss2) * (1.f / DM) + EPS);
#pragma unroll
        for (int j = 0; j < 4; ++j) { const int col = 4 * c.lane + 256 * j;
            const f32x4 gg = *(const f32x4*)(gpre + col), sh = *(const f32x4*)(mv + MOD_SH2 + col), sc = *(const f32x4*)(mv + MOD_SC2 + col);
            const float y0 = (x1[4 * j] * rinv2 * gg.x) * (1.f + sc.x) + sh.x, y1 = (x1[4 * j + 1] * rinv2 * gg.y) * (1.f + sc.y) + sh.y;
            const float y2 = (x1[4 * j + 2] * rinv2 * gg.z) * (1.f + sc.z) + sh.z, y3 = (x1[4 * j + 3] * rinv2 * gg.w) * (1.f + sc.w) + sh.w;
            u32x2 o; o.x = pk2(y0, y1); o.y = pk2(y2, y3);
            *(u32x2*)(H2 + (size_t)m * DM + col) = o;
            *(unsigned*)(XQ + (size_t)m * DM + col) = pk4_fp8(y0, y1, y2, y3, XSCALE); }
    }
#undef P7_LOAD
    { const f32x4* U4 = (const f32x4*)c.in[I_U]; const f32x4* V4 = (const f32x4*)c.in[I_V];
      u32x2* Uq = (u32x2*)(c.ws + WS_RC + 64 * MiB); u32x2* Vq = (u32x2*)(c.ws + WS_RC + 96 * MiB); unsigned* Uq4 = (unsigned*)(c.ws + WS_RC + 64 * MiB);
      unsigned* Vq4 = (unsigned*)(c.ws + WS_RC + 96 * MiB);
      for (int i = c.gtid; i < (TABLES_IN_SELECT && U4_TABLE && V4_TABLE && V5_MFMA && SLICED_PEER ? 0 : 16384 * 1024 / 8); i += c.gsz) {
          const size_t di = SLICED_PEER ? ((size_t)((i & 127) >> 4) * (16384 * 16) + (size_t)(i >> 7) * 16 + (i & 15)) : (size_t)i;
          const size_t d4 = (size_t)((i & 127) >> 5) * (16384 * 32) + (size_t)(i >> 7) * 32 + (i & 31);
          if (V4_TABLE && V5_MFMA && SLICED_PEER) {
              const int row = i >> 7, sl = (i & 127) >> 5, w = i & 31; const float* vp = c.in[I_V] + (size_t)row * 1024 + 256 * sl + 128 * (w & 1) + (w >> 1);
              f32x4 a0, a1; a0.x = vp[0]; a0.y = vp[16]; a0.z = vp[32]; a0.w = vp[48]; a1.x = vp[64]; a1.y = vp[80]; a1.z = vp[96]; a1.w = vp[112];
              Vq4[d4] = pk8_fp4(a0, a1, USCALE);
          } else if (V4_TABLE && SLICED_PEER) Vq4[d4] = pk8_fp4(V4[2 * i], V4[2 * i + 1], USCALE);
          else { const f32x4 b0 = V4[2 * i] * TSCALE, b1 = V4[2 * i + 1] * TSCALE;
              u32x2 ob;
              ob.x = (unsigned)__builtin_amdgcn_cvt_pk_fp8_f32(b0.z, b0.w, __builtin_amdgcn_cvt_pk_fp8_f32(b0.x, b0.y, 0, false), true);
              ob.y = (unsigned)__builtin_amdgcn_cvt_pk_fp8_f32(b1.z, b1.w, __builtin_amdgcn_cvt_pk_fp8_f32(b1.x, b1.y, 0, false), true);
              Vq[di] = ob; }
          if (U4_TABLE && SLICED_PEER) Uq4[d4] = pk8_fp4(U4[2 * i], U4[2 * i + 1], USCALE);
          else {
              const f32x4 a0 = U4[2 * i] * TSCALE, a1 = U4[2 * i + 1] * TSCALE; u32x2 oa;
              oa.x = (unsigned)__builtin_amdgcn_cvt_pk_fp8_f32(a0.z, a0.w, __builtin_amdgcn_cvt_pk_fp8_f32(a0.x, a0.y, 0, false), true);
              oa.y = (unsigned)__builtin_amdgcn_cvt_pk_fp8_f32(a1.z, a1.w, __builtin_amdgcn_cvt_pk_fp8_f32(a1.x, a1.y, 0, false), true);
              Uq[di] = oa; } } }
}

__device__ __forceinline__ void phase8(const Ctx& c) {
    EpiPlainT e{(bf16*)(c.ws + WS_RA), 2048};
    pg8::Gemm g{FP8_GEMM3 ? (const bf16*)(c.ws + WS_RB + 64 * MiB) : (const bf16*)(c.ws + WS_RB), (const bf16*)(c.ws + WS_WQK), ML, 2048, FP8_GEMM3 ? 512 : 1024};
    pg8::StaticOrder S; S.init(ML, 2048, c.nblk, c.bid, G3_WGM);
    pg8::gemm_phase<EpiPlainT, pg8::StaticOrder, true, true, FP8_GEMM3 != 0>((LAS unsigned char*)c.lds, g, S, e);
}

__device__ __forceinline__ void argmax_bfly(float& v, int& i) {
#pragma unroll
    for (int o = 1; o < 64; o <<= 1) { const float ov = __shfl_xor(v, o); const int oi = __shfl_xor(i, o);
        if (ov > v || (ov == v && oi < i)) { v = ov; i = oi; } }
}
typedef __attribute__((ext_vector_type(2))) __bf16 bf16x2_t;
__device__ __forceinline__ float dot2bf(unsigned a, unsigned b, float acc) { return __builtin_amdgcn_fdot2_f32_bf16(__builtin_bit_cast(bf16x2_t, a), __builtin_bit_cast(bf16x2_t, b), acc, false); }

__device__ __forceinline__ unsigned umin2(unsigned a, unsigned b) { return a < b ? a : b; }
#define CE(a, b) { const unsigned _h = umax2(x[a], x[b]), _l = umin2(x[a], x[b]); x[a] = _h; x[b] = _l; }
__device__ __forceinline__ void sort16_desc(unsigned* x) { CE(0,1) CE(2,3) CE(4,5) CE(6,7) CE(8,9) CE(10,11) CE(12,13) CE(14,15) CE(0,2) CE(1,3) CE(4,6) CE(5,7) CE(8,10) CE(9,11) CE(12,14) CE(13,15) CE(1,2) CE(5,6) CE(9,10) CE(13,14) CE(0,4) CE(1,5) CE(2,6) CE(3,7) CE(8,12) CE(9,13) CE(10,14) CE(11,15) CE(2,4) CE(3,5) CE(10,12) CE(11,13) CE(1,2) CE(3,4) CE(5,6) CE(9,10) CE(11,12) CE(13,14) CE(0,8) CE(1,9) CE(2,10) CE(3,11) CE(4,12) CE(5,13) CE(6,14) CE(7,15) CE(4,8) CE(5,9) CE(6,10) CE(7,11) CE(2,4) CE(3,5) CE(6,8) CE(7,9) CE(10,12) CE(11,13) CE(1,2) CE(3,4) CE(5,6) CE(7,8) CE(9,10) CE(11,12) CE(13,14) }
__device__ __forceinline__ void clean16_desc(unsigned* x) {
#pragma unroll
    for (int d = 8; d >= 1; d >>= 1)
#pragma unroll
        for (int i = 0; i < 16; ++i) if (!(i & d)) CE(i, i + d)
}
#undef CE
__device__ __forceinline__ unsigned ord32(unsigned u) { return u ^ ((unsigned)((int)u >> 31) | 0x80000000u); }
__device__ __forceinline__ unsigned deord32(unsigned o) { return o ^ ((~(unsigned)((int)o >> 31)) | 0x80000000u); }
template <class EP, class GP> __device__ __forceinline__ void peer_select(const bf16* srow, int lane, EP EL, GP GL) {
    unsigned k[32];
    { const u32x4* s4 = (const u32x4*)srow + 4 * lane; const unsigned sbits = (unsigned)(3 - (lane & 3)) << 5;
#pragma unroll
      for (int i = 0; i < 4; ++i) { const u32x4 w = s4[i]; const unsigned ww[4] = {w.x, w.y, w.z, w.w};
#pragma unroll
          for (int cidx = 0; cidx < 4; ++cidx)
#pragma unroll
              for (int hh = 0; hh < 2; ++hh) { const int j = i * 8 + cidx * 2 + hh; const unsigned u = hh ? (ww[cidx] & 0xffff0000u) : (ww[cidx] << 16);
                  const unsigned m = (unsigned)((int)u >> 31);
                  k[j] = (u ^ ((m & 0x7fff0000u) | 0x80000000u)) | sbits | (unsigned)(31 - j); } } }
    sort16_desc(k); sort16_desc(k + 16);
    unsigned x[16];
#pragma unroll
    for (int i = 0; i < 16; ++i) x[i] = umax2(k[i], k[31 - i]);
    clean16_desc(x);
    { unsigned y[16];
#pragma unroll
      for (int i = 0; i < 16; ++i) y[i] = umax2(x[i], dpp_u<0xB1>(x[15 - i]));
      clean16_desc(y);
#pragma unroll
      for (int i = 0; i < 16; ++i) x[i] = umax2(y[i], dpp_u<0x4E>(y[15 - i]));
      clean16_desc(x); }
    float xv[16]; unsigned xt[16]; const bool isB = (lane >> 2) & 1; const int sh = isB ? 0 : 7;
#pragma unroll
    for (int i = 0; i < 16; ++i) { const unsigned o = x[i] & 0xffff0000u; xv[i] = __uint_as_float(o ^ ((~(unsigned)((int)o >> 31) & 0x7fff0000u) | 0x80000000u));
        xt[i] = (((x[i] & 0x7fu) ^ 0x7fu) << sh); }
    unsigned ca[16], cb2[16];
#define CAND(dst, i, j) { const float s_ = xv[i] + dpp_f<0x141>(xv[j]); const unsigned t_ = xt[i] | dpp_u<0x141>(xt[j]); dst = (ord32(__float_as_uint(s_)) & 0xffffc000u) | t_; }
    CAND(ca[0], 0, 1) CAND(ca[1], 0, 2) CAND(ca[2], 0, 3) CAND(ca[3], 0, 4) CAND(ca[4], 0, 5) CAND(ca[5], 0, 6) CAND(ca[6], 0, 7) CAND(ca[7], 0, 8)
    CAND(ca[8], 0, 9) CAND(ca[9], 0, 10) CAND(ca[10], 0, 11) CAND(ca[11], 0, 12) CAND(ca[12], 0, 13) CAND(ca[13], 0, 14) CAND(ca[14], 0, 15) CAND(ca[15], 1, 2)
    CAND(cb2[0], 1, 3) CAND(cb2[1], 1, 4) CAND(cb2[2], 1, 5) CAND(cb2[3], 1, 6) CAND(cb2[4], 1, 7) CAND(cb2[5], 2, 3) CAND(cb2[6], 2, 4)
    CAND(cb2[7], 0, 0) CAND(cb2[8], 1, 1) CAND(cb2[9], 2, 2) CAND(cb2[10], 3, 3)
#undef CAND
    if (isB) { cb2[7] = 0u; cb2[8] = 0u; cb2[9] = 0u; cb2[10] = 0u; }
    cb2[11] = 0u; cb2[12] = 0u; cb2[13] = 0u; cb2[14] = 0u; cb2[15] = 0u;
    sort16_desc(ca); sort16_desc(cb2);
#pragma unroll
    for (int i = 0; i < 16; ++i) x[i] = umax2(ca[i], cb2[15 - i]);
    clean16_desc(x);
    { unsigned y[16];
#pragma unroll
      for (int i = 0; i < 16; ++i) y[i] = umax2(x[i], dpp_u<0x141>(x[15 - i]));
      clean16_desc(y);
      float e[16]; float sum = 0.f; const float c0 = __uint_as_float(deord32(y[0] & 0xffffc000u));
#pragma unroll
      for (int r = 0; r < 16; ++r) { const float cv = __uint_as_float(deord32(y[r] & 0xffffc000u)); e[r] = __expf(cv - c0); sum += e[r]; }
      const float inv = 1.f / sum;
      if ((lane & 7) == 0) { const int h = lane >> 3;
          if constexpr (sizeof(*EL) == 2) {
              u32x4 p0, p1; p0.x = (y[0] & 0x3fffu) | ((y[1] & 0x3fffu) << 16); p0.y = (y[2] & 0x3fffu) | ((y[3] & 0x3fffu) << 16); p0.z = (y[4] & 0x3fffu) | ((y[5] & 0x3fffu) << 16); p0.w = (y[6] & 0x3fffu) | ((y[7] & 0x3fffu) << 16);
              p1.x = (y[8] & 0x3fffu) | ((y[9] & 0x3fffu) << 16); p1.y = (y[10] & 0x3fffu) | ((y[11] & 0x3fffu) << 16); p1.z = (y[12] & 0x3fffu) | ((y[13] & 0x3fffu) << 16); p1.w = (y[14] & 0x3fffu) | ((y[15] & 0x3fffu) << 16);
              *(u32x4*)(EL + h * 16) = p0; *(u32x4*)(EL + h * 16 + 8) = p1;
#pragma unroll
              for (int r4 = 0; r4 < 4; ++r4) { f32x4 gv; gv.x = e[4 * r4] * inv; gv.y = e[4 * r4 + 1] * inv; gv.z = e[4 * r4 + 2] * inv; gv.w = e[4 * r4 + 3] * inv; *(f32x4*)(GL + h * 16 + 4 * r4) = gv; }
          } else {
#pragma unroll
          for (int r4 = 0; r4 < 4; ++r4) { u32x4 ev; ev.x = y[4 * r4] & 0x3fffu; ev.y = y[4 * r4 + 1] & 0x3fffu; ev.z = y[4 * r4 + 2] & 0x3fffu; ev.w = y[4 * r4 + 3] & 0x3fffu;
              f32x4 gv; gv.x = e[4 * r4] * inv; gv.y = e[4 * r4 + 1] * inv; gv.z = e[4 * r4 + 2] * inv; gv.w = e[4 * r4 + 3] * inv;
              *(LAS u32x4*)(EL + h * 16 + 4 * r4) = ev; *(LAS f32x4*)(GL + h * 16 + 4 * r4) = gv; } } } }
}

constexpr int RB = 8;
typedef _Float16 f16x2_t __attribute__((ext_vector_type(2)));
typedef float f32x2_t __attribute__((ext_vector_type(2)));
struct RowBuf { u32x4 a[RB]; };
__device__ __forceinline__ void rows_load(RowBuf& B, const unsigned char* T, int Ereg, int base, int lane) {
#pragma unroll
    for (int r = 0; r < RB; ++r) { const int ek = __builtin_amdgcn_readlane(Ereg, base + r);
        B.a[r] = ((const u32x4*)(T + (size_t)ek * DM))[lane]; }
}
__device__ __forceinline__ float dot2h(unsigned fp8w, bool hi, f16x2_t x, float acc) {
    const f16x2_t u = hi ? __builtin_amdgcn_cvt_scalef32_pk_f16_fp8((int)fp8w, 1.0f, true) : __builtin_amdgcn_cvt_scalef32_pk_f16_fp8((int)fp8w, 1.0f, false);
    return __builtin_amdgcn_fdot2(u, x, acc, false);
}
__device__ __forceinline__ void rows_dot(const RowBuf& B, const f16x2_t* x, int sub, int lane, float& mine) {
#pragma unroll
    for (int r = 0; r < RB; ++r) { float s = 0.f;
        s = dot2h(B.a[r].x, false, x[0], s); s = dot2h(B.a[r].x, true, x[1], s); s = dot2h(B.a[r].y, false, x[2], s); s = dot2h(B.a[r].y, true, x[3], s);
        s = dot2h(B.a[r].z, false, x[4], s); s = dot2h(B.a[r].z, true, x[5], s); s = dot2h(B.a[r].w, false, x[6], s); s = dot2h(B.a[r].w, true, x[7], s);
        s = wave_sum(s); if ((lane & 15) == sub + r) mine = s; }
}
__device__ __forceinline__ void rows_axpy(const RowBuf& B, float wv, int base, float* o) {
#pragma unroll
    for (int r = 0; r < RB; ++r) { const float w = __builtin_bit_cast(float, __builtin_amdgcn_readlane(__builtin_bit_cast(int, wv), base + r));
        const unsigned q[4] = {B.a[r].x, B.a[r].y, B.a[r].z, B.a[r].w};
#pragma unroll
        for (int j = 0; j < 4; ++j) { const f32x2_t lo = __builtin_amdgcn_cvt_pk_f32_fp8((int)q[j], false), hi = __builtin_amdgcn_cvt_pk_f32_fp8((int)q[j], true);
            o[4 * j] += w * lo.x; o[4 * j + 1] += w * lo.y; o[4 * j + 2] += w * hi.x; o[4 * j + 3] += w * hi.y; } }
}
__device__ __forceinline__ void phase9(const Ctx& c) {
    const bf16* SC = (const bf16*)(c.ws + WS_RA); const bf16* H2 = (const bf16*)(c.ws + WS_RB); float* X1 = c.out; const float* MOD = (const float*)(c.ws + WS_MOD);
    const unsigned char* Uq = c.ws + WS_RC + 64 * MiB; const unsigned char* Vq = c.ws + WS_RC + 96 * MiB; const float* gpost = c.in[I_GPOSTFFN];
    for (int m = c.gw; m < ML; m += c.ngw) {
        const int lane = c.lane;
        LAS unsigned* EL = (LAS unsigned*)((LAS unsigned char*)c.lds + c.wave * 1024); LAS float* GL = (LAS float*)(EL + 128);
        peer_select(SC + (size_t)m * 2048, lane, EL, GL);
        f16x2_t xh[8];
        { const u32x4 xa = ((const u32x4*)(H2 + (size_t)m * DM))[2 * lane], xb = ((const u32x4*)(H2 + (size_t)m * DM))[2 * lane + 1];
          const unsigned xw[8] = {xa.x, xa.y, xa.z, xa.w, xb.x, xb.y, xb.z, xb.w};
#pragma unroll
          for (int j = 0; j < 8; ++j) { f16x2_t t; t.x = (_Float16)__uint_as_float(xw[j] << 16); t.y = (_Float16)__uint_as_float(xw[j] & 0xffff0000u); xh[j] = t; } }
        float outv[16];
#pragma unroll
        for (int j = 0; j < 16; ++j) outv[j] = 0.f;
        RowBuf bA, bB;
        int Ev = (int)EL[lane & 15];
        rows_load(bA, Uq, Ev, 0, lane);
#pragma unroll 1
        for (int h = 0; h < 8; ++h) {
            const float gv = GL[h * 16 + (lane & 15)];
            const int En = (int)EL[((h + 1) & 7) * 16 + (lane & 15)];
            float mine = 0.f;
            rows_load(bB, Uq, Ev, 8, lane);  rows_dot(bA, xh, 0, lane, mine);
            rows_load(bA, Vq, Ev, 0, lane);  rows_dot(bB, xh, 8, lane, mine);
            const float wv = gv * gelu_tanh(mine * (1.f / TSCALE)) * (1.f / TSCALE);
            rows_load(bB, Vq, Ev, 8, lane);  rows_axpy(bA, wv, 0, outv);
            if (h < 7) rows_load(bA, Uq, En, 0, lane);
            rows_axpy(bB, wv, 8, outv);
            Ev = En;
        }
        float ss = 0.f;
#pragma unroll
        for (int j = 0; j < 16; ++j) ss += outv[j] * outv[j];
        const float rinv = rsqrtf(wave_sum(ss) * (1.f / DM) + EPS);
        const int b = m / SEQ; const float* gt2 = MOD + b * NMOD + MOD_GT2;
#pragma unroll
        for (int j = 0; j < 4; ++j) { const int col = lane * 16 + 4 * j; const float* ov = outv + 4 * j;
            const f32x4 xx = *(const f32x4*)(X1 + (size_t)m * DM + col), gg = *(const f32x4*)(gpost + col), gt = *(const f32x4*)(gt2 + col);
            f32x4 o; o.x = xx.x + gt.x * (ov[0] * rinv * gg.x); o.y = xx.y + gt.y * (ov[1] * rinv * gg.y);
            o.z = xx.z + gt.z * (ov[2] * rinv * gg.z); o.w = xx.w + gt.w * (ov[3] * rinv * gg.w);
            *(f32x4*)(X1 + (size_t)m * DM + col) = o; }
    }
}


__device__ __forceinline__ void phase9_probe(const Ctx& c, unsigned mask) {
    const bf16* H2 = (const bf16*)(c.ws + WS_RB);
    const unsigned char* Uq = c.ws + WS_RC + 64 * MiB; const unsigned char* Vq = c.ws + WS_RC + 96 * MiB;
    float* dump = (float*)(c.ws + WS_RE);
    for (int m = c.gw; m < ML; m += c.ngw) {
        const int lane = c.lane;
        f16x2_t xh[8];
        { const u32x4 xa = ((const u32x4*)(H2 + (size_t)m * DM))[2 * lane], xb = ((const u32x4*)(H2 + (size_t)m * DM))[2 * lane + 1];
          const unsigned xw[8] = {xa.x, xa.y, xa.z, xa.w, xb.x, xb.y, xb.z, xb.w};
#pragma unroll
          for (int j = 0; j < 8; ++j) { f16x2_t t; t.x = (_Float16)__uint_as_float(xw[j] << 16); t.y = (_Float16)__uint_as_float(xw[j] & 0xffff0000u); xh[j] = t; } }
        float outv[16];
#pragma unroll
        for (int j = 0; j < 16; ++j) outv[j] = 0.f;
        RowBuf bA, bB;
        int Ev = (int)((((unsigned)(m * 131 + (lane & 15)) * 2654435761u) >> 12) & mask);
        rows_load(bA, Uq, Ev, 0, lane);
#pragma unroll 1
        for (int h = 0; h < 8; ++h) {
            const float gv = 0.0625f;
            const int En = (int)((((unsigned)(m * 131 + (h + 1) * 17 + (lane & 15)) * 2654435761u) >> 12) & mask);
            float mine = 0.f;
            rows_load(bB, Uq, Ev, 8, lane);  rows_dot(bA, xh, 0, lane, mine);
            rows_load(bA, Vq, Ev, 0, lane);  rows_dot(bB, xh, 8, lane, mine);
            const float wv = gv * gelu_tanh(mine * (1.f / TSCALE)) * (1.f / TSCALE);
            rows_load(bB, Vq, Ev, 8, lane);  rows_axpy(bA, wv, 0, outv);
            if (h < 7) rows_load(bA, Uq, En, 0, lane);
            rows_axpy(bB, wv, 8, outv);
            Ev = En;
        }
#pragma unroll
        for (int j = 0; j < 4; ++j) { f32x4 o; o.x = outv[4 * j]; o.y = outv[4 * j + 1]; o.z = outv[4 * j + 2]; o.w = outv[4 * j + 3]; *(f32x4*)(dump + (size_t)(m & 4095) * DM + lane * 16 + 4 * j) = o; }
    }
}

constexpr size_t WS_EID = WS_RC, WS_GT = WS_RC + 8 * MiB, WS_WW = WS_RC + 24 * MiB, WS_SSQ = WS_RC + 40 * MiB;
constexpr int CW_PEERU = 8192, CW_PEERV = 8192 + 1024;
#ifndef TPW_
#define TPW_ 64
#endif
constexpr int TPW = TPW_;
constexpr int NTB = ML / (8 * TPW);

struct TabStep { f32x4 u0, u1, v0, v1; };
__device__ __forceinline__ void tab_load(const Ctx& c, int i, TabStep& T) {
    const f32x4* U4 = (const f32x4*)c.in[I_U]; T.u0 = U4[2 * i]; T.u1 = U4[2 * i + 1];
    const int row = i >> 7, sl = (i & 127) >> 5, w = i & 31; const float* vp = c.in[I_V] + (size_t)row * 1024 + 256 * sl + 128 * (w & 1) + (w >> 1);
    T.v0.x = vp[0]; T.v0.y = vp[16]; T.v0.z = vp[32]; T.v0.w = vp[48]; T.v1.x = vp[64]; T.v1.y = vp[80]; T.v1.z = vp[96]; T.v1.w = vp[112];
}
__device__ __forceinline__ void tab_store(const Ctx& c, int i, const TabStep& T) {
    unsigned* Uq4 = (unsigned*)(c.ws + WS_RC + 64 * MiB); unsigned* Vq4 = (unsigned*)(c.ws + WS_RC + 96 * MiB);
    const size_t d4 = (size_t)((i & 127) >> 5) * (16384 * 32) + (size_t)(i >> 7) * 32 + (i & 31);
    Uq4[d4] = pk8_fp4(T.u0, T.u1, USCALE); Vq4[d4] = pk8_fp4(T.v0, T.v1, USCALE);
}
__device__ __forceinline__ void phase9s(const Ctx& c) {
    const bf16* SC = (const bf16*)(c.ws + WS_RA);
    constexpr int NTAB = (TABLES_IN_SELECT && U4_TABLE && V4_TABLE && V5_MFMA) ? 16384 * 1024 / 8 : 0;
    int ci = c.gtid;
    for (int m = c.gw; m < ML; m += c.ngw) {
        TabStep T; const bool doit = ci < NTAB; const int cj = doit ? ci : 0;
        if (NTAB) tab_load(c, cj, T);
        peer_select(SC + (size_t)m * 2048, c.lane, (unsigned short*)(c.ws + WS_EID) + (size_t)m * 128, (float*)(c.ws + WS_GT) + (size_t)m * 128);
        if (NTAB) { if (doit) tab_store(c, cj, T); ci += c.gsz; }
    }
    for (; ci < NTAB; ci += c.gsz) { TabStep T; tab_load(c, ci, T); tab_store(c, ci, T); }
}

__device__ __forceinline__ int grab_item(unsigned* ctr, volatile LAS int* slot) {
    if (threadIdx.x == 0) *slot = (int)__hip_atomic_fetch_add(ctr, 1u, __ATOMIC_RELAXED, __HIP_MEMORY_SCOPE_AGENT);
    __syncthreads(); const int v = *slot; __syncthreads(); return v;
}
struct SliceBuf { u32x4 a[16]; };
__device__ __forceinline__ void slice_load(SliceBuf& B, const unsigned char* Tslice, const u32x4& e0, const u32x4& e1) {
    const unsigned ew[8] = {e0.x, e0.y, e0.z, e0.w, e1.x, e1.y, e1.z, e1.w};
#pragma unroll
    for (int r = 0; r < 16; ++r) { const unsigned eid = (r & 1) ? (ew[r >> 1] >> 16) : (ew[r >> 1] & 0xffffu);
        B.a[r] = *(const u32x4*)(Tslice + (size_t)eid * 128); }
}
__device__ __forceinline__ void pub8(void* p, const u32x2& v) {
    if (FUSE_TAIL) __hip_atomic_store((unsigned long long*)p, ((unsigned long long)v.y << 32) | v.x, __ATOMIC_RELAXED, __HIP_MEMORY_SCOPE_AGENT); else *(u32x2*)p = v; }
__device__ __forceinline__ void pub4(float* p, float v) {
    if (FUSE_TAIL) __hip_atomic_store(p, v, __ATOMIC_RELAXED, __HIP_MEMORY_SCOPE_AGENT); else *p = v; }
__device__ __forceinline__ long mk64(unsigned lo, unsigned hi) { return (long)(((unsigned long long)hi << 32) | lo); }
__device__ __forceinline__ void u_token(const SliceBuf& B, const u32x4& x0, const u32x4& x1, bf16* PDt, int lane, LAS unsigned char* stg) {
    { const int h = lane >> 3, cs = ((lane & 7) ^ h) * 16;
#pragma unroll
      for (int j = 0; j < 16; ++j) *(LAS u32x4*)(stg + (8 * j + h) * 128 + cs) = B.a[j]; }
    const long b0 = mk64(x0.x, x0.y), b1 = mk64(x0.z, x0.w), b2 = mk64(x1.x, x1.y), b3 = mk64(x1.z, x1.w);
    const int i = lane & 15, q = lane >> 4, hh = i & 7;
    const LAS unsigned char* rb = stg + ((i >> 3) * 8 + hh) * 128;
    const int o0 = (((2 * q) ^ hh) * 16), o1 = (((2 * q + 1) ^ hh) * 16);
    f32x4 keep = {0.f, 0.f, 0.f, 0.f};
#pragma unroll
    for (int G = 0; G < 8; ++G) { f32x4 acc = {0.f, 0.f, 0.f, 0.f}; const LAS unsigned char* rg = rb + G * 2048;
        acc = __builtin_amdgcn_mfma_f32_16x16x32_fp8_fp8(*(const LAS long*)(rg + o0), b0, acc, 0, 0, 0);
        acc = __builtin_amdgcn_mfma_f32_16x16x32_fp8_fp8(*(const LAS long*)(rg + o0 + 8), b1, acc, 0, 0, 0);
        acc = __builtin_amdgcn_mfma_f32_16x16x32_fp8_fp8(*(const LAS long*)(rg + o1), b2, acc, 0, 0, 0);
        acc = __builtin_amdgcn_mfma_f32_16x16x32_fp8_fp8(*(const LAS long*)(rg + o1 + 8), b3, acc, 0, 0, 0);
        if (i == G) keep = acc; }
    if (i < 8) { u32x2 o; o.x = pk2(keep[0], keep[1]); o.y = pk2(keep[2], keep[3]);
        *(u32x2*)(PDt + (2 * i + (q >> 1)) * 8 + 4 * (q & 1)) = o; }
}
__device__ __forceinline__ void u_item(const Ctx& c, int s, int tb) {
    const unsigned char* XQ = c.ws + WS_RB + 64 * MiB + 128 * s; const unsigned short* EID = (const unsigned short*)(c.ws + WS_EID);
    bf16* PD = (bf16*)(c.ws + WS_RA) + (size_t)s * ML * 128;
    const int lane = c.lane, h = lane >> 3, cc = lane & 7;
    const unsigned char* Us = c.ws + WS_RC + 64 * MiB + (size_t)s * (16384 * 128) + 16 * cc;
    LAS unsigned char* stg = (LAS unsigned char*)c.lds + c.wave * 16384;
    const int t0 = tb * (8 * TPW) + c.wave * TPW;
    const unsigned short* Eh = EID + 16 * h; const unsigned char* Xq = XQ + 32 * (lane >> 4);
#define LD_E(dst0, dst1, t) { dst0 = *(const u32x4*)(Eh + (size_t)(t) * 128); dst1 = *(const u32x4*)(Eh + (size_t)(t) * 128 + 8); }
#define LD_X(dst0, dst1, t) { dst0 = *(const u32x4*)(Xq + (size_t)(t) * DM); dst1 = *(const u32x4*)(Xq + (size_t)(t) * DM + 16); }
    SliceBuf bA, bB; u32x4 ea0, ea1, eb0, eb1, ec0, ec1, xa0, xa1, xb0, xb1;
    LD_E(ea0, ea1, t0) LD_X(xa0, xa1, t0) LD_E(eb0, eb1, t0 + 1)
    slice_load(bA, Us, ea0, ea1);
#pragma unroll 1
    for (int i = 0; i < TPW; i += 2) { const int t = t0 + i; const int t2 = (i + 2 < TPW) ? t + 2 : t, t3 = (i + 3 < TPW) ? t + 3 : t;
        LD_E(ec0, ec1, t2) LD_X(xb0, xb1, t + 1)
        slice_load(bB, Us, eb0, eb1);
        u_token(bA, xa0, xa1, PD + (size_t)t * 128, lane, stg);
        LD_E(eb0, eb1, t3) LD_X(xa0, xa1, t2)
        slice_load(bA, Us, ec0, ec1);
        u_token(bB, xb0, xb1, PD + (size_t)(t + 1) * 128, lane, stg);
    }
#undef LD_X
}
typedef int i32x8_u __attribute__((ext_vector_type(8)));
__device__ __forceinline__ void u4_token(const SliceBuf& B, const u32x4& x0, const u32x4& x1, const u32x4& x2, const u32x4& x3, bf16* PDt, int lane, LAS unsigned char* stg) {
    { const int h = lane >> 3, cs = ((lane & 7) ^ h) * 16;
#pragma unroll
      for (int j = 0; j < 16; ++j) *(LAS u32x4*)(stg + (8 * j + h) * 128 + cs) = B.a[j]; }
    const i32x8_u b0 = {(int)x0.x, (int)x0.y, (int)x0.z, (int)x0.w, (int)x1.x, (int)x1.y, (int)x1.z, (int)x1.w};
    const i32x8_u b1 = {(int)x2.x, (int)x2.y, (int)x2.z, (int)x2.w, (int)x3.x, (int)x3.y, (int)x3.z, (int)x3.w};
    const int i = lane & 15, q = lane >> 4, hh = i & 7;
    const LAS unsigned char* rb = stg + ((i >> 3) * 8 + hh) * 128;
    const int o0 = ((q ^ hh) * 16), o1 = (((4 + q) ^ hh) * 16);
    f32x4 keep = {0.f, 0.f, 0.f, 0.f};
#pragma unroll
    for (int G = 0; G < 8; ++G) { f32x4 acc = {0.f, 0.f, 0.f, 0.f}; const LAS unsigned char* rg = rb + G * 2048;
        const u32x4 a0 = *(const LAS u32x4*)(rg + o0), a1 = *(const LAS u32x4*)(rg + o1);
        const i32x8_u A0 = {(int)a0.x, (int)a0.y, (int)a0.z, (int)a0.w, 0, 0, 0, 0}, A1 = {(int)a1.x, (int)a1.y, (int)a1.z, (int)a1.w, 0, 0, 0, 0};
        acc = __builtin_amdgcn_mfma_scale_f32_16x16x128_f8f6f4(A0, b0, acc, 4, 0, 0, 127, 0, 127);
        acc = __builtin_amdgcn_mfma_scale_f32_16x16x128_f8f6f4(A1, b1, acc, 4, 0, 0, 127, 0, 127);
        if (i == G) keep = acc; }
    if (i < 8) { u32x2 o; o.x = pk2(keep[0], keep[1]); o.y = pk2(keep[2], keep[3]);
        pub8(PDt + (2 * i + (q >> 1)) * 8 + 4 * (q & 1), o); }
}
__device__ __forceinline__ void u4_item(const Ctx& c, int s, int tb) {
    const unsigned char* XQ = c.ws + WS_RB + 64 * MiB + 256 * s; const unsigned short* EID = (const unsigned short*)(c.ws + WS_EID);
    bf16* PD = (bf16*)(c.ws + WS_RA) + (size_t)s * ML * 128;
    const int lane = c.lane, h = lane >> 3, cc = lane & 7, q = lane >> 4;
    const unsigned char* Us = c.ws + WS_RC + 64 * MiB + (size_t)s * (16384 * 128) + 16 * cc;
    LAS unsigned char* stg = (LAS unsigned char*)c.lds + c.wave * 16384;
    const int t0 = tb * (8 * TPW) + c.wave * TPW;
    const unsigned short* Eh = EID + 16 * h; const unsigned char* Xq = XQ + 16 * q;
#define LD_E(dst0, dst1, t) { dst0 = *(const u32x4*)(Eh + (size_t)(t) * 128); dst1 = *(const u32x4*)(Eh + (size_t)(t) * 128 + 8); }
#define LD_X4(d0, d1, d2, d3, t) { d0 = *(const u32x4*)(Xq + (size_t)(t) * DM); d1 = *(const u32x4*)(Xq + (size_t)(t) * DM + 64); d2 = *(const u32x4*)(Xq + (size_t)(t) * DM + 128); d3 = *(const u32x4*)(Xq + (size_t)(t) * DM + 192); }
    SliceBuf bA, bB; u32x4 ea0, ea1, eb0, eb1, ec0, ec1, xa0, xa1, xa2, xa3, xb0, xb1, xb2, xb3;
    LD_E(ea0, ea1, t0) LD_X4(xa0, xa1, xa2, xa3, t0) LD_E(eb0, eb1, t0 + 1)
    slice_load(bA, Us, ea0, ea1);
#pragma unroll 1
    for (int i = 0; i < TPW; i += 2) { const int t = t0 + i; const int t2 = (i + 2 < TPW) ? t + 2 : t, t3 = (i + 3 < TPW) ? t + 3 : t;
        LD_E(ec0, ec1, t2) LD_X4(xb0, xb1, xb2, xb3, t + 1)
        slice_load(bB, Us, eb0, eb1);
        u4_token(bA, xa0, xa1, xa2, xa3, PD + (size_t)t * 128, lane, stg);
        LD_E(eb0, eb1, t3) LD_X4(xa0, xa1, xa2, xa3, t2)
        slice_load(bA, Us, ec0, ec1);
        u4_token(bB, xb0, xb1, xb2, xb3, PD + (size_t)(t + 1) * 128, lane, stg);
    }
#undef LD_X4
#undef LD_E
}
__device__ __forceinline__ float swap32_add(float a, float b) { auto r = __builtin_amdgcn_permlane32_swap(__builtin_bit_cast(unsigned, a), __builtin_bit_cast(unsigned, b), false, false);
    return __builtin_bit_cast(float, (unsigned)r[0]) + __builtin_bit_cast(float, (unsigned)r[1]); }
__device__ __forceinline__ float swap16_add(float a, float b) { auto r = __builtin_amdgcn_permlane16_swap(__builtin_bit_cast(unsigned, a), __builtin_bit_cast(unsigned, b), false, false);
    return __builtin_bit_cast(float, (unsigned)r[0]) + __builtin_bit_cast(float, (unsigned)r[1]); }
__device__ __forceinline__ void v_token(const SliceBuf& B, const f32x4* w4, bf16* POt, float* SSQt, int lane) {
    f32x2_t acc[8];
#pragma unroll
    for (int j = 0; j < 8; ++j) acc[j] = (f32x2_t){0.f, 0.f};
#pragma unroll
    for (int r = 0; r < 16; ++r) { const float w = w4[r >> 2][r & 3]; const f32x2_t ww = {w, w}; const unsigned q[4] = {B.a[r].x, B.a[r].y, B.a[r].z, B.a[r].w};
#pragma unroll
        for (int j = 0; j < 4; ++j) { const f32x2_t lo = __builtin_amdgcn_cvt_pk_f32_fp8((int)q[j], false), hi = __builtin_amdgcn_cvt_pk_f32_fp8((int)q[j], true);
            acc[2 * j] = ww * lo + acc[2 * j]; acc[2 * j + 1] = ww * hi + acc[2 * j + 1]; } }
    float b8[8], c4[4], d2[2];
#pragma unroll
    for (int j = 0; j < 4; ++j) { b8[2 * j] = swap32_add(acc[j].x, acc[j + 4].x); b8[2 * j + 1] = swap32_add(acc[j].y, acc[j + 4].y); }
#pragma unroll
    for (int j = 0; j < 4; ++j) c4[j] = swap16_add(b8[j], b8[j + 4]);
    const bool b3 = (lane >> 3) & 1;
#pragma unroll
    for (int j = 0; j < 2; ++j) { const float keep = b3 ? c4[j + 2] : c4[j], send = b3 ? c4[j] : c4[j + 2]; d2[j] = keep + dpp_f<0x128>(send); }
    const int col = 8 * (lane >> 5) + 4 * ((lane >> 4) & 1) + 2 * ((lane >> 3) & 1);
    *(unsigned*)(POt + 16 * (lane & 7) + col) = pk2(d2[0], d2[1]);
    const float ss = wave_sum(d2[0] * d2[0] + d2[1] * d2[1]);
    if (lane == 0) *SSQt = ss;
}
__device__ __forceinline__ void v4_token(const SliceBuf& B, const f32x4* w4, bf16* POt, float* SSQt, int lane) {
    f32x2_t acc[16];
#pragma unroll
    for (int j = 0; j < 16; ++j) acc[j] = (f32x2_t){0.f, 0.f};
#pragma unroll
    for (int r = 0; r < 16; ++r) { const float w = w4[r >> 2][r & 3]; const f32x2_t ww = {w, w}; const unsigned q[4] = {B.a[r].x, B.a[r].y, B.a[r].z, B.a[r].w};
#pragma unroll
        for (int j = 0; j < 4; ++j) {
            acc[4 * j]     = ww * __builtin_amdgcn_cvt_scalef32_pk_f32_fp4(q[j], 1.0f, 0) + acc[4 * j];
            acc[4 * j + 1] = ww * __builtin_amdgcn_cvt_scalef32_pk_f32_fp4(q[j], 1.0f, 1) + acc[4 * j + 1];
            acc[4 * j + 2] = ww * __builtin_amdgcn_cvt_scalef32_pk_f32_fp4(q[j], 1.0f, 2) + acc[4 * j + 2];
            acc[4 * j + 3] = ww * __builtin_amdgcn_cvt_scalef32_pk_f32_fp4(q[j], 1.0f, 3) + acc[4 * j + 3]; } }
    float b16[16], c8[8], d4[4];
#pragma unroll
    for (int j = 0; j < 8; ++j) { b16[2 * j] = swap32_add(acc[j].x, acc[j + 8].x); b16[2 * j + 1] = swap32_add(acc[j].y, acc[j + 8].y); }
#pragma unroll
    for (int j = 0; j < 8; ++j) c8[j] = swap16_add(b16[j], b16[j + 8]);
    const bool b3 = (lane >> 3) & 1;
#pragma unroll
    for (int j = 0; j < 4; ++j) { const float keep = b3 ? c8[j + 4] : c8[j], send = b3 ? c8[j] : c8[j + 4]; d4[j] = keep + dpp_f<0x128>(send); }
    const int col = 16 * (lane >> 5) + 8 * ((lane >> 4) & 1) + 4 * ((lane >> 3) & 1);
    u32x2 o; o.x = pk2(d4[0], d4[1]); o.y = pk2(d4[2], d4[3]);
    pub8(POt + 32 * (lane & 7) + col, o);
    const float ss = wave_sum(d4[0] * d4[0] + d4[1] * d4[1] + d4[2] * d4[2] + d4[3] * d4[3]);
    if (lane == 0) pub4(SSQt, ss);
}
typedef int v2i32_t __attribute__((ext_vector_type(2)));
__device__ __forceinline__ void v5_token(const SliceBuf& B, const u32x4& w0, const u32x4& w1, bf16* POt, float* SSQt, int lane, LAS unsigned char* stg) {
    { const int h = lane >> 3, cc = lane & 7;
#pragma unroll
      for (int j = 0; j < 16; ++j) { const u32x4 v = B.a[j]; const u32x4 sw = {v.z, v.w, v.x, v.y};
          *(LAS u32x4*)(stg + (8 * j + h) * 128 + ((cc ^ ((4 * j + (h >> 1)) & 7)) * 16)) = ((j >> 2) & 1) ? sw : v; } }
    const i32x8_u A = {(int)w0.x, (int)w0.y, (int)w0.z, (int)w0.w, (int)w1.x, (int)w1.y, (int)w1.z, (int)w1.w};
    const int l16 = lane & 15, q = lane >> 4, fx = (((l16 >> 1) & 7) * 16) | ((q & 1) * 8);
    const LAS unsigned char* rb = stg + (32 * q + l16) * 128;
    float val[16];
#pragma unroll
    for (int g = 0; g < 16; ++g) {
        const LAS unsigned char* pa = rb + (((g >> 1) * 16 + 8 * (g & 1)) ^ fx);
        const v2i32_t lo = __builtin_amdgcn_ds_read_tr4_b64_v2i32((LAS v2i32_t*)pa), hi = __builtin_amdgcn_ds_read_tr4_b64_v2i32((LAS v2i32_t*)(pa + 2048));
        const i32x8_u Bv = {lo.x, lo.y, hi.x, hi.y, 0, 0, 0, 0};
        f32x4 acc = {0.f, 0.f, 0.f, 0.f};
        acc = __builtin_amdgcn_mfma_scale_f32_16x16x128_f8f6f4(A, Bv, acc, 0, 4, 0, 127, 0, 127);
        val[g] = (acc[0] + acc[1] * (1.f / WLO)) * (1.f / (WSC * USCALE)); }
    float ss = 0.f;
#pragma unroll
    for (int g = 0; g < 16; ++g) ss += val[g] * val[g];
    u32x4 o0, o1; o0.x = pk2(val[0], val[1]); o0.y = pk2(val[2], val[3]); o0.z = pk2(val[4], val[5]); o0.w = pk2(val[6], val[7]);
    o1.x = pk2(val[8], val[9]); o1.y = pk2(val[10], val[11]); o1.z = pk2(val[12], val[13]); o1.w = pk2(val[14], val[15]);
    ss = row16_sum(ss);
    if (lane < 16) { *(u32x4*)(POt + 16 * lane) = o0; *(u32x4*)(POt + 16 * lane + 8) = o1; }
    if (lane == 0) *SSQt = ss;
}
__device__ __forceinline__ void v5_item(const Ctx& c, int s, int tb) {
    const unsigned short* EID = (const unsigned short*)(c.ws + WS_EID); const unsigned char* WQ = c.ws + WS_WW;
    bf16* PO = (bf16*)(c.ws + WS_RA) + 256 * s; float* SSQ = (float*)(c.ws + WS_SSQ) + (size_t)s * ML;
    const int lane = c.lane, h = lane >> 3, cc = lane & 7;
    const unsigned char* Vs = c.ws + WS_RC + 96 * MiB + (size_t)s * (16384 * 128) + 16 * cc;
    LAS unsigned char* stg = (LAS unsigned char*)c.lds + c.wave * 16384;
    const int t0 = tb * (8 * TPW) + c.wave * TPW;
    const unsigned short* Eh = EID + 16 * h; const unsigned char* Wl = WQ + 128 * (lane & 1) + 32 * (lane >> 4);
#define LD_E(dst0, dst1, t) { dst0 = *(const u32x4*)(Eh + (size_t)(t) * 128); dst1 = *(const u32x4*)(Eh + (size_t)(t) * 128 + 8); }
#define LD_A(dst0, dst1, t) { dst0 = *(const u32x4*)(Wl + (size_t)(t) * 256); dst1 = *(const u32x4*)(Wl + (size_t)(t) * 256 + 16); }
    SliceBuf bA, bB; u32x4 ea0, ea1, eb0, eb1, ec0, ec1, wa0, wa1, wb0, wb1;
    LD_E(ea0, ea1, t0) LD_A(wa0, wa1, t0) LD_E(eb0, eb1, t0 + 1)
    slice_load(bA, Vs, ea0, ea1);
#pragma unroll 1
    for (int i = 0; i < TPW; i += 2) { const int t = t0 + i; const int t2 = (i + 2 < TPW) ? t + 2 : t, t3 = (i + 3 < TPW) ? t + 3 : t;
        LD_E(ec0, ec1, t2) LD_A(wb0, wb1, t + 1)
        slice_load(bB, Vs, eb0, eb1);
        v5_token(bA, wa0, wa1, PO + (size_t)t * DM, SSQ + t, lane, stg);
        LD_E(eb0, eb1, t3) LD_A(wa0, wa1, t2)
        slice_load(bA, Vs, ec0, ec1);
        v5_token(bB, wb0, wb1, PO + (size_t)(t + 1) * DM, SSQ + t + 1, lane, stg);
    }
#undef LD_A
#undef LD_E
}
#ifndef LD_E
#define LD_E(dst0, dst1, t) { dst0 = *(const u32x4*)(Eh + (size_t)(t) * 128); dst1 = *(const u32x4*)(Eh + (size_t)(t) * 128 + 8); }
#endif
__device__ __forceinline__ void v_item(const Ctx& c, int s, int tb) {
    const unsigned short* EID = (const unsigned short*)(c.ws + WS_EID); const float* WW = (const float*)(c.ws + WS_WW);
    bf16* PO = (bf16*)(c.ws + WS_RA) + (V4_TABLE ? 256 : 128) * s; float* SSQ = (float*)(c.ws + WS_SSQ) + (size_t)s * ML;
    const int lane = c.lane, h = lane >> 3, cc = lane & 7;
    const unsigned char* Vs = c.ws + WS_RC + 96 * MiB + (size_t)s * (16384 * 128) + 16 * cc;
    const int t0 = tb * (8 * TPW) + c.wave * TPW;
    const unsigned short* Eh = EID + 16 * h; const float* Wh = WW + 16 * h;
#define LD_W(dst, t) { _Pragma("unroll") for (int j_ = 0; j_ < 4; ++j_) dst[j_] = *(const f32x4*)(Wh + (size_t)(t) * 128 + 4 * j_); }
    SliceBuf bA, bB; u32x4 ea0, ea1, eb0, eb1, ec0, ec1; f32x4 wa[4], wb[4];
    LD_E(ea0, ea1, t0) LD_W(wa, t0) LD_E(eb0, eb1, t0 + 1)
    slice_load(bA, Vs, ea0, ea1);
#pragma unroll 1
    for (int i = 0; i < TPW; i += 2) { const int t = t0 + i; const int t2 = (i + 2 < TPW) ? t + 2 : t, t3 = (i + 3 < TPW) ? t + 3 : t;
        LD_E(ec0, ec1, t2) LD_W(wb, t + 1)
        slice_load(bB, Vs, eb0, eb1);
        if (V4_TABLE) v4_token(bA, wa, PO + (size_t)t * DM, SSQ + t, lane); else v_token(bA, wa, PO + (size_t)t * DM, SSQ + t, lane);
        LD_E(eb0, eb1, t3) LD_W(wa, t2)
        slice_load(bA, Vs, ec0, ec1);
        if (V4_TABLE) v4_token(bB, wb, PO + (size_t)(t + 1) * DM, SSQ + t + 1, lane); else v_token(bB, wb, PO + (size_t)(t + 1) * DM, SSQ + t + 1, lane);
    }
#undef LD_W
#undef LD_E
}
__device__ __forceinline__ void reduce_range(const Ctx& c, int i0, int i1, int st);
__device__ __forceinline__ void final_range(const Ctx& c, int m0, int m1, int st, float* dst);
__device__ __forceinline__ void final_block(const Ctx& c, int m0, int nrows);
constexpr int CW_FINU = 10240, CW_FINV = 11264;
__device__ __forceinline__ bool arrive_last(unsigned* cnt, unsigned need, volatile LAS int* flag) {
    asm volatile("s_waitcnt vmcnt(0)" ::: "memory");
    __syncthreads();
    if (threadIdx.x == 0) {
        const unsigned old = __hip_atomic_fetch_add(cnt, 1u, __ATOMIC_RELAXED, __HIP_MEMORY_SCOPE_AGENT);
        const int last = (old == need - 1u);
        if (last) { __builtin_amdgcn_fence(__ATOMIC_ACQUIRE, "agent"); asm volatile("s_waitcnt vmcnt(0)" ::: "memory"); }
        *flag = last;
    }
    __syncthreads(); const int v = *flag; __syncthreads(); return v != 0;
}
template <int WHICH> __device__ __forceinline__ void slice_pass(const Ctx& c) {
    unsigned* ctr = (unsigned*)(c.ws + WS_CTL) + (WHICH == 0 ? CW_PEERU : CW_PEERV) + 32 * c.qsel;
    unsigned* fin = (unsigned*)(c.ws + WS_CTL) + (WHICH == 0 ? CW_FINU : CW_FINV) + 512 * c.qsel;
    volatile LAS int* slot = (volatile LAS int*)((LAS unsigned char*)c.lds + MISC_OFF + 64);
    const int xcc = (int)(xb_xcc_id() & 7u);
    constexpr int NS = ((WHICH == 0 && U4_TABLE) || (WHICH == 1 && V4_TABLE)) ? 4 : 8;
    for (int so = 0; so < NS; ++so) { const int s = (xcc + so) & (NS - 1);
        for (;;) { const int tb = grab_item(ctr + 64 * s, slot); if (tb >= NTB) break;
            if (WHICH == 0) { if (U4_TABLE) u4_item(c, s, tb); else u_item(c, s, tb); } else { if (V5_MFMA) v5_item(c, s, tb); else v_item(c, s, tb); }
            if (FUSE_TAIL) { if (arrive_last(fin + tb, (unsigned)NS, slot + 1)) {
                if (WHICH == 0) reduce_range(c, tb * (8 * TPW * 32) + c.tid, (tb + 1) * (8 * TPW * 32), 512);
                else final_block(c, tb * (8 * TPW), 8 * TPW); } } } }
}
__device__ __forceinline__ void phase10(const Ctx& c) { slice_pass<0>(c); }
__device__ __forceinline__ void reduce_range(const Ctx& c, int i0, int i1, int st) {
    const bf16* PD = (const bf16*)(c.ws + WS_RA); const float* GT = (const float*)(c.ws + WS_GT); float* WW = (float*)(c.ws + WS_WW);
    const float sc = U4_TABLE ? 1.f / (USCALE * XSCALE) : 1.f / (TSCALE * XSCALE);
#pragma unroll 4
    for (int idx = i0; idx < i1; idx += st) { const int t = idx >> 5, m = idx & 31, j = m >> 1, h0 = 4 * (m & 1);
        f32x4 s = {0.f, 0.f, 0.f, 0.f};
#pragma unroll
        for (int q = 0; q < (U4_TABLE ? 4 : 8); ++q) { const u32x2 w = ((const u32x2*)(PD + (size_t)q * ML * 128))[idx];
            s.x += __uint_as_float(w.x << 16); s.y += __uint_as_float(w.x & 0xffff0000u); s.z += __uint_as_float(w.y << 16); s.w += __uint_as_float(w.y & 0xffff0000u); }
        if (V5_MFMA) {
            float a[4], r[4];
#pragma unroll
            for (int e = 0; e < 4; ++e) a[e] = GT[(size_t)t * 128 + 16 * (h0 + e) + j] * gelu_tanh(s[e] * sc) * WSC;
            const unsigned hi = (unsigned)__builtin_amdgcn_cvt_pk_fp8_f32(a[2], a[3], __builtin_amdgcn_cvt_pk_fp8_f32(a[0], a[1], 0, false), true);
            const f32x2_t d0 = __builtin_amdgcn_cvt_pk_f32_fp8((int)hi, false), d1 = __builtin_amdgcn_cvt_pk_f32_fp8((int)hi, true);
            r[0] = (a[0] - d0.x) * WLO; r[1] = (a[1] - d0.y) * WLO; r[2] = (a[2] - d1.x) * WLO; r[3] = (a[3] - d1.y) * WLO;
            const unsigned lo = (unsigned)__builtin_amdgcn_cvt_pk_fp8_f32(r[2], r[3], __builtin_amdgcn_cvt_pk_fp8_f32(r[0], r[1], 0, false), true);
            unsigned char* wq = (unsigned char*)WW + (size_t)t * 256 + 32 * ((m >> 2) & 3) + 16 * (m >> 4) + 4 * (m & 3);
            *(unsigned*)wq = hi; *(unsigned*)(wq + 128) = lo;
        } else {
#pragma unroll
        for (int e = 0; e < 4; ++e) { const int k = 16 * (h0 + e) + j; WW[(size_t)t * 128 + k] = GT[(size_t)t * 128 + k] * gelu_tanh(s[e] * sc) * (V4_TABLE ? 1.f / USCALE : 1.f / TSCALE); } } }
}
__device__ __forceinline__ void phase11(const Ctx& c) { reduce_range(c, c.gtid, ML * 128 / 4, c.gsz); }
__device__ __forceinline__ void phase12(const Ctx& c) { slice_pass<1>(c); }
__device__ __forceinline__ void final_range(const Ctx& c, int m0, int m1, int st, float* dst = nullptr) {
    const bf16* PO = (const bf16*)(c.ws + WS_RA); const float* SSQ = (const float*)(c.ws + WS_SSQ); float* X1 = c.out; const bf16* X1b = (const bf16*)(c.ws + WS_X1); const float* MOD = (const float*)(c.ws + WS_MOD);
    const float* gpost = c.in[I_GPOSTFFN]; float* O = dst ? dst : X1;
    for (int m = m0; m < m1; m += 2 * st) {
        const int mb = (m + st < m1) ? m + st : m;
        float ssa = 0.f, ssb = 0.f; u32x2 pwa[4], pwb[4], xwa[4], xwb[4];
#pragma unroll
        for (int q = 0; q < (V4_TABLE ? 4 : 8); ++q) { ssa += SSQ[(size_t)q * ML + m]; ssb += SSQ[(size_t)q * ML + mb]; }
#pragma unroll
        for (int j = 0; j < 4; ++j) { const int col = 4 * c.lane + 256 * j;
            pwa[j] = *(const u32x2*)(PO + (size_t)m * DM + col); xwa[j] = *(const u32x2*)(X1b + (size_t)m * DM + col);
            pwb[j] = *(const u32x2*)(PO + (size_t)mb * DM + col); xwb[j] = *(const u32x2*)(X1b + (size_t)mb * DM + col); }
        const float rinva = rsqrtf(ssa * (1.f / DM) + EPS), rinvb = rsqrtf(ssb * (1.f / DM) + EPS);
        const float* gt2a = MOD + (m / SEQ) * NMOD + MOD_GT2; const float* gt2b = MOD + (mb / SEQ) * NMOD + MOD_GT2;
#pragma unroll
        for (int j = 0; j < 4; ++j) { const int col = 4 * c.lane + 256 * j;
            const f32x4 gg = *(const f32x4*)(gpost + col), gta = *(const f32x4*)(gt2a + col), gtb = *(const f32x4*)(gt2b + col);
            f32x4 po, xx;
            po.x = __uint_as_float(pwa[j].x << 16); po.y = __uint_as_float(pwa[j].x & 0xffff0000u); po.z = __uint_as_float(pwa[j].y << 16); po.w = __uint_as_float(pwa[j].y & 0xffff0000u);
            xx.x = __uint_as_float(xwa[j].x << 16); xx.y = __uint_as_float(xwa[j].x & 0xffff0000u); xx.z = __uint_as_float(xwa[j].y << 16); xx.w = __uint_as_float(xwa[j].y & 0xffff0000u);
            *(f32x4*)(O + (size_t)m * DM + col) = xx + gta * (po * rinva * gg);
            po.x = __uint_as_float(pwb[j].x << 16); po.y = __uint_as_float(pwb[j].x & 0xffff0000u); po.z = __uint_as_float(pwb[j].y << 16); po.w = __uint_as_float(pwb[j].y & 0xffff0000u);
            xx.x = __uint_as_float(xwb[j].x << 16); xx.y = __uint_as_float(xwb[j].x & 0xffff0000u); xx.z = __uint_as_float(xwb[j].y << 16); xx.w = __uint_as_float(xwb[j].y & 0xffff0000u);
            *(f32x4*)(O + (size_t)mb * DM + col) = xx + gtb * (po * rinvb * gg); }
    }
}
__device__ __forceinline__ void phase13(const Ctx& c) { if (PROBE_DBL == 13) final_range(c, c.gw, ML, c.ngw, (float*)(c.ws + WS_RB)); final_range(c, c.gw, ML, c.ngw); }
__device__ __forceinline__ void final_block(const Ctx& c, int m0, int nrows) {
    const bf16* PO = (const bf16*)(c.ws + WS_RA); const float* SSQ = (const float*)(c.ws + WS_SSQ); float* X1 = c.out; const float* MOD = (const float*)(c.ws + WS_MOD);
    const float* gpost = c.in[I_GPOSTFFN]; const float* gt2 = MOD + (m0 / SEQ) * NMOD + MOD_GT2;
    f32x4 gg[4];
#pragma unroll
    for (int j = 0; j < 4; ++j) { const int col = 4 * c.lane + 256 * j; gg[j] = *(const f32x4*)(gpost + col) * *(const f32x4*)(gt2 + col); }
    for (int r0 = c.wave; r0 < nrows; r0 += 32) {
        float ss[4]; u32x2 pw[4][4]; f32x4 xx[4][4];
#pragma unroll
        for (int r = 0; r < 4; ++r) { const int m = m0 + r0 + 8 * r; ss[r] = 0.f;
#pragma unroll
            for (int q = 0; q < (V4_TABLE ? 4 : 8); ++q) ss[r] += SSQ[(size_t)q * ML + m];
#pragma unroll
            for (int j = 0; j < 4; ++j) { const int col = 4 * c.lane + 256 * j; pw[r][j] = *(const u32x2*)(PO + (size_t)m * DM + col); xx[r][j] = *(const f32x4*)(X1 + (size_t)m * DM + col); } }
#pragma unroll
        for (int r = 0; r < 4; ++r) { const int m = m0 + r0 + 8 * r; const float rinv = rsqrtf(ss[r] * (1.f / DM) + EPS);
#pragma unroll
            for (int j = 0; j < 4; ++j) { const int col = 4 * c.lane + 256 * j; f32x4 po;
                po.x = __uint_as_float(pw[r][j].x << 16); po.y = __uint_as_float(pw[r][j].x & 0xffff0000u); po.z = __uint_as_float(pw[r][j].y << 16); po.w = __uint_as_float(pw[r][j].y & 0xffff0000u);
                *(f32x4*)(X1 + (size_t)m * DM + col) = xx[r][j] + gg[j] * (po * rinv); } }
    }
}

constexpr int NPHASE = SLICED_PEER ? (FUSE_TAIL ? 12 : 14) : 10;
__global__ void __launch_bounds__(512, 2) mega(Args args) {
    extern __shared__ __attribute__((aligned(16))) unsigned char lds[];
    Ctx c; c.in = args.in; c.out = args.out; c.ws = args.ws; c.lds = lds;
    c.tid = threadIdx.x; c.lane = c.tid & 63; c.wave = __builtin_amdgcn_readfirstlane(c.tid >> 6);
    c.qsel = 0; c.bid = blockIdx.x; c.nblk = gridDim.x; c.gw = c.bid * 8 + c.wave; c.ngw = c.nblk * 8; c.gtid = c.bid * 512 + c.tid; c.gsz = c.nblk * 512;
    volatile LAS unsigned* MISC = (volatile LAS unsigned*)((LAS unsigned char*)lds + MISC_OFF);
    if (c.tid < 32) MISC[c.tid] = 0u;
    __syncthreads();
    const int lo = args.ph_lo, hi = args.ph_hi;
    XcdBarrier bar; bar.bar = (unsigned*)(args.ws + WS_CTL) + CW_BAR; bar.x = 0; bar.st = nullptr;
    if (hi - lo > 1) bar = xcd_barrier_post((unsigned*)(args.ws + WS_CTL) + CW_BAR, MISC + 8);
#define PHASE(k, fn) if (lo <= (k) && (k) < hi) { if (PROBE_DBL == 5 && (k) == 5) { c.qsel = 1; fn(c); c.qsel = 0; xcd_barrier(bar); } fn(c); if (PROBE_DBL == (k) && (k) != 4 && (k) != 13 && (k) != 5) { xcd_barrier(bar); c.qsel = 1; fn(c); c.qsel = 0; } if ((k) + 1 < hi) { xcd_barrier(bar); if (PROBE_DBL == 99) xcd_barrier(bar); } }
    PHASE(0, phase0)
    PHASE(1, phase1)
    PHASE(2, phase2)
#if FAST_SSD
    PHASE(3, phase3f)
    PHASE(4, phase4f)
    PHASE(5, phase5f)
#else
    PHASE(3, phase3)
    PHASE(4, phase4)
    PHASE(5, phase5)
#endif
    PHASE(6, phase6)
    PHASE(7, phase7)
    PHASE(8, phase8)
    if (PROBE_DBL == 90 || PROBE_DBL == 91) { if (lo <= 8 && 8 < hi) { phase9_probe(c, PROBE_DBL == 90 ? 0x3ffu : 0x3fffu); xcd_barrier(bar); } }
#if SLICED_PEER && FUSE_TAIL
    PHASE(9, phase9s)
    PHASE(10, phase10)
    PHASE(11, phase12)
#elif SLICED_PEER
    PHASE(9, phase9s)
    PHASE(10, phase10)
    PHASE(11, phase11)
    PHASE(12, phase12)
    PHASE(13, phase13)
#else
    PHASE(9, phase9)
#endif
#undef PHASE
}

extern "C" void kernel_launch(void* const* d_in, const int* in_sizes, int n_in, void* d_out, int out_size, void* d_ws, size_t ws_size, hipStream_t stream) {
    static int grid = 0;
    if (grid == 0) {
        if (n_in != 24 || out_size != ML * DM || ws_size < WS_END) { fprintf(stderr, "kernel_launch: unexpected shapes n_in %d out %d ws %zu\n", n_in, out_size, ws_size); grid = -1; return; }
        int dev = 0, cus = 0;
        if (hipGetDevice(&dev) != hipSuccess || hipDeviceGetAttribute(&cus, hipDeviceAttributeMultiprocessorCount, dev) != hipSuccess) { grid = -1; return; }
        if (hipFuncSetAttribute((const void*)mega, hipFuncAttributeMaxDynamicSharedMemorySize, LDS_BYTES) != hipSuccess) { fprintf(stderr, "kernel_launch: hipFuncSetAttribute failed\n"); grid = -1; return; }
        int per_cu = 0;
        if (hipOccupancyMaxActiveBlocksPerMultiprocessor(&per_cu, (const void*)mega, 512, LDS_BYTES) != hipSuccess || per_cu < 1) fprintf(stderr, "kernel_launch: occupancy query says %d\n", per_cu);
        (void)hipGetLastError();
        grid = cus;
    }
    if (grid < 0) return;
    (void)hipMemsetAsync((char*)d_ws + WS_CTL, 0, CTL_ZERO_BYTES, stream);
    Args a{};
    for (int i = 0; i < 24; ++i) a.in[i] = (const float*)d_in[i];
    a.out = (float*)d_out; a.ws = (unsigned char*)d_ws;
#if N_LAUNCH_PER_PHASE
    for (int p = 0; p < NPHASE; ++p) { a.ph_lo = p; a.ph_hi = p + 1; hipLaunchKernelGGL(mega, dim3(grid), dim3(512), LDS_BYTES, stream, a); }
#else
    a.ph_lo = 0; a.ph_hi = NPHASE; hipLaunchKernelGGL(mega, dim3(grid), dim3(512), LDS_BYTES, stream, a);
#endif
}
```

```cpp
#include <hip/hip_runtime.h>
#include <cstdio>
#include <cstdint>

#define LAS __attribute__((address_space(3)))
typedef unsigned short bf16;
typedef float f32x4 __attribute__((ext_vector_type(4)));
typedef unsigned u32x4 __attribute__((ext_vector_type(4)));
typedef unsigned u32x2 __attribute__((ext_vector_type(2)));

#ifndef G2_WGM
#define G2_WGM 8
#endif
#ifndef G3_WGM
#define G3_WGM 8
#endif
#ifndef G1_WGM
#define G1_WGM 2
#endif
#ifndef U4_TABLE
#define U4_TABLE 1
#endif
#ifndef SLICED_PEER
#define SLICED_PEER 1
#endif
#ifndef PROBE_DBL
#define PROBE_DBL -1
#endif
#ifndef FAST_SSD
#define FAST_SSD 1
#endif
#ifndef N_LAUNCH_PER_PHASE
#define N_LAUNCH_PER_PHASE 0
#endif

constexpr int NB = 4, SEQ = 8192, DM = 1024, CTXL = 256;
constexpr int ML = NB * SEQ, MC = NB * CTXL, MT = ML + MC;
constexpr int N1 = 6400, NMOD = 6144;
constexpr int HEADS = 16, GROUPS = 4;
constexpr float EPS = 1e-6f;
constexpr float STSCALE = 64.f;
constexpr float XSCALE = 16.f;
constexpr float USCALE = 64.f;
#ifndef V4_TABLE
#define V4_TABLE 1
#endif
#ifndef V5_MFMA
#define V5_MFMA 1
#endif
#ifndef FP8_GEMM2
#define FP8_GEMM2 1
#endif
#ifndef TABLES_IN_SELECT
#define TABLES_IN_SELECT 1
#endif
#ifndef FP4_HWCVT
#define FP4_HWCVT 1
#endif
#ifndef STATIC_SLICE_ITEMS
#define STATIC_SLICE_ITEMS 1
#endif
#ifndef EPI_NT
#define EPI_NT 1
#endif
#ifndef FP8_GEMM3
#define FP8_GEMM3 0
#endif
#ifndef PO_FP8
#define PO_FP8 1
#endif
#ifndef FP8_GEMM1
#define FP8_GEMM1 1
#endif
#ifndef G1_ALIGN
#define G1_ALIGN true
#endif
#ifndef FP8_SP2
#define FP8_SP2 true
#endif
#ifndef FP8_TPL
#define FP8_TPL FP8_GEMM2
#endif
#ifndef FUSE_TAIL
#define FUSE_TAIL 0
#endif
constexpr float WSC = 256.f, WLO = 16.f;
constexpr float POSCALE = 1024.f;
constexpr float YSCALE = 16.f, WOSCALE = 64.f, HSCALE = 16.f, WISCALE = 64.f;
constexpr float TSCALE = 32.f;
constexpr int MOD_SH1 = 0, MOD_SC1 = 1024, MOD_GT1 = 2048, MOD_SH2 = 3072, MOD_SC2 = 4096, MOD_GT2 = 5120;

constexpr size_t MiB = 1u << 20;
constexpr size_t WS_CTL = 0, CTL_ZERO_BYTES = 64 * 1024;
constexpr size_t WS_MOD = 1 * MiB;
constexpr size_t WS_DEC = 1 * MiB + 512 * 1024;
constexpr size_t WS_HC = 2 * MiB;
constexpr size_t WS_WIN = 6 * MiB;
constexpr size_t WS_WOUT = 19 * MiB;
constexpr size_t WS_WQK = 23 * MiB;
constexpr size_t WS_DT = 27 * MiB;
constexpr size_t WS_RA = 32 * MiB;
constexpr size_t WS_RB = 160 * MiB;
constexpr size_t WS_RC = 292 * MiB;
constexpr size_t WS_RE = 420 * MiB;
constexpr size_t WS_END = 484 * MiB;
constexpr size_t WS_X1 = WS_RE;
constexpr int CW_BAR = 1024;

constexpr int LDS_BYTES = 151552;
constexpr int MISC_OFF = LDS_BYTES - 128;

__device__ __forceinline__ float bf2f(bf16 b) { return __uint_as_float(((unsigned)b) << 16); }
__device__ __forceinline__ bf16 f2bf(float f) { unsigned u = __float_as_uint(f); return (bf16)((u + 0x7fffu + ((u >> 16) & 1u)) >> 16); }
#define LDS_BARRIER() do { asm volatile("s_waitcnt lgkmcnt(0)" ::: "memory"); __builtin_amdgcn_s_barrier(); asm volatile("" ::: "memory"); } while (0)
typedef __attribute__((ext_vector_type(2))) __bf16 bf16pair_t; typedef float f32pair_t __attribute__((ext_vector_type(2)));
__device__ __forceinline__ unsigned pk2(float lo, float hi) { const f32pair_t f = {lo, hi}; return __builtin_bit_cast(unsigned, __builtin_convertvector(f, bf16pair_t)); }
__device__ __forceinline__ float silu_f(float x) { return x * __builtin_amdgcn_rcpf(1.f + __expf(-x)); }
__device__ __forceinline__ float softplus_f(float x) { const float u = __expf(-fabsf(x)); const float l = u < 1e-3f ? u * (1.f - 0.5f * u) : __logf(1.f + u); return fmaxf(x, 0.f) + l; }
__device__ __forceinline__ float gelu_tanh(float x) { const float u = 0.7978845608028654f * (x + 0.044715f * x * x * x); return x * __builtin_amdgcn_rcpf(1.f + __expf(-2.f * u)); }
template <int CTRL> __device__ __forceinline__ float dpp_f(float v) { return __builtin_bit_cast(float, __builtin_amdgcn_update_dpp(0, __builtin_bit_cast(int, v), CTRL, 0xf, 0xf, true)); }
template <int CTRL> __device__ __forceinline__ unsigned dpp_u(unsigned v) { return (unsigned)__builtin_amdgcn_update_dpp(0, (int)v, CTRL, 0xf, 0xf, true); }
__device__ __forceinline__ float row16_sum(float v) { v += dpp_f<0xB1>(v); v += dpp_f<0x4E>(v); v += dpp_f<0x141>(v); v += dpp_f<0x140>(v); return v; }
__device__ __forceinline__ float wave_sum(float v) {
    v = row16_sum(v);
    { const unsigned u = __builtin_bit_cast(unsigned, v); auto r = __builtin_amdgcn_permlane16_swap(u, u, false, false); v = __builtin_bit_cast(float, (unsigned)r[0]) + __builtin_bit_cast(float, (unsigned)r[1]); }
    { const unsigned u = __builtin_bit_cast(unsigned, v); auto r = __builtin_amdgcn_permlane32_swap(u, u, false, false); v = __builtin_bit_cast(float, (unsigned)r[0]) + __builtin_bit_cast(float, (unsigned)r[1]); }
    return v;
}
__device__ __forceinline__ unsigned umax2(unsigned a, unsigned b) { return a > b ? a : b; }
__device__ __forceinline__ unsigned wave_umax(unsigned v) {
    v = umax2(v, dpp_u<0xB1>(v)); v = umax2(v, dpp_u<0x4E>(v)); v = umax2(v, dpp_u<0x141>(v)); v = umax2(v, dpp_u<0x140>(v));
    { auto r = __builtin_amdgcn_permlane16_swap(v, v, false, false); v = umax2((unsigned)r[0], (unsigned)r[1]); }
    { auto r = __builtin_amdgcn_permlane32_swap(v, v, false, false); v = umax2((unsigned)r[0], (unsigned)r[1]); }
    return v;
}

#define XB_TMO      128
#define XB_XCNT(j)  (256  + 64 * (j))
#define XB_XSUB(j)  (1280 + 64 * (j))
#define XB_XGEN(j)  (2304 + 64 * (j))
#define XB_TOP      3328
#define XB_TOPGEN   3392
#define XCD_BAR_WORDS 3456
#define XB_SPIN_CAP (1u << 22)
__device__ __forceinline__ unsigned xb_ld(unsigned* p)              { return __hip_atomic_load(p, __ATOMIC_RELAXED, __HIP_MEMORY_SCOPE_AGENT); }
__device__ __forceinline__ unsigned xb_add(unsigned* p, unsigned v) { return __hip_atomic_fetch_add(p, v, __ATOMIC_RELAXED, __HIP_MEMORY_SCOPE_AGENT); }
__device__ __forceinline__ unsigned xb_xcc_id() { return (unsigned)__builtin_amdgcn_s_getreg((3 << 11) | 20) & 0xFu; }
#define XB_SPIN(cond, bar) do { unsigned _sp = 0; while (cond) { __builtin_amdgcn_s_sleep(1); \
    if ((++_sp & 255u) == 0u) { if (xb_ld(&(bar)[XB_TMO])) break; if (_sp > XB_SPIN_CAP) { atomicAdd(&(bar)[XB_TMO], 1u); break; } } } } while (0)
struct XcdBarrier { unsigned* bar; unsigned x; volatile LAS unsigned* st; };
__device__ __forceinline__ XcdBarrier xcd_barrier_post(unsigned* bar, volatile LAS unsigned* st) {
    XcdBarrier b; b.bar = bar; b.x = xb_xcc_id(); b.st = st;
    if (threadIdx.x == 0) st[4] = xb_add(&bar[XB_XCNT(b.x)], 1u);
    return b;
}
__device__ __forceinline__ void xcd_barrier_complete(unsigned* bar, unsigned x, unsigned& nloc, unsigned& nx, unsigned& even32) {
    const unsigned G = gridDim.x * gridDim.y * gridDim.z;
    unsigned sum, cnt, mine, sp = 0u;
    for (;;) {
        sum = 0u; cnt = 0u; mine = 0u; even32 = 1u;
#pragma unroll
        for (unsigned j = 0; j < 16; ++j) { const unsigned c = xb_ld(&bar[XB_XCNT(j)]); sum += c; cnt += (c > 0u) ? 1u : 0u; mine = (j == x) ? c : mine; even32 &= (c == (j < 8u ? 32u : 0u)) ? 1u : 0u; }
        if (sum == G) break;
        __builtin_amdgcn_s_sleep(1);
        if ((++sp & 255u) == 0u) { if (xb_ld(&bar[XB_TMO])) break; if (sp > XB_SPIN_CAP) { atomicAdd(&bar[XB_TMO], 1u); break; } }
    }
    nloc = mine > 0u ? mine : 1u; nx = cnt > 0u ? cnt : 1u;
}
__device__ __forceinline__ void xcd_barrier(const XcdBarrier& b) {
    asm volatile("s_waitcnt vmcnt(0)" ::: "memory");
    __syncthreads();
    if (threadIdx.x == 0) {
        unsigned* bar = b.bar;
        __builtin_amdgcn_s_waitcnt(0);
        unsigned nloc = b.st[0], nx = b.st[1];
        if (nloc == 0u) { unsigned ev; xcd_barrier_complete(bar, b.x, nloc, nx, ev); b.st[0] = nloc; b.st[1] = nx; b.st[3] = ev; }
        const unsigned old = xb_add(&bar[XB_XSUB(b.x)], 1u);
        const unsigned gen = old / nloc;
        if (old + 1u == (gen + 1u) * nloc) {
            __builtin_amdgcn_fence(__ATOMIC_RELEASE, "agent");
            asm volatile("s_waitcnt vmcnt(0)" ::: "memory");
            const unsigned og = xb_add(&bar[XB_TOP], 1u);
            const unsigned tg = og / nx;
            if (og + 1u == (tg + 1u) * nx) xb_add(&bar[XB_TOPGEN], 1u);
            else XB_SPIN(xb_ld(&bar[XB_TOPGEN]) == tg, bar);
            xb_add(&bar[XB_XGEN(b.x)], 1u);
            __builtin_amdgcn_fence(__ATOMIC_ACQUIRE, "agent");
            asm volatile("s_waitcnt vmcnt(0)" ::: "memory");
        } else {
            XB_SPIN(xb_ld(&bar[XB_XGEN(b.x)]) == gen, bar);
            __builtin_amdgcn_fence(__ATOMIC_ACQUIRE, "agent");
            asm volatile("s_waitcnt vmcnt(0)" ::: "memory");
        }
    }
    __syncthreads();
}

namespace pg8 {
#define PG8_LAS __attribute__((address_space(3)))
typedef unsigned short bf16_t;
typedef short bf16x8 __attribute__((ext_vector_type(8)));
typedef float f32x4 __attribute__((ext_vector_type(4)));
typedef unsigned u32x4 __attribute__((ext_vector_type(4)));
constexpr int BM = 256, BK = 64, HALF = 128, HTB = HALF * BK * 2  , STAGE_BYTES = 8 * HTB, NXCD = 8, WGM = 8;

__host__ __device__ __forceinline__ int lds_byte(int r, int c) { const int st = (r >> 4) * 2 + (c >> 5), rr = r & 15, cc = c & 31, ob = rr * 64 + cc * 2; return st * 1024 + (ob ^ (((ob >> 9) & 1) << 5)); }
__host__ __device__ __forceinline__ void stage_rc(int b, int& R, int& C) { const int st = b / 1024, sb = b % 1024, swz = sb ^ (((sb >> 9) & 1) << 5); R = (st >> 1) * 16 + swz / 64; C = (st & 1) * 32 + (swz % 64) / 2; }
__host__ __device__ __forceinline__ int perm32(int rho) { const int n = rho >> 4, i = rho & 15; return 8 * (i >> 2) + 4 * n + (i & 3); }

struct Unit { int pm, pn; };
struct Gemm { const bf16_t* A; const bf16_t* Bt; int M, N, K; };

struct StaticOrder {
    int nM, nN, nwg, G, c, wgm;
    __host__ __device__ void init(int M, int N, int G_, int c_, int wgm_ = WGM) { nM = M / BM; nN = N / BM; nwg = nM * nN; G = G_; c = c_; wgm = wgm_; }
    __host__ __device__ bool next(int i, Unit& u) const {
        const long L = (long)i * G + c; if (L >= nwg) return false;
        int wgid = (int)L; { const int q = nwg / NXCD, r = nwg % NXCD, xcd = wgid % NXCD, off = wgid / NXCD; wgid = (xcd < r ? xcd * (q + 1) : r * (q + 1) + (xcd - r) * q) + off; }
        const int nig = wgm * nN, gid = wgid / nig, fm = gid * wgm, gsz = (nM - fm) < wgm ? (nM - fm) : wgm;
        u.pm = fm + ((wgid % nig) % gsz); u.pn = (wgid % nig) / gsz; return true;
    }
    __device__ __forceinline__ void a_ready(const Unit&) const {}
    __device__ __forceinline__ void done(const Unit&) const {}
};

__device__ __forceinline__ unsigned cvt_pk_bf16(float lo, float hi) { unsigned r; asm volatile("v_cvt_pk_bf16_f32 %0, %1, %2" : "=v"(r) : "v"(lo), "v"(hi)); return r; }
template <class Epi, class Sched, bool ALIGN_EPI = false, bool SP2 = false, bool FP8 = false>
__device__ __forceinline__ void gemm_phase(PG8_LAS unsigned char* lds, const Gemm g, const Sched& S, const Epi& E) {
    const int tid = threadIdx.x, wid = __builtin_amdgcn_readfirstlane(tid >> 6), lane = tid & 63, wr = wid >> 2, wc = wid & 3, fr = lane & 15, fq = lane >> 4;
    const int K = g.K, nt = K / BK;
    unsigned voffA[2], voffB[2];
#pragma unroll
    for (int i = 0; i < 2; ++i) { int R, C; stage_rc(tid * 16 + i * 8192, R, C); const int Rb = Epi::PERM ? (64 * (R >> 5) + perm32(R & 31)) : R;
        voffA[i] = (unsigned)(R * K + C) * 2u; voffB[i] = (unsigned)(Rb * K + C) * 2u; }
    const size_t kstep = (size_t)(BK * 2);
    const size_t hstep = (size_t)HALF * K * 2;
    const size_t hstepB = Epi::PERM ? (size_t)32 * K * 2 : hstep;
    const size_t tstep = 2 * hstep;
    const unsigned ldsw = (unsigned)wid * 1024u;
    const int aoff = lds_byte(wr * 64 + fr, fq * 8), boff = lds_byte(wc * 32 + fr, fq * 8);
#define PG8_SA(b, h) (((b) * 2 + (h)) * HTB)
#define PG8_SB(b, h) ((4 + (b) * 2 + (h)) * HTB)
#define PG8_STAGE(bufoff, gbase, voff) do { _Pragma("unroll") for (int _i = 0; _i < 2; ++_i) \
        __builtin_amdgcn_global_load_lds((const unsigned*)((const char*)(gbase) + (voff)[_i]), (PG8_LAS unsigned*)(lds + (bufoff) + ldsw + _i * 8192), 16, 0, 0); } while (0)
#define PG8_LDA(dst, b, h) do { _Pragma("unroll") for (int m = 0; m < 4; ++m) { if constexpr (FP8) { \
            const i32x4_ lo_ = *(const PG8_LAS i32x4_*)(lds + PG8_SA(b, h) + aoff + m * 2048), hi_ = *(const PG8_LAS i32x4_*)(lds + PG8_SA(b, h) + aoff + m * 2048 + 1024); \
            dst.wf[m] = __builtin_shufflevector(lo_, hi_, 0, 1, 2, 3, 4, 5, 6, 7); } \
        else { _Pragma("unroll") for (int k = 0; k < 2; ++k) dst.hf[m][k] = *(const PG8_LAS bf16x8*)(lds + PG8_SA(b, h) + aoff + m * 2048 + k * 1024); } } } while (0)
#define PG8_LDB(dst, b, h) do { _Pragma("unroll") for (int n = 0; n < 2; ++n) { if constexpr (FP8) { \
            const i32x4_ lo_ = *(const PG8_LAS i32x4_*)(lds + PG8_SB(b, h) + boff + n * 2048), hi_ = *(const PG8_LAS i32x4_*)(lds + PG8_SB(b, h) + boff + n * 2048 + 1024); \
            dst.wf[n] = __builtin_shufflevector(lo_, hi_, 0, 1, 2, 3, 4, 5, 6, 7); } \
        else { _Pragma("unroll") for (int k = 0; k < 2; ++k) dst.hf[n][k] = *(const PG8_LAS bf16x8*)(lds + PG8_SB(b, h) + boff + n * 2048 + k * 1024); } } } while (0)
#define PG8_MMA(ai, bj, At, Bt) do { __builtin_amdgcn_s_setprio(1); \
        if constexpr (FP8) { _Pragma("unroll") for (int m = 0; m < 4; ++m) _Pragma("unroll") for (int n = 0; n < 2; ++n) \
                asm volatile("v_mfma_scale_f32_16x16x128_f8f6f4 %0, %1, %2, %0, %3, %4 op_sel_hi:[0,0,0]" : "+v"(acc[ai][bj][m][n]) : "v"(Bt.wf[n]), "v"(At.wf[m]), "v"(scb_), "v"(sca_)); } \
        else { _Pragma("unroll") for (int m = 0; m < 4; ++m) _Pragma("unroll") for (int n = 0; n < 2; ++n) _Pragma("unroll") for (int k = 0; k < 2; ++k) \
            acc[ai][bj][m][n] = __builtin_amdgcn_mfma_f32_16x16x32_bf16(Bt.hf[n][k], At.hf[m][k], acc[ai][bj][m][n], 0, 0, 0); } \
        __builtin_amdgcn_s_setprio(0); } while (0)
#define PG8_WAIT_V(n) asm volatile("s_waitcnt vmcnt(" #n ")" ::: "memory")
#define PG8_WAIT_L(n) asm volatile("s_waitcnt lgkmcnt(" #n ")" ::: "memory")
#define PG8_BAR __builtin_amdgcn_s_barrier()
#define PG8_SCHED __builtin_amdgcn_sched_barrier(0)
    Unit cur, nxt; int ui = 0;
    if (!S.next(0, cur)) return;
    f32x4 acc[2][2][4][2];
#pragma unroll
    for (int a = 0; a < 2; ++a)
#pragma unroll
        for (int b = 0; b < 2; ++b)
#pragma unroll
            for (int m = 0; m < 4; ++m)
#pragma unroll
                for (int n = 0; n < 2; ++n) acc[a][b][m][n] = (f32x4){0.f, 0.f, 0.f, 0.f};
    typedef int i32x4_ __attribute__((ext_vector_type(4))); typedef int i32x8_ __attribute__((ext_vector_type(8)));
    struct FragA_ { bf16x8 hf[4][2]; i32x8_ wf[4]; }; struct FragB_ { bf16x8 hf[2][2]; i32x8_ wf[2]; };
    int sca_ = 127, scb_ = 127; if constexpr (FP8) { sca_ = Epi::SCA; scb_ = Epi::SCB; }
    FragA_ At; FragB_ B0, B1;
    const char* cA = (const char*)g.A + (size_t)cur.pm * tstep; const char* cB = (const char*)g.Bt + (size_t)cur.pn * tstep;
    S.a_ready(cur);
    if constexpr (SP2) {
        PG8_STAGE(PG8_SB(0, 0), cB, voffB); PG8_STAGE(PG8_SB(0, 1), cB + hstepB, voffB); PG8_STAGE(PG8_SA(0, 0), cA, voffA); PG8_STAGE(PG8_SA(0, 1), cA + hstep, voffA);
        if (wr == 1) PG8_BAR;
        PG8_WAIT_V(2); PG8_BAR;
        PG8_STAGE(PG8_SB(1, 0), cB + kstep, voffB); PG8_STAGE(PG8_SA(1, 0), cA + kstep, voffA); PG8_STAGE(PG8_SB(1, 1), cB + hstepB + kstep, voffB);
        PG8_WAIT_V(6); PG8_BAR;
    } else {
        PG8_STAGE(PG8_SB(0, 0), cB, voffB); PG8_STAGE(PG8_SA(0, 0), cA, voffA); PG8_STAGE(PG8_SB(0, 1), cB + hstepB, voffB); PG8_STAGE(PG8_SA(0, 1), cA + hstep, voffA);
        if (wr == 1) PG8_BAR;
        PG8_WAIT_V(4); PG8_BAR;
        PG8_STAGE(PG8_SB(1, 0), cB + kstep, voffB); PG8_STAGE(PG8_SA(1, 0), cA + kstep, voffA); PG8_STAGE(PG8_SB(1, 1), cB + hstepB + kstep, voffB);
        PG8_WAIT_V(6); PG8_BAR;
    }
    for (;;) {
        const bool has_next = S.next(ui + 1, nxt);
        const char* nA = has_next ? (const char*)g.A + (size_t)nxt.pm * tstep : cA; const char* nB = has_next ? (const char*)g.Bt + (size_t)nxt.pn * tstep : cB;
        for (int t = 0; t < nt; t += 2) {
            const bool last = (t == nt - 2);
            const char* a1 = cA + (size_t)(t + 1) * kstep;
            const char* a2 = last ? nA : cA + (size_t)(t + 2) * kstep; const char* b2 = last ? nB : cB + (size_t)(t + 2) * kstep;
            const char* a3 = a2 + kstep; const char* b3 = b2 + kstep;
            if (last && has_next) S.a_ready(nxt);
            if constexpr (SP2) {
            PG8_LDB(B0, 0, 0); PG8_LDB(B1, 0, 1); PG8_SCHED; PG8_LDA(At, 0, 0); PG8_STAGE(PG8_SA(1, 1), a1 + hstep, voffA);
            PG8_WAIT_V(8); PG8_WAIT_L(0); PG8_BAR; PG8_MMA(0, 0, At, B0); PG8_MMA(0, 1, At, B1); PG8_BAR; PG8_SCHED;
            PG8_LDA(At, 0, 1); PG8_STAGE(PG8_SB(0, 0), b2, voffB); PG8_STAGE(PG8_SB(0, 1), b2 + hstepB, voffB); PG8_STAGE(PG8_SA(0, 0), a2, voffA);
            PG8_WAIT_V(8); PG8_WAIT_L(0); PG8_BAR; PG8_MMA(1, 0, At, B0); PG8_MMA(1, 1, At, B1); PG8_BAR; PG8_SCHED;
            PG8_LDB(B0, 1, 0); PG8_LDB(B1, 1, 1); PG8_SCHED; PG8_LDA(At, 1, 0); PG8_STAGE(PG8_SA(0, 1), a2 + hstep, voffA);
            PG8_WAIT_V(8); PG8_WAIT_L(0); PG8_BAR; PG8_MMA(0, 0, At, B0); PG8_MMA(0, 1, At, B1); PG8_BAR; PG8_SCHED;
            PG8_LDA(At, 1, 1); PG8_STAGE(PG8_SB(1, 0), b3, voffB); PG8_STAGE(PG8_SB(1, 1), b3 + hstepB, voffB); PG8_STAGE(PG8_SA(1, 0), a3, voffA);
            PG8_WAIT_V(8); PG8_WAIT_L(0); PG8_BAR; PG8_MMA(1, 0, At, B0); PG8_MMA(1, 1, At, B1); PG8_BAR; PG8_SCHED;
            } else {
            PG8_LDB(B0, 0, 0); PG8_SCHED; PG8_LDA(At, 0, 0); PG8_STAGE(PG8_SA(1, 1), a1 + hstep, voffA);
            PG8_WAIT_L(8); PG8_BAR; PG8_WAIT_L(0); PG8_MMA(0, 0, At, B0); PG8_BAR; PG8_SCHED;
            PG8_LDB(B1, 0, 1); PG8_STAGE(PG8_SB(0, 0), b2, voffB);
            PG8_BAR; PG8_WAIT_L(0); PG8_MMA(0, 1, At, B1); PG8_BAR;
            PG8_LDA(At, 0, 1); PG8_STAGE(PG8_SA(0, 0), a2, voffA);
            PG8_BAR; PG8_WAIT_L(0); PG8_MMA(1, 0, At, B0); PG8_BAR; PG8_SCHED;
            PG8_STAGE(PG8_SB(0, 1), b2 + hstepB, voffB);
            PG8_WAIT_V(6); PG8_BAR; PG8_MMA(1, 1, At, B1); PG8_BAR;
            PG8_LDB(B0, 1, 0); PG8_SCHED; PG8_LDA(At, 1, 0); PG8_STAGE(PG8_SA(0, 1), a2 + hstep, voffA);
            PG8_WAIT_L(8); PG8_BAR; PG8_WAIT_L(0); PG8_MMA(0, 0, At, B0); PG8_BAR; PG8_SCHED;
            PG8_LDB(B1, 1, 1); PG8_STAGE(PG8_SB(1, 0), b3, voffB);
            PG8_BAR; PG8_WAIT_L(0); PG8_MMA(0, 1, At, B1); PG8_BAR;
            PG8_LDA(At, 1, 1); PG8_STAGE(PG8_SA(1, 0), a3, voffA);
            PG8_BAR; PG8_WAIT_L(0); PG8_MMA(1, 0, At, B0); PG8_BAR; PG8_SCHED;
            PG8_STAGE(PG8_SB(1, 1), b3 + hstepB, voffB);
            PG8_WAIT_V(6); PG8_BAR; PG8_MMA(1, 1, At, B1); PG8_BAR;
            }
        }
        if constexpr (ALIGN_EPI) { if (wr == 0) PG8_BAR; }
        if constexpr (FP8) asm volatile("s_nop 15\n\ts_nop 15" ::: "memory");
        if constexpr (!Epi::AFTER_DRAIN) { E(acc, cur, wr, wc, fr, fq);
            if (PROBE_DBL == 21) E(acc, cur, wr, wc, fr, fq);
            if (PROBE_DBL == 22) {
                unsigned char* dz = E.probe_base + (size_t)blockIdx.x * (96 * 1024) + (size_t)wid * (12 * 1024) + lane * 16;
                _Pragma("unroll") for (int ai = 0; ai < 2; ++ai) _Pragma("unroll") for (int m = 0; m < 4; ++m) _Pragma("unroll") for (int bj = 0; bj < 2; ++bj) {
                    const f32x4 v0 = acc[ai][bj][m][0], v1 = acc[ai][bj][m][1];
                    u32x4 w; w.x = cvt_pk_bf16(v0[0], v0[1]); w.y = cvt_pk_bf16(v0[2], v0[3]); w.z = cvt_pk_bf16(v1[0], v1[1]); w.w = cvt_pk_bf16(v1[2], v1[3]);
                    *(u32x4*)(dz + (((ai * 4 + m) * 2 + bj) % 12) * 1024) = w; } }
            S.done(cur); }
        if (!has_next) break;
#pragma unroll
        for (int a = 0; a < 2; ++a)
#pragma unroll
            for (int b = 0; b < 2; ++b)
#pragma unroll
                for (int m = 0; m < 4; ++m)
#pragma unroll
                    for (int n = 0; n < 2; ++n) acc[a][b][m][n] = (f32x4){0.f, 0.f, 0.f, 0.f};
        cur = nxt; cA = nA; cB = nB; ++ui;
        if constexpr (ALIGN_EPI) { if (wr == 1) PG8_BAR; }
    }
    PG8_WAIT_V(0);
    if constexpr (!ALIGN_EPI) { if (wr == 0) PG8_BAR; }
    PG8_BAR;
    if constexpr (Epi::AFTER_DRAIN) { E.fused(acc, cur, wr, wc, fr, fq, lds, wid, lane); S.done(cur); }
#undef PG8_SA
#undef PG8_SB
#undef PG8_STAGE
#undef PG8_LDA
#undef PG8_LDB
#undef PG8_MMA
#undef PG8_WAIT_V
#undef PG8_WAIT_L
#undef PG8_BAR
#undef PG8_SCHED
}
}

struct Args { const float* in[24]; float* out; unsigned char* ws; int ph_lo, ph_hi; };
struct Ctx {
    const float* const* in; float* out; unsigned char* ws; unsigned char* lds;
    int tid, lane, wave, gw, ngw, gtid, gsz, bid, nblk, qsel;
};
enum { I_X = 0, I_C, I_CTX, I_CCTX, I_WADA, I_BADA, I_GPREMIX, I_GPOSTMIX, I_GPREFFN, I_GPOSTFFN, I_WIN, I_CONVW, I_CONVB, I_DTBIAS, I_ALOG, I_DSKIP,
       I_SSDNORMG, I_SCCONVW, I_SCNORMG, I_WOUT, I_WQ, I_KEYS, I_U, I_V };

__device__ __forceinline__ unsigned pk4_fp8(float a, float b, float c_, float d, float s) {
    a = __builtin_amdgcn_fmed3f(a * s, -440.f, 440.f); b = __builtin_amdgcn_fmed3f(b * s, -440.f, 440.f); c_ = __builtin_amdgcn_fmed3f(c_ * s, -440.f, 440.f); d = __builtin_amdgcn_fmed3f(d * s, -440.f, 440.f);
    return (unsigned)__builtin_amdgcn_cvt_pk_fp8_f32(c_, d, __builtin_amdgcn_cvt_pk_fp8_f32(a, b, 0, false), true);
}
__device__ __forceinline__ void transpose_item(const float* W, int K, int N, bf16* WT, int row_off, float* scr, int item, int lane) {
    const int nblk = N / 32, kb = item / nblk, nb = item % nblk, k0 = 64 * kb, n0 = 32 * nb;
#pragma unroll
    for (int i = 0; i < 8; ++i) { const int kk = 8 * i + (lane >> 3), c4 = (lane & 7) * 4; const f32x4 v = *(const f32x4*)(W + (size_t)(k0 + kk) * N + n0 + c4);
        float* d = scr + kk * 33 + c4; d[0] = v.x; d[1] = v.y; d[2] = v.z; d[3] = v.w; }
    asm volatile("s_waitcnt lgkmcnt(0)" ::: "memory");
    const int c = lane & 7;
#pragma unroll
    for (int j = 0; j < 4; ++j) { const int n = (lane >> 3) + 8 * j; const float* s = scr + (8 * c) * 33 + n;
        u32x4 o; o.x = pk2(s[0 * 33], s[1 * 33]); o.y = pk2(s[2 * 33], s[3 * 33]); o.z = pk2(s[4 * 33], s[5 * 33]); o.w = pk2(s[6 * 33], s[7 * 33]);
        *(u32x4*)(WT + (size_t)(row_off + n0 + n) * K + k0 + 8 * c) = o; }
    asm volatile("s_waitcnt lgkmcnt(0)" ::: "memory");
}

__device__ __forceinline__ void transpose_item_fp8(const float* W, int K, int N, unsigned char* WT, int row_off, float* scr, int item, int lane, float sc) {
    const int nblk = N / 32, kb = item / nblk, nb = item % nblk, k0 = 64 * kb, n0 = 32 * nb;
#pragma unroll
    for (int i = 0; i < 8; ++i) { const int kk = 8 * i + (lane >> 3), c4 = (lane & 7) * 4; const f32x4 v = *(const f32x4*)(W + (size_t)(k0 + kk) * N + n0 + c4);
        float* d = scr + kk * 33 + c4; d[0] = v.x; d[1] = v.y; d[2] = v.z; d[3] = v.w; }
    asm volatile("s_waitcnt lgkmcnt(0)" ::: "memory");
    const int c = lane & 7;
#pragma unroll
    for (int j = 0; j < 4; ++j) { const int n = (lane >> 3) + 8 * j; const float* s = scr + (8 * c) * 33 + n;
        u32x2 o;
        o.x = (unsigned)__builtin_amdgcn_cvt_pk_fp8_f32(s[2 * 33] * sc, s[3 * 33] * sc, __builtin_amdgcn_cvt_pk_fp8_f32(s[0 * 33] * sc, s[1 * 33] * sc, 0, false), true);
        o.y = (unsigned)__builtin_amdgcn_cvt_pk_fp8_f32(s[6 * 33] * sc, s[7 * 33] * sc, __builtin_amdgcn_cvt_pk_fp8_f32(s[4 * 33] * sc, s[5 * 33] * sc, 0, false), true);
        *(u32x2*)(WT + (size_t)(row_off + n0 + n) * K + k0 + 8 * c) = o; }
    asm volatile("s_waitcnt lgkmcnt(0)" ::: "memory");
}

__device__ __forceinline__ void phase0(const Ctx& c) {
    float* sct = (float*)c.lds;
    float* red = (float*)(c.lds + 20480);
    float* scr = (float*)(c.lds + 32768 + c.wave * 8704);
    const float* cvec = c.in[I_C]; const float* cctx = c.in[I_CCTX];
    for (int i = c.tid; i < 5 * 1024; i += 512) { const int v = i >> 10, k = i & 1023; const float x = v < 4 ? cvec[v * 1024 + k] : cctx[k]; sct[i] = silu_f(x); }
    __syncthreads();
    float* MOD = (float*)(c.ws + WS_MOD);
    const float* w_ada = c.in[I_WADA]; const float* b_ada = c.in[I_BADA];
    for (int item = c.bid; item < NMOD / 64; item += c.nblk) {
        const int j = item * 64 + c.lane; float acc[5] = {0.f, 0.f, 0.f, 0.f, 0.f};
#pragma unroll 1
        for (int k0 = c.wave * 128; k0 < c.wave * 128 + 128; k0 += 32) { float wv[32];
#pragma unroll
            for (int u = 0; u < 32; ++u) wv[u] = w_ada[(size_t)(k0 + u) * NMOD + j];
            __builtin_amdgcn_sched_barrier(0);
#pragma unroll
            for (int u = 0; u < 32; ++u) {
#pragma unroll
                for (int v = 0; v < 5; ++v) acc[v] += sct[v * 1024 + k0 + u] * wv[u]; }
            __builtin_amdgcn_sched_barrier(0); }
#pragma unroll
        for (int v = 0; v < 5; ++v) red[(c.wave * 64 + c.lane) * 5 + v] = acc[v];
        __syncthreads();
        if (c.wave == 0) { const float bj = b_ada[j];
#pragma unroll
            for (int v = 0; v < 5; ++v) { float s = bj;
                for (int w8 = 0; w8 < 8; ++w8) s += red[(w8 * 64 + c.lane) * 5 + v];
                MOD[v * NMOD + j] = s; } }
        __syncthreads();
    }
    bf16* WinT = (bf16*)(c.ws + WS_WIN); bf16* WoutT = (bf16*)(c.ws + WS_WOUT); bf16* WqkT = (bf16*)(c.ws + WS_WQK);
    constexpr int NIN = 6176, I_IN = (1024 / 64) * (NIN / 32), I_OUT = (2048 / 64) * (1024 / 32);
    const bool split = c.nblk >= NMOD / 64 + 64; const int hb = split ? NMOD / 64 : 0;
    for (int it = c.ngw - 1 - c.gw; it < I_IN + I_OUT; it += c.ngw) {
        if (it < I_IN) { const int nb = it % (NIN / 32); if (FP8_GEMM1) transpose_item_fp8(c.in[I_WIN], 1024, NIN, (unsigned char*)WinT, nb >= 97 ? 224 : 0, scr, it, c.lane, WISCALE); else transpose_item(c.in[I_WIN], 1024, NIN, WinT, nb >= 97 ? 224 : 0, scr, it, c.lane); }
        else if (FP8_GEMM2) transpose_item_fp8(c.in[I_WOUT], 2048, 1024, (unsigned char*)WoutT, 0, scr, it - I_IN, c.lane, WOSCALE);
        else transpose_item(c.in[I_WOUT], 2048, 1024, WoutT, 0, scr, it - I_IN, c.lane);
    }
    if (c.bid < hb) return;
    const int hgw = (c.bid - hb) * 8 + c.wave, hngw = (c.nblk - hb) * 8, hgtid = (c.bid - hb) * 512 + c.tid, hgsz = (c.nblk - hb) * 512;
    { u32x4* z = FP8_GEMM1 ? (u32x4*)((unsigned char*)WinT + (size_t)3104 * 1024) : (u32x4*)(WinT + (size_t)3104 * 1024); const u32x4 zz = {0u, 0u, 0u, 0u};
      for (int i = hgtid; i < 224 * 1024 / (FP8_GEMM1 ? 16 : 8); i += hgsz) z[i] = zz; }
    { typedef short bf16x8_l __attribute__((ext_vector_type(8)));
      const float* wq = c.in[I_WQ]; const float* keys = c.in[I_KEYS]; const int fr = c.lane & 15, fq = c.lane >> 4;
      for (int it = hgw; it < 16 * 64; it += hngw) { const int hp = it >> 6, kt = it & 63;
          bf16x8_l af[4];
#pragma unroll
          for (int ks = 0; ks < 4; ++ks) { const f32x4* a = (const f32x4*)(wq + (size_t)(16 * kt + fr) * 2048 + hp * 128 + 32 * ks + 8 * fq); const f32x4 a0 = a[0], a1 = a[1];
              u32x4 w; w.x = pk2(a0.x, a0.y); w.y = pk2(a0.z, a0.w); w.z = pk2(a1.x, a1.y); w.w = pk2(a1.z, a1.w); af[ks] = __builtin_bit_cast(bf16x8_l, w); }
#pragma unroll 2
          for (int nt = 0; nt < 8; ++nt) { f32x4 acc = {0.f, 0.f, 0.f, 0.f};
#pragma unroll
              for (int ks = 0; ks < 4; ++ks) { const f32x4* b = (const f32x4*)(keys + (size_t)(hp * 128 + 16 * nt + fr) * 128 + 32 * ks + 8 * fq); const f32x4 b0 = b[0], b1 = b[1];
                  u32x4 w; w.x = pk2(b0.x, b0.y); w.y = pk2(b0.z, b0.w); w.z = pk2(b1.x, b1.y); w.w = pk2(b1.z, b1.w);
                  acc = __builtin_amdgcn_mfma_f32_16x16x32_bf16(af[ks], __builtin_bit_cast(bf16x8_l, w), acc, 0, 0, 0); }
              if (FP8_GEMM3) *(unsigned*)((unsigned char*)WqkT + (size_t)(hp * 128 + 16 * nt + fr) * 1024 + 16 * kt + 4 * fq) = pk4_fp8(acc[0], acc[1], acc[2], acc[3], WISCALE);
              else { u32x2 o; o.x = pk2(acc[0], acc[1]); o.y = pk2(acc[2], acc[3]);
              *(u32x2*)(WqkT + (size_t)(hp * 128 + 16 * nt + fr) * 1024 + 16 * kt + 4 * fq) = o; } } } }
}

__device__ __forceinline__ void phase1(const Ctx& c) {
    bf16* H = (bf16*)c.out; const float* MOD = (const float*)(c.ws + WS_MOD); const float* g = c.in[I_GPREMIX];
    f32x4 xn[4];
#define P1_ROW(m_) ((m_) < ML ? c.in[I_X] + (size_t)(m_) * DM : c.in[I_CTX] + (size_t)((m_) - ML) * DM)
#define P1_LOAD(m_) { const f32x4* x4_ = (const f32x4*)P1_ROW(m_) + c.lane; _Pragma("unroll") for (int j = 0; j < 4; ++j) xn[j] = x4_[64 * j]; }
    if (c.gw < MT) P1_LOAD(c.gw)
    f32x4 gv[4];
#pragma unroll
    for (int j = 0; j < 4; ++j) gv[j] = *(const f32x4*)(g + 4 * c.lane + 256 * j);
    for (int m = c.gw; m < MT; m += c.ngw) {
        const int v = m < ML ? m / SEQ : 4;
        const float* mv = MOD + v * NMOD;
        f32x4 shv[4], scv[4];
#pragma unroll
        for (int j = 0; j < 4; ++j) { const int col = 4 * c.lane + 256 * j; shv[j] = *(const f32x4*)(mv + MOD_SH1 + col); scv[j] = *(const f32x4*)(mv + MOD_SC1 + col); }
        f32x4 xv[4]; float ss = 0.f;
#pragma unroll
        for (int j = 0; j < 4; ++j) { xv[j] = xn[j]; ss += xv[j].x * xv[j].x + xv[j].y * xv[j].y + xv[j].z * xv[j].z + xv[j].w * xv[j].w; }
        { const int mn = (m + c.ngw < MT) ? m + c.ngw : m; P1_LOAD(mn) }
        const float rinv = rsqrtf(wave_sum(ss) * (1.f / DM) + EPS);
#pragma unroll
        for (int j = 0; j < 4; ++j) { const int col = 4 * c.lane + 256 * j;
            const f32x4 gg = gv[j], sh = shv[j], sc = scv[j];
            const f32x4 y = (xv[j] * rinv * gg) * (1.f + sc) + sh;
            if (FP8_GEMM1) *(unsigned*)((unsigned char*)H + (size_t)m * DM + col) = pk4_fp8(y.x, y.y, y.z, y.w, HSCALE);
            else { u32x2 o; o.x = pk2(y.x, y.y); o.y = pk2(y.z, y.w);
            *(u32x2*)(H + (size_t)m * DM + col) = o; } }
    }
#undef P1_LOAD
#undef P1_ROW
}

template <class Epi>
__device__ __forceinline__ void naive_gemm(const Ctx& c, const bf16* A, const bf16* Bt, int M, int N, int K, const Epi& epi) {
    float* As = (float*)c.lds;
    float* Bs = (float*)(c.lds + 64 * 33 * 4);
    const int tn_count = N / 128, tiles = (M / 64) * tn_count;
    const int row = c.tid >> 3, cb = c.tid & 7;
    for (int tile = c.bid; tile < tiles; tile += c.nblk) {
        const int tm = tile / tn_count, tn = tile % tn_count;
        float acc[16];
#pragma unroll
        for (int j = 0; j < 16; ++j) acc[j] = 0.f;
        for (int k0 = 0; k0 < K; k0 += 32) {
            { const int r = c.tid >> 3, c4 = (c.tid & 7) * 4; const u32x2 v = *(const u32x2*)(A + (size_t)(tm * 64 + r) * K + k0 + c4);
              As[r * 33 + c4 + 0] = __uint_as_float(v.x << 16); As[r * 33 + c4 + 1] = __uint_as_float(v.x & 0xffff0000u);
              As[r * 33 + c4 + 2] = __uint_as_float(v.y << 16); As[r * 33 + c4 + 3] = __uint_as_float(v.y & 0xffff0000u); }
            { const int r = c.tid >> 2, c8 = (c.tid & 3) * 8; const u32x4 v = *(const u32x4*)(Bt + (size_t)(tn * 128 + r) * K + k0 + c8);
              float* d = Bs + r * 33 + c8;
              d[0] = __uint_as_float(v.x << 16); d[1] = __uint_as_float(v.x & 0xffff0000u); d[2] = __uint_as_float(v.y << 16); d[3] = __uint_as_float(v.y & 0xffff0000u);
              d[4] = __uint_as_float(v.z << 16); d[5] = __uint_as_float(v.z & 0xffff0000u); d[6] = __uint_as_float(v.w << 16); d[7] = __uint_as_float(v.w & 0xffff0000u); }
            __syncthreads();
#pragma unroll 8
            for (int kk = 0; kk < 32; ++kk) { const float a = As[row * 33 + kk];
#pragma unroll
                for (int j = 0; j < 16; ++j) acc[j] += a * Bs[(cb + 8 * j) * 33 + kk]; }
            __syncthreads();
        }
#pragma unroll
        for (int j = 0; j < 16; ++j) epi(tm * 64 + row, tn * 128 + cb + 8 * j, acc[j]);
    }
}


__device__ __forceinline__ unsigned ror8_u(unsigned v) { return (unsigned)__builtin_amdgcn_update_dpp(0, (int)v, 0x128, 0xf, 0xf, true); }
__device__ __forceinline__ void epi_swap(const u32x4& w0, const u32x4& w1, bool upper, u32x4& A, u32x4& B) {
    u32x4 t = upper ? w0 : w1; t.x = ror8_u(t.x); t.y = ror8_u(t.y); t.z = ror8_u(t.z); t.w = ror8_u(t.w);
    A = upper ? t : w0; B = upper ? w1 : t;
}
struct EpiG1 {
    static constexpr bool PERM = true, AFTER_DRAIN = false;
    static constexpr int SCA = 127 - 4, SCB = 127 - 6;
    bf16* ZG; bf16* XBC; float* DT; bf16* GCV; const float* dtb; unsigned char* probe_base;
    __device__ __forceinline__ void operator()(const pg8::f32x4 (&acc)[2][2][4][2], const pg8::Unit& u, int wr, int wc, int fr, int fq) const {
        const int row0 = u.pm * 256 + wr * 64 + fr, pn = u.pn;
        if (pn == 12) {
            if (wc == 0) {
#pragma unroll
                for (int n = 0; n < 2; ++n) { const int col = 8 * fq + 4 * n; const f32x4 bv = *(const f32x4*)(dtb + col);
#pragma unroll
                    for (int ai = 0; ai < 2; ++ai)
#pragma unroll
                        for (int m = 0; m < 4; ++m) { const pg8::f32x4 v = acc[ai][0][m][n]; f32x4 o;
                            o.x = softplus_f(v[0] + bv.x); o.y = softplus_f(v[1] + bv.y); o.z = softplus_f(v[2] + bv.z); o.w = softplus_f(v[3] + bv.w);
                            *(f32x4*)(DT + (size_t)(row0 + ai * 128 + m * 16) * 32 + col) = o; } }
            }
            return;
        }
        const bool isx = (pn >= 4) & (pn < 12), isg = pn >= 17;
        const size_t boff = isx ? (WS_RB - WS_RA) : (isg ? (WS_RC - WS_RA) : (size_t)0);
        bf16* base = (bf16*)((unsigned char*)ZG + boff);
        const int colt = pn < 4 ? pn * 256 : (isx ? (pn - 4) * 256 : (isg ? (pn - 17) * 256 : 1024 + (pn - 13) * 256));
        if (!isx && u.pm >= 128) return;
        const bool upper = fr >= 8; const int rlow = u.pm * 256 + wr * 64 + (fr & 7), col0 = colt + wc * 64 + 8 * fq + 32 * (fr >> 3);
#pragma unroll
        for (int ai = 0; ai < 2; ++ai)
#pragma unroll
            for (int m = 0; m < 4; ++m) { bf16* rowp = base + (size_t)(rlow + ai * 128 + m * 16) * 2048 + col0;
                u32x4 w[2];
#pragma unroll
                for (int bj = 0; bj < 2; ++bj) { const pg8::f32x4 v0 = acc[ai][bj][m][0], v1 = acc[ai][bj][m][1];
                    w[bj].x = pg8::cvt_pk_bf16(v0[0], v0[1]); w[bj].y = pg8::cvt_pk_bf16(v0[2], v0[3]); w[bj].z = pg8::cvt_pk_bf16(v1[0], v1[1]); w[bj].w = pg8::cvt_pk_bf16(v1[2], v1[3]); }
                u32x4 A, B; epi_swap(w[0], w[1], upper, A, B);
                if (EPI_NT) { __builtin_nontemporal_store(A, (u32x4*)rowp); __builtin_nontemporal_store(B, (u32x4*)(rowp + (size_t)8 * 2048)); } else { *(u32x4*)rowp = A; *(u32x4*)(rowp + (size_t)8 * 2048) = B; } }
    }
};
struct EpiPlainT {
    static constexpr bool PERM = true, AFTER_DRAIN = false;
    static constexpr int SCA = 127 - 4, SCB = 127 - 6;
    bf16* O; int ld; unsigned char* probe_base;
    __device__ __forceinline__ void operator()(const pg8::f32x4 (&acc)[2][2][4][2], const pg8::Unit& u, int wr, int wc, int fr, int fq) const {
        const bool upper = fr >= 8; const int rlow = u.pm * 256 + wr * 64 + (fr & 7), col0 = u.pn * 256 + wc * 64 + 8 * fq + 32 * (fr >> 3);
#pragma unroll
        for (int ai = 0; ai < 2; ++ai)
#pragma unroll
            for (int m = 0; m < 4; ++m) { bf16* rowp = O + (size_t)(rlow + ai * 128 + m * 16) * ld + col0;
                u32x4 w[2];
#pragma unroll
                for (int bj = 0; bj < 2; ++bj) { const pg8::f32x4 v0 = acc[ai][bj][m][0], v1 = acc[ai][bj][m][1];
                    w[bj].x = pg8::cvt_pk_bf16(v0[0], v0[1]); w[bj].y = pg8::cvt_pk_bf16(v0[2], v0[3]); w[bj].z = pg8::cvt_pk_bf16(v1[0], v1[1]); w[bj].w = pg8::cvt_pk_bf16(v1[2], v1[3]); }
                u32x4 A, B; epi_swap(w[0], w[1], upper, A, B);
                if (EPI_NT) { __builtin_nontemporal_store(A, (u32x4*)rowp); __builtin_nontemporal_store(B, (u32x4*)(rowp + (size_t)8 * ld)); } else { *(u32x4*)rowp = A; *(u32x4*)(rowp + (size_t)8 * ld) = B; } }
    }
};
struct Order1 {
    pg8::StaticOrder so; int G, c;
    __device__ void init(int G_, int c_) { so.init(ML, N1, G_, c_, G1_WGM); G = G_; c = c_; }
    __device__ bool next(int i, pg8::Unit& u) const {
        const int L = i * G + c;
        if (L < 3200) return so.next(i, u);
        const int r = L - 3200; if (r >= 36) return false;
        u.pm = 128 + r / 9; u.pn = 4 + r % 9; return true;
    }
    __device__ __forceinline__ void a_ready(const pg8::Unit&) const {}
    __device__ __forceinline__ void done(const pg8::Unit&) const {}
};
struct Epi1 {
    bf16* ZG; bf16* XBC; float* DT; bf16* GCV; const float* dtb;
    __device__ __forceinline__ void operator()(int m, int n, float v) const {
        if (n < 1024) { if (m < ML) ZG[(size_t)m * 2048 + n] = f2bf(v); }
        else if (n < 3072) XBC[(size_t)m * 2048 + (n - 1024)] = f2bf(v);
        else if (n < 3104) DT[(size_t)m * 32 + (n - 3072)] = softplus_f(v + dtb[n - 3072]);
        else if (n < 3328) {}
        else if (n < 4352) { if (m < ML) ZG[(size_t)m * 2048 + 1024 + (n - 3328)] = f2bf(v); }
        else { if (m < ML) GCV[(size_t)m * 2048 + (n - 4352)] = f2bf(v); }
    }
};
struct EpiPlain { bf16* O; int ld; __device__ __forceinline__ void operator()(int m, int n, float v) const { O[(size_t)m * ld + n] = f2bf(v); } };

__device__ __forceinline__ void phase2(const Ctx& c) {
    EpiG1 e{(bf16*)(c.ws + WS_RA), (bf16*)(c.ws + WS_RB), (float*)(c.ws + WS_DT), (bf16*)(c.ws + WS_RC), c.in[I_DTBIAS], c.ws + WS_END};
    pg8::Gemm g{(const bf16*)c.out, (const bf16*)(c.ws + WS_WIN), MT, N1, FP8_GEMM1 ? 512 : 1024};
    Order1 S; S.init(c.nblk, c.bid);
    pg8::gemm_phase<EpiG1, Order1, G1_ALIGN, true, FP8_GEMM1 != 0>((LAS unsigned char*)c.lds, g, S, e);
}

__device__ __forceinline__ void phase3(const Ctx& c) {
    bf16* XBC = (bf16*)(c.ws + WS_RB); const float* cw = c.in[I_CONVW]; const float* cbias = c.in[I_CONVB];
    for (int idx = c.gtid; idx < (ML / 64) * 2048; idx += c.gsz) {
        const int ch = idx & 2047, r64 = idx >> 11; bf16* base = XBC + (size_t)r64 * 64 * 2048 + ch;
        float u[64];
#pragma unroll
        for (int t = 0; t < 64; ++t) u[t] = bf2f(base[(size_t)t * 2048]);
        const float w0 = cw[ch], w1 = cw[2048 + ch], w2 = cw[4096 + ch], w3 = cw[6144 + ch], w4 = cw[8192 + ch], bb = cbias[ch];
#pragma unroll
        for (int t = 0; t < 64; ++t) {
            float o = bb + w2 * u[t];
            if (t >= 2) o += w0 * u[t - 2];
            if (t >= 1) o += w1 * u[t - 1];
            if (t <= 62) o += w3 * u[t + 1];
            if (t <= 61) o += w4 * u[t + 2];
            base[(size_t)t * 2048] = f2bf(silu_f(o));
        }
    }
    for (int idx = c.gtid; idx < NB * 2048; idx += c.gsz) {
        const int ch = idx & 2047, b = idx >> 11; bf16* base = XBC + (size_t)(ML + b * CTXL) * 2048 + ch;
        const float w0 = cw[ch], w1 = cw[2048 + ch], w2 = cw[4096 + ch], w3 = cw[6144 + ch], w4 = cw[8192 + ch], bb = cbias[ch];
        float um2 = 0.f, um1 = 0.f, u0 = bf2f(base[0]), up1 = bf2f(base[2048]), up2;
        for (int t = 0; t < CTXL; ++t) {
            up2 = (t + 2 < CTXL) ? bf2f(base[(size_t)(t + 2) * 2048]) : 0.f;
            const float o = bb + w0 * um2 + w1 * um1 + w2 * u0 + w3 * up1 + w4 * up2;
            base[(size_t)t * 2048] = f2bf(silu_f(o));
            um2 = um1; um1 = u0; u0 = up1; up1 = up2;
        }
    }
    { bf16* ZG = (bf16*)(c.ws + WS_RA); const bf16* GCV = (const bf16*)(c.ws + WS_RC); const float* sw = c.in[I_SCCONVW]; const float* sg = c.in[I_SCNORMG];
      for (int m = c.gw; m < ML; m += c.ngw) {
          const int pos = m & 63, ch0 = c.lane * 16;
          float acc[16];
#pragma unroll
          for (int j = 0; j < 16; ++j) acc[j] = 0.f;
#pragma unroll
          for (int k = 0; k < 3; ++k) { const int tt = pos + k - 1;
              if (tt >= 0 && tt < 64) { const bf16* gr = GCV + (size_t)(m + k - 1) * 2048 + ch0;
#pragma unroll
                  for (int j = 0; j < 16; ++j) acc[j] += sw[k * 1024 + ch0 + j] * (bf2f(gr[j]) * bf2f(gr[1024 + j])); } }
          bf16* gb = ZG + (size_t)m * 2048 + 1024 + ch0; float ss = 0.f;
#pragma unroll
          for (int j = 0; j < 16; ++j) { acc[j] *= bf2f(gb[j]); ss += acc[j] * acc[j]; }
          const float rinv = rsqrtf(wave_sum(ss) * (1.f / 1024.f) + EPS);
#pragma unroll
          for (int j = 0; j < 16; ++j) gb[j] = f2bf(acc[j] * rinv * sg[ch0 + j]);
      } }
    { f32x4* y = (f32x4*)c.out; const f32x4 z = {0.f, 0.f, 0.f, 0.f}; for (int i = c.gtid; i < ML * DM / 4; i += c.gsz) y[i] = z; }
}

__device__ __forceinline__ void phase4(const Ctx& c) {
    const bf16* XBC = (const bf16*)(c.ws + WS_RB); const float* DT = (const float*)(c.ws + WS_DT); float* Y = c.out;
    for (int idx = c.gtid; idx < 65536; idx += c.gsz) {
        const int nc = idx & 7, p = (idx >> 3) & 63, d = (idx >> 9) & 1, hd = (idx >> 10) & 15, b = idx >> 14, g = hd >> 2;
        const float A = -__expf(c.in[I_ALOG][d * 16 + hd]);
        float h[16];
#pragma unroll
        for (int j = 0; j < 16; ++j) h[j] = 0.f;
        for (int step = 0; step < CTXL + SEQ; ++step) {
            int row; bool lat = step >= CTXL;
            if (!lat) { const int t = d == 0 ? step : CTXL - 1 - step; row = ML + b * CTXL + t; }
            else { const int s2 = step - CTXL; const int t = d == 0 ? s2 : SEQ - 1 - s2; row = b * SEQ + t; }
            const float dt = DT[(size_t)row * 32 + d * 16 + hd]; const float dec = __expf(dt * A);
            const bf16* xr = XBC + (size_t)row * 2048;
            const float xv = bf2f(xr[hd * 64 + p]) * dt;
            const u32x4 b0 = *(const u32x4*)(xr + 1024 + g * 128 + nc * 16), b1 = *(const u32x4*)(xr + 1024 + g * 128 + nc * 16 + 8);
            const unsigned bw[8] = {b0.x, b0.y, b0.z, b0.w, b1.x, b1.y, b1.z, b1.w};
#pragma unroll
            for (int j = 0; j < 8; ++j) { h[2 * j] = h[2 * j] * dec + __uint_as_float(bw[j] << 16) * xv; h[2 * j + 1] = h[2 * j + 1] * dec + __uint_as_float(bw[j] & 0xffff0000u) * xv; }
            if (lat) {
                const u32x4 c0 = *(const u32x4*)(xr + 1536 + g * 128 + nc * 16), c1 = *(const u32x4*)(xr + 1536 + g * 128 + nc * 16 + 8);
                const unsigned cwv[8] = {c0.x, c0.y, c0.z, c0.w, c1.x, c1.y, c1.z, c1.w};
                float y = 0.f;
#pragma unroll
                for (int j = 0; j < 8; ++j) y += __uint_as_float(cwv[j] << 16) * h[2 * j] + __uint_as_float(cwv[j] & 0xffff0000u) * h[2 * j + 1];
                y += __shfl_xor(y, 1); y += __shfl_xor(y, 2); y += __shfl_xor(y, 4);
                if (nc == 0) atomicAdd(&Y[(size_t)row * 1024 + hd * 64 + p], y);
            }
        }
    }
}

__device__ __forceinline__ void phase5(const Ctx& c) {
    const bf16* XBC = (const bf16*)(c.ws + WS_RB); bf16* ZG = (bf16*)(c.ws + WS_RA); const float* Y = c.out;
    const float* dsk = c.in[I_DSKIP]; const float* ng = c.in[I_SSDNORMG];
    for (int it = c.gw; it < ML * 4; it += c.ngw) {
        const int m = it >> 2, g = it & 3, ch = g * 256 + c.lane * 4, hd = ch >> 6;
        const f32x4 yv = *(const f32x4*)(Y + (size_t)m * 1024 + ch);
        const u32x2 xw = *(const u32x2*)(XBC + (size_t)m * 2048 + ch), zw = *(const u32x2*)(ZG + (size_t)m * 2048 + ch);
        const float dk = dsk[hd];
        float y[4] = {yv.x, yv.y, yv.z, yv.w};
        const float xs[4] = {__uint_as_float(xw.x << 16), __uint_as_float(xw.x & 0xffff0000u), __uint_as_float(xw.y << 16), __uint_as_float(xw.y & 0xffff0000u)};
        const float zz[4] = {__uint_as_float(zw.x << 16), __uint_as_float(zw.x & 0xffff0000u), __uint_as_float(zw.y << 16), __uint_as_float(zw.y & 0xffff0000u)};
        float ss = 0.f;
#pragma unroll
        for (int j = 0; j < 4; ++j) { y[j] = (y[j] + dk * xs[j]) * silu_f(zz[j]); ss += y[j] * y[j]; }
        const float rinv = rsqrtf(wave_sum(ss) * (1.f / 256.f) + EPS);
        u32x2 o; o.x = pk2(y[0] * rinv * ng[ch], y[1] * rinv * ng[ch + 1]); o.y = pk2(y[2] * rinv * ng[ch + 2], y[3] * rinv * ng[ch + 3]);
        *(u32x2*)(ZG + (size_t)m * 2048 + ch) = o;
    }
}

typedef short bf16x8_t __attribute__((ext_vector_type(8)));
constexpr int XPITCH = 272;
__device__ __forceinline__ float fast_exp(float x) { return __expf(x); }
__device__ __forceinline__ float wave_scan_incl(float v, float& tot) {
    v += dpp_f<0x111>(v); v += dpp_f<0x112>(v); v += dpp_f<0x114>(v); v += dpp_f<0x118>(v);
    const float r0 = __builtin_bit_cast(float, __builtin_amdgcn_readlane(__builtin_bit_cast(int, v), 15));
    const float r1 = __builtin_bit_cast(float, __builtin_amdgcn_readlane(__builtin_bit_cast(int, v), 31));
    const float r2 = __builtin_bit_cast(float, __builtin_amdgcn_readlane(__builtin_bit_cast(int, v), 47));
    const float r3 = __builtin_bit_cast(float, __builtin_amdgcn_readlane(__builtin_bit_cast(int, v), 63));
    const int row = (int)(threadIdx.x & 63) >> 4;
    const float add = row == 0 ? 0.f : (row == 1 ? r0 : (row == 2 ? r0 + r1 : r0 + r1 + r2));
    tot = r0 + r1 + r2 + r3;
    return v + add;
}
__device__ __forceinline__ void unpack8(const u32x4& w, float* f) {
    f[0] = __uint_as_float(w.x << 16); f[1] = __uint_as_float(w.x & 0xffff0000u); f[2] = __uint_as_float(w.y << 16); f[3] = __uint_as_float(w.y & 0xffff0000u);
    f[4] = __uint_as_float(w.z << 16); f[5] = __uint_as_float(w.z & 0xffff0000u); f[6] = __uint_as_float(w.w << 16); f[7] = __uint_as_float(w.w & 0xffff0000u);
}
template <int J> __device__ __forceinline__ float row_elem(const u32x4& w) {
    const unsigned v = (J >> 1) == 0 ? w.x : ((J >> 1) == 1 ? w.y : ((J >> 1) == 2 ? w.z : w.w));
    return (J & 1) ? __uint_as_float(v & 0xffff0000u) : __uint_as_float(v << 16);
}
template <int J> __device__ __forceinline__ u32x4 conv_chan(const u32x4* rows, const float (&w)[5][8], const float (&bb)[8]) {
    float x[12];
#pragma unroll
    for (int i = 0; i < 12; ++i) x[i] = row_elem<J>(rows[i]);
    float o[8];
#pragma unroll
    for (int t = 0; t < 8; ++t) o[t] = silu_f(bb[J] + w[0][J] * x[t] + w[1][J] * x[t + 1] + w[2][J] * x[t + 2] + w[3][J] * x[t + 3] + w[4][J] * x[t + 4]);
    u32x4 q; q.x = pk2(o[0], o[1]); q.y = pk2(o[2], o[3]); q.z = pk2(o[4], o[5]); q.w = pk2(o[6], o[7]); return q;
}
__device__ __forceinline__ void conv_unit(const u32x4* rows, const float* cw, const float* cb, int chcol, u32x4* out) {
    float w[5][8], bb[8];
#pragma unroll
    for (int k = 0; k < 5; ++k) { const f32x4 a = *(const f32x4*)(cw + k * 2048 + chcol), b = *(const f32x4*)(cw + k * 2048 + chcol + 4);
        w[k][0] = a.x; w[k][1] = a.y; w[k][2] = a.z; w[k][3] = a.w; w[k][4] = b.x; w[k][5] = b.y; w[k][6] = b.z; w[k][7] = b.w; }
    { const f32x4 a = *(const f32x4*)(cb + chcol), b = *(const f32x4*)(cb + chcol + 4); bb[0] = a.x; bb[1] = a.y; bb[2] = a.z; bb[3] = a.w; bb[4] = b.x; bb[5] = b.y; bb[6] = b.z; bb[7] = b.w; }
    out[0] = conv_chan<0>(rows, w, bb); out[1] = conv_chan<1>(rows, w, bb); out[2] = conv_chan<2>(rows, w, bb); out[3] = conv_chan<3>(rows, w, bb);
    out[4] = conv_chan<4>(rows, w, bb); out[5] = conv_chan<5>(rows, w, bb); out[6] = conv_chan<6>(rows, w, bb); out[7] = conv_chan<7>(rows, w, bb);
}


__device__ __forceinline__ void un4_fp8(unsigned w, float* f) {
    typedef float f32x2_u __attribute__((ext_vector_type(2)));
    const f32x2_u lo = __builtin_amdgcn_cvt_pk_f32_fp8((int)w, false), hi = __builtin_amdgcn_cvt_pk_f32_fp8((int)w, true);
    f[0] = lo.x; f[1] = lo.y; f[2] = hi.x; f[3] = hi.y;
}
__device__ __forceinline__ void s1_item(const Ctx& c, int b, int cc, int g) {
    LAS unsigned char* L = (LAS unsigned char*)c.lds;
    LAS unsigned char* XT = L;
    LAS unsigned char* BT = L + 256 * XPITCH;
    LAS float* WT = (LAS float*)(L + 384 * XPITCH);
    const bf16* XBC = (const bf16*)(c.ws + WS_RB); const float* DT = (const float*)(c.ws + WS_DT);
    const bool isctx = cc < 2;
    const int seq0 = isctx ? ML + b * CTXL : b * SEQ;
    const int t0c = isctx ? cc * 128 : (cc - 2) * 128;
    const int tid = c.tid, lane = c.lane, w = c.wave;
    { const int d = w >> 2, r = w & 3, hd = g * 4 + r;
      const float A = -__expf(c.in[I_ALOG][d * 16 + hd]);
      const float dt0 = DT[(size_t)(seq0 + t0c + lane) * 32 + d * 16 + hd], dt1 = DT[(size_t)(seq0 + t0c + 64 + lane) * 32 + d * 16 + hd];
      const float a0 = dt0 * A, a1 = dt1 * A; float tot0, tot1;
      const float P0 = wave_scan_incl(a0, tot0); const float P1 = wave_scan_incl(a1, tot1) + tot0; const float Ptot = tot0 + tot1;
      float w0, w1;
      if (d == 0) { w0 = dt0 * fast_exp(Ptot - P0); w1 = dt1 * fast_exp(Ptot - P1); }
      else { w0 = dt0 * fast_exp(P0 - a0); w1 = dt1 * fast_exp(P1 - a1); }
      WT[w * 128 + lane] = w0; WT[w * 128 + 64 + lane] = w1;
      if (lane == 0) ((float*)(c.ws + WS_DEC))[((b * 66 + cc) * 16 + hd) * 2 + d] = fast_exp(Ptot); }
    { const int sg = tid & 15, q = tid >> 4;
      const int tok0 = sg * 8;
      int lo, hi;
      if (isctx) { lo = -t0c; hi = CTXL - t0c; } else { lo = tok0 & ~63; hi = lo + 64; }
#pragma unroll 1
      for (int pass = 0; pass < 2; ++pass) {
          if (pass == 1 && q >= 16) break;
          const int chcol = pass == 0 ? g * 256 + 8 * q : 1024 + g * 128 + 8 * q;
          u32x4 rows[12];
#pragma unroll
          for (int i = 0; i < 12; ++i) { const int t = tok0 - 2 + i; const u32x4 z = {0u, 0u, 0u, 0u};
              rows[i] = (t >= lo && t < hi) ? *(const u32x4*)(XBC + (size_t)(seq0 + t0c + t) * 2048 + chcol) : z; }
          u32x4 outp[8];
          conv_unit(rows, c.in[I_CONVW], c.in[I_CONVB], chcol, outp);
          LAS unsigned char* dst = (pass == 0 ? XT + (8 * q) * XPITCH : BT + (8 * q) * XPITCH) + sg * 16;
#pragma unroll
          for (int j = 0; j < 8; ++j) *(LAS u32x4*)(dst + j * XPITCH) = outp[j];
          if (pass == 0 && !isctx) { bf16* xg = (bf16*)(c.ws + WS_RE) + ((size_t)((b * 64 + (cc - 2)) * 4 + g) * 256 + 8 * q) * 128 + tok0;
#pragma unroll
              for (int j = 0; j < 8; ++j) __builtin_nontemporal_store(outp[j], (u32x4*)(xg + j * 128)); }
      } }
    LDS_BARRIER();
    { const int fr = lane & 15, fq = lane >> 4;
      unsigned char* stbase = isctx ? c.ws + WS_HC + (size_t)((b * 2 + cc) * 16) * 2 * 8192 : (unsigned char*)c.out + (size_t)((b * 64 + (cc - 2)) * 16) * 2 * 8192;
#pragma unroll 1
      for (int dr = 0; dr < 8; ++dr) { const int d = dr >> 2, r = dr & 3, hd = g * 4 + r;
          f32x4 acc[4];
#pragma unroll
          for (int pt = 0; pt < 4; ++pt) acc[pt] = (f32x4){0.f, 0.f, 0.f, 0.f};
#pragma unroll
          for (int ks = 0; ks < 4; ++ks) {
              const u32x4 araw = *(const LAS u32x4*)(BT + (16 * w + fr) * XPITCH + (32 * ks + 8 * fq) * 2);
              const f32x4 wl = *(const LAS f32x4*)(WT + dr * 128 + 32 * ks + 8 * fq), wh = *(const LAS f32x4*)(WT + dr * 128 + 32 * ks + 8 * fq + 4);
              float af[8]; unpack8(araw, af);
              u32x4 as; as.x = pk2(af[0] * wl.x, af[1] * wl.y); as.y = pk2(af[2] * wl.z, af[3] * wl.w); as.z = pk2(af[4] * wh.x, af[5] * wh.y); as.w = pk2(af[6] * wh.z, af[7] * wh.w);
              const bf16x8_t afrag = __builtin_bit_cast(bf16x8_t, as);
#pragma unroll
              for (int pt = 0; pt < 4; ++pt) { const bf16x8_t bfrag = *(const LAS bf16x8_t*)(XT + (r * 64 + 16 * pt + fr) * XPITCH + (32 * ks + 8 * fq) * 2);
                  acc[pt] = __builtin_amdgcn_mfma_f32_16x16x32_bf16(afrag, bfrag, acc[pt], 0, 0, 0); }
          }
          unsigned char* dst = stbase + (size_t)(hd * 2 + d) * 8192;
#pragma unroll
          for (int pt = 0; pt < 4; ++pt) *(unsigned*)(dst + (16 * pt + fr) * 128 + 16 * w + 4 * fq) = pk4_fp8(acc[pt][0], acc[pt][1], acc[pt][2], acc[pt][3], STSCALE);
      } }
    LDS_BARRIER();
}

__device__ __forceinline__ void shortconv_row(const Ctx& c, int row64) {
    bf16* ZG = (bf16*)(c.ws + WS_RA); const bf16* GCV = (const bf16*)(c.ws + WS_RC); const float* sw = c.in[I_SCCONVW]; const float* sg = c.in[I_SCNORMG];
    const int p0 = c.wave * 8, ch0 = c.lane * 16; const size_t mbase = (size_t)row64 * 64;
    float w0[16], w1[16], w2[16], gn[16];
#pragma unroll
    for (int j = 0; j < 16; j += 4) { const f32x4 a = *(const f32x4*)(sw + ch0 + j), b = *(const f32x4*)(sw + 1024 + ch0 + j), d = *(const f32x4*)(sw + 2048 + ch0 + j), e = *(const f32x4*)(sg + ch0 + j);
        w0[j] = a.x; w0[j + 1] = a.y; w0[j + 2] = a.z; w0[j + 3] = a.w; w1[j] = b.x; w1[j + 1] = b.y; w1[j + 2] = b.z; w1[j + 3] = b.w;
        w2[j] = d.x; w2[j + 1] = d.y; w2[j + 2] = d.z; w2[j + 3] = d.w; gn[j] = e.x; gn[j + 1] = e.y; gn[j + 2] = e.z; gn[j + 3] = e.w; }
#define SC_LOAD(dst, tt_) { const int t_ = (tt_) < 0 ? 0 : ((tt_) > 63 ? 63 : (tt_)); const bf16* gr = GCV + (mbase + t_) * 2048 + ch0; \
        dst[0] = *(const u32x4*)gr; dst[1] = *(const u32x4*)(gr + 8); dst[2] = *(const u32x4*)(gr + 1024); dst[3] = *(const u32x4*)(gr + 1032); }
#define SC_PROD(dst, raw, tt_) { float gf[16], vf[16]; unpack8(raw[0], gf); unpack8(raw[1], gf + 8); unpack8(raw[2], vf); unpack8(raw[3], vf + 8); \
        const float ok_ = ((tt_) >= 0 && (tt_) < 64) ? 1.f : 0.f; _Pragma("unroll") for (int j = 0; j < 16; ++j) dst[j] = gf[j] * vf[j] * ok_; }
    u32x4 ra[4], rb[4], gbr[2], gbn[2];
    float pm[16], pc[16], pn[16];
    SC_LOAD(ra, p0 - 1) SC_LOAD(rb, p0)
    SC_PROD(pm, ra, p0 - 1) SC_PROD(pc, rb, p0)
    SC_LOAD(ra, p0 + 1)
    { const bf16* gb = ZG + (mbase + p0) * 2048 + 1024 + ch0; gbr[0] = *(const u32x4*)gb; gbr[1] = *(const u32x4*)(gb + 8); }
#pragma unroll 1
    for (int i = 0; i < 8; ++i) { const int pos = p0 + i;
        SC_PROD(pn, ra, pos + 1)
        SC_LOAD(ra, pos + 2)
        { const int pq = (i < 7) ? pos + 1 : pos; const bf16* gb = ZG + (mbase + pq) * 2048 + 1024 + ch0; gbn[0] = *(const u32x4*)gb; gbn[1] = *(const u32x4*)(gb + 8); }
        float acc[16], bf[16]; unpack8(gbr[0], bf); unpack8(gbr[1], bf + 8); float ss = 0.f;
#pragma unroll
        for (int j = 0; j < 16; ++j) { acc[j] = (w0[j] * pm[j] + w1[j] * pc[j] + w2[j] * pn[j]) * bf[j]; ss += acc[j] * acc[j]; }
        const float rinv = rsqrtf(wave_sum(ss) * (1.f / 1024.f) + EPS);
        u32x4 o0, o1;
        o0.x = pk2(acc[0] * rinv * gn[0], acc[1] * rinv * gn[1]); o0.y = pk2(acc[2] * rinv * gn[2], acc[3] * rinv * gn[3]);
        o0.z = pk2(acc[4] * rinv * gn[4], acc[5] * rinv * gn[5]); o0.w = pk2(acc[6] * rinv * gn[6], acc[7] * rinv * gn[7]);
        o1.x = pk2(acc[8] * rinv * gn[8], acc[9] * rinv * gn[9]); o1.y = pk2(acc[10] * rinv * gn[10], acc[11] * rinv * gn[11]);
        o1.z = pk2(acc[12] * rinv * gn[12], acc[13] * rinv * gn[13]); o1.w = pk2(acc[14] * rinv * gn[14], acc[15] * rinv * gn[15]);
        if (FP8_GEMM2) { float y[16];
#pragma unroll
            for (int j = 0; j < 16; ++j) y[j] = acc[j] * rinv * gn[j] * YSCALE;
            u32x4 o;
            o.x = pk4_fp8(y[0], y[1], y[2], y[3], 1.f); o.y = pk4_fp8(y[4], y[5], y[6], y[7], 1.f); o.z = pk4_fp8(y[8], y[9], y[10], y[11], 1.f); o.w = pk4_fp8(y[12], y[13], y[14], y[15], 1.f);
            __builtin_nontemporal_store(o, (u32x4*)((unsigned char*)c.out + 64 * MiB + (mbase + pos) * 2048 + 1024 + ch0));
        } else {
        bf16* gb = ZG + (mbase + pos) * 2048 + 1024 + ch0;
        *(u32x4*)gb = o0; *(u32x4*)(gb + 8) = o1; }
#pragma unroll
        for (int j = 0; j < 16; ++j) { pm[j] = pc[j]; pc[j] = pn[j]; }
        gbr[0] = gbn[0]; gbr[1] = gbn[1];
    }
#undef SC_LOAD
#undef SC_PROD
}

__device__ __forceinline__ void phase3f(const Ctx& c) {
    constexpr int NS1 = NB * 66 * 4;
    const int nx = NS1 % c.nblk, slot = (c.bid >> 3) & 3;
    int k = 0;
    for (int it = c.bid; it < NS1; it += c.nblk, ++k) { const int g = it & 3, t = it >> 2, cc = t % 66, b = t / 66; s1_item(c, b, cc, g); if (PROBE_DBL == 30) s1_item(c, b, cc, g);
        if (k == slot && c.bid >= nx) for (int j = c.bid - nx; j < ML / 64; j += c.nblk - nx) { shortconv_row(c, j); if (PROBE_DBL == 31) shortconv_row(c, j); } }
}

__device__ __forceinline__ void phase4f_(const Ctx& c, size_t woff) {
    unsigned char* ST = (unsigned char*)c.out; const unsigned char* STC = c.ws + WS_HC; const float* DEC = (const float*)(c.ws + WS_DEC);
    for (int idx = c.gtid; idx < NB * 16 * 2 * 64 * 16; idx += c.gsz) {
        const int n8 = idx & 15, p = (idx >> 4) & 63, d = (idx >> 10) & 1, hd = (idx >> 11) & 15, b = idx >> 15;
        const size_t inner = (size_t)((hd * 2 + d) * 64 + p) * 128 + n8 * 8;
        float h[8];
#pragma unroll
        for (int j = 0; j < 8; ++j) h[j] = 0.f;
#pragma unroll
        for (int s = 0; s < 2; ++s) { const int cc = d == 0 ? s : 1 - s;
            const float dec = DEC[((b * 66 + cc) * 16 + hd) * 2 + d];
            const u32x2 sv = *(const u32x2*)(STC + (size_t)(b * 2 + cc) * 16 * 2 * 8192 + inner); float sf[8]; un4_fp8(sv.x, sf); un4_fp8(sv.y, sf + 4);
#pragma unroll
            for (int j = 0; j < 8; ++j) h[j] = h[j] * dec + sf[j]; }
#pragma unroll 4
        for (int s = 0; s < 64; ++s) { const int cl = d == 0 ? s : 63 - s;
            const float dec = DEC[((b * 66 + 2 + cl) * 16 + hd) * 2 + d];
            unsigned char* ptr = ST + (size_t)(b * 64 + cl) * 16 * 2 * 8192 + inner;
            const u32x2 sv = *(const u32x2*)ptr; float sf[8]; un4_fp8(sv.x, sf); un4_fp8(sv.y, sf + 4);
            u32x2 o; o.x = pk4_fp8(h[0], h[1], h[2], h[3], 1.f); o.y = pk4_fp8(h[4], h[5], h[6], h[7], 1.f);
            *(u32x2*)(ptr + woff) = o;
#pragma unroll
            for (int j = 0; j < 8; ++j) h[j] = h[j] * dec + sf[j]; }
    }
}

__device__ __forceinline__ void phase4f(const Ctx& c) {
    if (PROBE_DBL == 4) phase4f_(c, (size_t)((c.ws + WS_RC) - (unsigned char*)c.out));
    phase4f_(c, 0);
}

__device__ __forceinline__ void s3_item(const Ctx& c, int b, int cl, int g, size_t zoff, int nm0, int ngrp, float& pdt0, float& pdt1, float& palog) {
    LAS unsigned char* L = (LAS unsigned char*)c.lds;
    LAS unsigned char* CM = L;
    LAS unsigned char* BM = L + 128 * XPITCH;
    LAS unsigned char* XT = L + 256 * XPITCH;
    LAS float* TB = (LAS float*)(L + 256 * XPITCH + 65536);
    const bf16* XBC = (const bf16*)(c.ws + WS_RB); const float* DT = (const float*)(c.ws + WS_DT);
    const int tid = c.tid, lane = c.lane, w = c.wave, fr = lane & 15, fq = lane >> 4;
    const int m0 = b * SEQ + cl * 128;
    { const int d = w >> 2, r = w & 3, hd = g * 4 + r;
      const float A = -__expf(palog);
      const float dt0 = pdt0, dt1 = pdt1;
      const float a0 = dt0 * A * 1.44269504f, a1 = dt1 * A * 1.44269504f; float tot0, tot1;
      const float P0 = wave_scan_incl(a0, tot0); const float P1 = wave_scan_incl(a1, tot1) + tot0;
      LAS float* t = TB + r * 512 + d * 256;
      if (d == 0) { t[lane] = P0; t[64 + lane] = P1; } else { t[lane] = P0 - a0; t[64 + lane] = P1 - a1; }
      t[128 + lane] = dt0; t[128 + 64 + lane] = dt1;
      if (d == 1 && lane == 0) TB[2048 + r] = tot0 + tot1;
      { LAS float* e2 = TB + 2064 + (r * 2 + d) * 128;
        const int e0 = d == 0 ? (lane | 15) : (lane & ~15);
        const float r0 = t[e0], r1 = t[64 + e0];
        const float p0 = d == 0 ? P0 : P0 - a0, p1 = d == 0 ? P1 : P1 - a1;
        e2[lane] = __builtin_amdgcn_exp2f(d == 0 ? r0 - p0 : p0 - r0) * dt0; e2[64 + lane] = __builtin_amdgcn_exp2f(d == 0 ? r1 - p1 : p1 - r1) * dt1; }
    }
#pragma unroll 1
    for (int rep_ = 0; rep_ < (PROBE_DBL == 55 ? 2 : 1); ++rep_)
    { const int sg = tid & 15, q = tid >> 4, tok0 = sg * 8;
      const int lo = tok0 & ~63, hi = lo + 64;
      const int chcol = q < 16 ? 1024 + g * 128 + 8 * q : 1536 + g * 128 + 8 * (q - 16);
      u32x4 rows[12];
#pragma unroll
      for (int i = 0; i < 12; ++i) { const int t = tok0 - 2 + i, tt = t < lo ? lo : (t >= hi ? hi - 1 : t);
          rows[i] = *(const u32x4*)(XBC + (size_t)(m0 + tt) * 2048 + chcol); }
      if (tid < 64) { int t2 = tid; asm volatile("" : "+v"(t2));
          *(LAS f32x4*)(TB + 3088 + 4 * t2) = *(const f32x4*)(c.in[I_SSDNORMG] + g * 256 + 4 * t2); }
      { const u32x4 z = {0u, 0u, 0u, 0u}; const bool zlo = tok0 == lo, zhi = tok0 + 8 == hi;
        rows[0] = zlo ? z : rows[0]; rows[1] = zlo ? z : rows[1]; rows[10] = zhi ? z : rows[10]; rows[11] = zhi ? z : rows[11]; }
      u32x4 outp[8];
      conv_unit(rows, c.in[I_CONVW], c.in[I_CONVB], chcol, outp);
      LAS unsigned char* dst = (q < 16 ? BM + (8 * q) * 2 : CM + (8 * (q - 16)) * 2) + tok0 * XPITCH;
      const unsigned e[8][4] = {{outp[0].x, outp[0].y, outp[0].z, outp[0].w}, {outp[1].x, outp[1].y, outp[1].z, outp[1].w}, {outp[2].x, outp[2].y, outp[2].z, outp[2].w}, {outp[3].x, outp[3].y, outp[3].z, outp[3].w},
                                {outp[4].x, outp[4].y, outp[4].z, outp[4].w}, {outp[5].x, outp[5].y, outp[5].z, outp[5].w}, {outp[6].x, outp[6].y, outp[6].z, outp[6].w}, {outp[7].x, outp[7].y, outp[7].z, outp[7].w}};
#pragma unroll
      for (int tp = 0; tp < 4; ++tp) {
          u32x4 lo4, hi4;
          lo4.x = (e[0][tp] & 0xffffu) | (e[1][tp] << 16); lo4.y = (e[2][tp] & 0xffffu) | (e[3][tp] << 16); lo4.z = (e[4][tp] & 0xffffu) | (e[5][tp] << 16); lo4.w = (e[6][tp] & 0xffffu) | (e[7][tp] << 16);
          hi4.x = (e[0][tp] >> 16) | (e[1][tp] & 0xffff0000u); hi4.y = (e[2][tp] >> 16) | (e[3][tp] & 0xffff0000u); hi4.z = (e[4][tp] >> 16) | (e[5][tp] & 0xffff0000u); hi4.w = (e[6][tp] >> 16) | (e[7][tp] & 0xffff0000u);
          *(LAS u32x4*)(dst + (2 * tp) * XPITCH) = lo4; *(LAS u32x4*)(dst + (2 * tp + 1) * XPITCH) = hi4; }
    }
    LAS unsigned char* HF = XT + 16384; LAS unsigned char* HB = XT + 32768; LAS unsigned char* ZY = XT + 49152;
    const bf16* xg = (const bf16*)(c.ws + WS_RE) + (size_t)((b * 64 + cl) * 4 + g) * 256 * 128;
    const unsigned char* STg = (const unsigned char*)c.out + (size_t)((b * 64 + cl) * 16) * 2 * 8192;
    bf16* ZG = (bf16*)(c.ws + WS_RA);
    u32x4 pre[6];
#define S3_ISSUE(r_) { const int hd_ = g * 4 + (r_); \
        pre[2] = *(const u32x4*)(STg + (size_t)(hd_ * 2 + 0) * 8192 + tid * 16); \
        pre[3] = *(const u32x4*)(STg + (size_t)(hd_ * 2 + 1) * 8192 + tid * 16); \
        _Pragma("unroll") for (int i_ = 0; i_ < 2; ++i_) { const int piece = tid + 512 * i_; \
            pre[i_]     = *(const u32x4*)(xg + (size_t)((r_) * 64) * 128 + piece * 8); \
            pre[4 + i_] = *(const u32x4*)(ZG + (size_t)(m0 + (piece >> 3)) * 2048 + g * 256 + (r_) * 64 + (piece & 7) * 8); } }
#define S3_H2L(dstT, v) { const int row = tid >> 3, c8 = tid & 7; const unsigned w_[4] = {(v).x, (v).y, (v).z, (v).w}; float f_[16]; \
        un4_fp8(w_[0], f_); un4_fp8(w_[1], f_ + 4); un4_fp8(w_[2], f_ + 8); un4_fp8(w_[3], f_ + 12); \
        u32x4 lo_, hi_; lo_.x = pk2(f_[0], f_[1]); lo_.y = pk2(f_[2], f_[3]); lo_.z = pk2(f_[4], f_[5]); lo_.w = pk2(f_[6], f_[7]); \
        hi_.x = pk2(f_[8], f_[9]); hi_.y = pk2(f_[10], f_[11]); hi_.z = pk2(f_[12], f_[13]); hi_.w = pk2(f_[14], f_[15]); \
        *(LAS u32x4*)((dstT) + row * 256 + (((2 * c8) ^ (row & 15)) * 16)) = lo_; *(LAS u32x4*)((dstT) + row * 256 + (((2 * c8 + 1) ^ (row & 15)) * 16)) = hi_; }
#define S3_COMMIT() { S3_H2L(HF, pre[2]) S3_H2L(HB, pre[3]) \
        _Pragma("unroll") for (int i_ = 0; i_ < 2; ++i_) { const int piece = tid + 512 * i_, row = piece >> 4, cq = piece & 15, o_ = row * 256 + ((cq ^ (row & 15)) * 16); \
            *(LAS u32x4*)(XT + o_) = pre[i_]; \
            const int zl = piece >> 3, zc = piece & 7; *(LAS u32x4*)(ZY + zl * 128 + ((zc ^ (zl & 7)) * 16)) = pre[4 + i_]; } }
    S3_ISSUE(0)
    LDS_BARRIER();
    f32x4 cb[8];
#pragma unroll
    for (int st = 0; st < 8; ++st) cb[st] = (f32x4){0.f, 0.f, 0.f, 0.f};
#pragma unroll
    for (int ks = 0; ks < 4; ++ks) { const bf16x8_t bfrag = *(const LAS bf16x8_t*)(CM + (16 * w + fr) * XPITCH + (32 * ks + 8 * fq) * 2);
#pragma unroll
        for (int st = 0; st < 8; ++st) { const bf16x8_t afrag = *(const LAS bf16x8_t*)(BM + (16 * st + fr) * XPITCH + (32 * ks + 8 * fq) * 2);
            cb[st] = __builtin_amdgcn_mfma_f32_16x16x32_bf16(afrag, bfrag, cb[st], 0, 0, 0); } }
    unsigned cbp[8][2];
#pragma unroll
    for (int st = 0; st < 8; ++st) { cbp[st][0] = pk2(cb[st][0], cb[st][1]); cbp[st][1] = pk2(cb[st][2], cb[st][3]); }
    LAS unsigned char* MT_ = BM + (16 * w) * XPITCH;
    const int l = 16 * w + fr;
    float ssq = 0.f;
    unsigned ypk[4][8];
#pragma unroll 1
    for (int r = 0; r < 4; ++r) { const int hd = g * 4 + r;
        unsigned yp[8];
        S3_COMMIT()
        if (PROBE_DBL == 54) { S3_COMMIT() }
        LDS_BARRIER();
        const LAS float* Pf = TB + r * 512, *dtf = TB + r * 512 + 128, *Pbx = TB + r * 512 + 256, *dtb = TB + r * 512 + 384;
        const LAS float* E2f = TB + 2064 + (r * 2) * 128, *E2b = TB + 2064 + (r * 2 + 1) * 128;
        const float Pf_l = Pf[l], Pbx_l = Pbx[l], dsk = c.in[I_DSKIP][hd];
#pragma unroll
        for (int st = 0; st < 8; ++st) { const int s0 = 16 * st + 4 * fq; const bool fwd = st < w;
            const f32x4 e2 = *(const LAS f32x4*)((fwd ? E2f : E2b) + s0);
            const float ref = fwd ? Pf[16 * st + 15] : Pbx[16 * st];
            const float e1 = __builtin_amdgcn_exp2f(fwd ? Pf_l - ref : fminf(ref - Pbx_l, 0.f));
            float mv[4];
#pragma unroll
            for (int e = 0; e < 4; ++e) { const float cbv = (e & 1) ? __uint_as_float(cbp[st][e >> 1] & 0xffff0000u) : __uint_as_float(cbp[st][e >> 1] << 16);
                mv[e] = cbv * (e1 * e2[e]); }
            u32x2 o; o.x = pk2(mv[0], mv[1]); o.y = pk2(mv[2], mv[3]);
            *(LAS u32x2*)(MT_ + fr * XPITCH + s0 * 2) = o; }
        { const int s0 = 16 * w + 4 * fq;
            unsigned c0 = cbp[0][0], c1 = cbp[0][1];
#pragma unroll
            for (int k = 1; k < 8; ++k) { c0 = (w == k) ? cbp[k][0] : c0; c1 = (w == k) ? cbp[k][1] : c1; }
            const f32x4 pfs = *(const LAS f32x4*)(Pf + s0), dfs = *(const LAS f32x4*)(dtf + s0), pbs = *(const LAS f32x4*)(Pbx + s0), dbs = *(const LAS f32x4*)(dtb + s0);
            float mv[4];
#pragma unroll
            for (int e = 0; e < 4; ++e) { const int s = s0 + e;
                const float cf = __builtin_amdgcn_exp2f(fminf(Pf_l - pfs[e], 0.f)) * dfs[e];
                const float cbw = __builtin_amdgcn_exp2f(fminf(pbs[e] - Pbx_l, 0.f)) * dbs[e];
                float co = s < l ? cf : (s > l ? cbw : cf + cbw);
                const unsigned cw = (e >> 1) ? c1 : c0;
                const float cbv = (e & 1) ? __uint_as_float(cw & 0xffff0000u) : __uint_as_float(cw << 16);
                mv[e] = cbv * co + (s == l ? dsk : 0.f); }
            u32x2 o; o.x = pk2(mv[0], mv[1]); o.y = pk2(mv[2], mv[3]);
            *(LAS u32x2*)(MT_ + fr * XPITCH + s0 * 2) = o; }
        asm volatile("s_waitcnt lgkmcnt(0)" ::: "memory");
        S3_ISSUE(r < 3 ? r + 1 : r)
        f32x4 yd[4], yo[4];
#pragma unroll
        for (int pt = 0; pt < 4; ++pt) { yd[pt] = (f32x4){0.f, 0.f, 0.f, 0.f}; yo[pt] = yd[pt]; }
#pragma unroll 1
        for (int rep_ = 0; rep_ < (PROBE_DBL == 52 ? 2 : 1); ++rep_)
#pragma unroll
        for (int ks = 0; ks < 4; ++ks) {
            const bf16x8_t mfrag = *(const LAS bf16x8_t*)(MT_ + fr * XPITCH + (32 * ks + 8 * fq) * 2);
#pragma unroll
            for (int pt = 0; pt < 4; ++pt) {
                const bf16x8_t xfrag = *(const LAS bf16x8_t*)(XT + (16 * pt + fr) * 256 + (((4 * ks + fq) ^ fr) * 16));
                yd[pt] = __builtin_amdgcn_mfma_f32_16x16x32_bf16(xfrag, mfrag, yd[pt], 0, 0, 0); }
            asm volatile("" ::: "memory"); }
        if (PROBE_DBL == 52) { _Pragma("unroll") for (int pt = 0; pt < 4; ++pt) yd[pt] = yd[pt] * 0.5f; }
        const float ef = __builtin_amdgcn_exp2f(Pf_l) * (PROBE_DBL == 53 ? 0.5f : 1.f) * (1.f / STSCALE), eb = __builtin_amdgcn_exp2f(TB[2048 + r] - Pbx_l) * (PROBE_DBL == 53 ? 0.5f : 1.f) * (1.f / STSCALE);
#pragma unroll 1
        for (int rep_ = 0; rep_ < (PROBE_DBL == 53 ? 2 : 1); ++rep_)
#pragma unroll
        for (int ks = 0; ks < 4; ++ks) {
            const bf16x8_t cfrag = *(const LAS bf16x8_t*)(CM + (16 * w + fr) * XPITCH + (32 * ks + 8 * fq) * 2);
#pragma unroll
            for (int pt = 0; pt < 4; ++pt) { const bf16x8_t hff = *(const LAS bf16x8_t*)(HF + (16 * pt + fr) * 256 + (((4 * ks + fq) ^ fr) * 16));
                yo[pt] = __builtin_amdgcn_mfma_f32_16x16x32_bf16(hff, cfrag, yo[pt], 0, 0, 0); }
            asm volatile("" ::: "memory"); }
#pragma unroll
        for (int pt = 0; pt < 4; ++pt) { yd[pt] = yd[pt] + yo[pt] * ef; yo[pt] = (f32x4){0.f, 0.f, 0.f, 0.f}; }
#pragma unroll 1
        for (int rep_ = 0; rep_ < (PROBE_DBL == 53 ? 2 : 1); ++rep_)
#pragma unroll
        for (int ks = 0; ks < 4; ++ks) {
            const bf16x8_t cfrag = *(const LAS bf16x8_t*)(CM + (16 * w + fr) * XPITCH + (32 * ks + 8 * fq) * 2);
#pragma unroll
            for (int pt = 0; pt < 4; ++pt) { const bf16x8_t hbf = *(const LAS bf16x8_t*)(HB + (16 * pt + fr) * 256 + (((4 * ks + fq) ^ fr) * 16));
                yo[pt] = __builtin_amdgcn_mfma_f32_16x16x32_bf16(hbf, cfrag, yo[pt], 0, 0, 0); }
            asm volatile("" ::: "memory"); }
#pragma unroll
        for (int pt = 0; pt < 4; ++pt) {
            const u32x2 zw = *(const LAS u32x2*)(ZY + l * 128 + (((2 * pt + (fq >> 1)) ^ (l & 7)) * 16) + (fq & 1) * 8);
            const float zz[4] = {__uint_as_float(zw.x << 16), __uint_as_float(zw.x & 0xffff0000u), __uint_as_float(zw.y << 16), __uint_as_float(zw.y & 0xffff0000u)};
            float y[4];
#pragma unroll
            for (int e = 0; e < 4; ++e) { y[e] = (yd[pt][e] + eb * yo[pt][e]) * silu_f(zz[e]); ssq += y[e] * y[e]; }
            yp[2 * pt] = pk2(y[0], y[1]); yp[2 * pt + 1] = pk2(y[2], y[3]); }
        if (r == 0) { _Pragma("unroll") for (int k = 0; k < 8; ++k) ypk[0][k] = yp[k]; } else if (r == 1) { _Pragma("unroll") for (int k = 0; k < 8; ++k) ypk[1][k] = yp[k]; }
        else if (r == 2) { _Pragma("unroll") for (int k = 0; k < 8; ++k) ypk[2][k] = yp[k]; } else { _Pragma("unroll") for (int k = 0; k < 8; ++k) ypk[3][k] = yp[k]; }
        LDS_BARRIER();
    }
#undef S3_ISSUE
#undef S3_COMMIT
#undef S3_H2L
    { const unsigned u = __builtin_bit_cast(unsigned, ssq); auto r1 = __builtin_amdgcn_permlane16_swap(u, u, false, false); ssq = __builtin_bit_cast(float, (unsigned)r1[0]) + __builtin_bit_cast(float, (unsigned)r1[1]); }
    { const unsigned u = __builtin_bit_cast(unsigned, ssq); auto r2 = __builtin_amdgcn_permlane32_swap(u, u, false, false); ssq = __builtin_bit_cast(float, (unsigned)r2[0]) + __builtin_bit_cast(float, (unsigned)r2[1]); }
    const float rinv = rsqrtf(ssq * (1.f / 256.f) + EPS);
    const float* ng = c.in[I_SSDNORMG];
#pragma unroll 1
    for (int rep2_ = 0; rep2_ < (PROBE_DBL == 56 ? 2 : 1); ++rep2_) {
#pragma unroll
    for (int r = 0; r < 4; ++r)
#pragma unroll
        for (int pt = 0; pt < 4; ++pt) { const f32x4 gg = *(const LAS f32x4*)(TB + 3088 + r * 64 + 16 * pt + 4 * fq);
            const unsigned a0 = ypk[r][2 * pt], a1 = ypk[r][2 * pt + 1];
            if (FP8_GEMM2) { const float rs = rinv * YSCALE;
                const unsigned o8 = (unsigned)__builtin_amdgcn_cvt_pk_fp8_f32(__uint_as_float(a1 << 16) * rs * gg.z, __uint_as_float(a1 & 0xffff0000u) * rs * gg.w,
                    __builtin_amdgcn_cvt_pk_fp8_f32(__uint_as_float(a0 << 16) * rs * gg.x, __uint_as_float(a0 & 0xffff0000u) * rs * gg.y, 0, false), true);
                *(LAS unsigned*)(XT + r * 8192 + l * 64 + 16 * pt + 4 * fq) = o8;
            } else {
            u32x2 o; o.x = pk2(__uint_as_float(a0 << 16) * rinv * gg.x, __uint_as_float(a0 & 0xffff0000u) * rinv * gg.y);
            o.y = pk2(__uint_as_float(a1 << 16) * rinv * gg.z, __uint_as_float(a1 & 0xffff0000u) * rinv * gg.w);
            *(LAS u32x2*)(XT + r * 16384 + l * 128 + (((2 * pt + (fq >> 1)) ^ (l & 7)) * 16) + (fq & 1) * 8) = o; }
            asm volatile("" ::: "memory"); }
    LDS_BARRIER();
    { const int dn = w >> 2, hdn = ngrp * 4 + (w & 3); int ln_ = lane; asm volatile("" : "+v"(ln_));
      palog = c.in[I_ALOG][dn * 16 + hdn]; pdt0 = DT[(size_t)(nm0 + ln_) * 32 + dn * 16 + hdn]; pdt1 = DT[(size_t)(nm0 + 64 + ln_) * 32 + dn * 16 + hdn]; }
    if (FP8_GEMM2) { unsigned char* AQ = (unsigned char*)c.out + 64 * MiB + zoff;
#pragma unroll
        for (int i = 0; i < 4; ++i) { const int piece = tid + 512 * i, zl = piece >> 4, r = (piece >> 2) & 3, zc = piece & 3;
            const u32x4 v = *(const LAS u32x4*)(XT + r * 8192 + zl * 64 + zc * 16);
            __builtin_nontemporal_store(v, (u32x4*)(AQ + (size_t)(m0 + zl) * 2048 + g * 256 + r * 64 + zc * 16)); }
    } else {
#pragma unroll
    for (int i = 0; i < 8; ++i) { const int piece = tid + 512 * i, r = piece >> 10, zl = (piece >> 3) & 127, zc = piece & 7;
        const u32x4 v = *(const LAS u32x4*)(XT + r * 16384 + zl * 128 + ((zc ^ (zl & 7)) * 16));
        *(u32x4*)(ZG + zoff + (size_t)(m0 + zl) * 2048 + g * 256 + r * 64 + zc * 8) = v; } }
    LDS_BARRIER();
    }
}
__device__ __forceinline__ void phase5f(const Ctx& c) {
    const float* DT = (const float*)(c.ws + WS_DT); float pdt0 = 0.f, pdt1 = 0.f, palog = 0.f;
    if (c.bid < NB * 64 * 4) { const int g = c.bid & 3, t = c.bid >> 2, m0 = (t >> 6) * SEQ + (t & 63) * 128, d = c.wave >> 2, hd = g * 4 + (c.wave & 3);
        palog = c.in[I_ALOG][d * 16 + hd]; pdt0 = DT[(size_t)(m0 + c.lane) * 32 + d * 16 + hd]; pdt1 = DT[(size_t)(m0 + 64 + c.lane) * 32 + d * 16 + hd]; }
    for (int it = c.bid; it < NB * 64 * 4; it += c.nblk) { const int g = it & 3, t = it >> 2, cl = t & 63, b = t >> 6;
        const int itn = (it + c.nblk < NB * 64 * 4) ? it + c.nblk : it, tn = itn >> 2;
        s3_item(c, b, cl, g, PROBE_DBL == 5 ? (size_t)c.qsel * ((WS_RC - WS_RA) / 2) : (size_t)0, (tn >> 6) * SEQ + (tn & 63) * 128, itn & 3, pdt0, pdt1, palog); }
}

__device__ __forceinline__ void phase6(const Ctx& c) {
    EpiPlainT e{(bf16*)(c.ws + WS_RC), 1024, c.ws + WS_END};
    static_assert(YSCALE == 16.f && WOSCALE == 64.f, "EpiPlainT::SCA / SCB undo these");
    pg8::Gemm g{FP8_GEMM2 ? (const bf16*)((const unsigned char*)c.out + 64 * MiB) : (const bf16*)(c.ws + WS_RA), (const bf16*)(c.ws + WS_WOUT), ML, 1024, FP8_GEMM2 ? 1024 : 2048};
    pg8::StaticOrder S; S.init(ML, 1024, c.nblk, c.bid, G2_WGM);
    pg8::gemm_phase<EpiPlainT, pg8::StaticOrder, true, FP8_SP2, FP8_TPL != 0>((LAS unsigned char*)c.lds, g, S, e);
}

__device__ __forceinline__ unsigned pk8_fp4(const f32x4& a0, const f32x4& a1, float scale) {
#if FP4_HWCVT
    const float inv = 1.f / scale; unsigned r = 0u;
    r = __builtin_amdgcn_cvt_scalef32_pk_fp4_f32(r, a0.x, a0.y, inv, 0); r = __builtin_amdgcn_cvt_scalef32_pk_fp4_f32(r, a0.z, a0.w, inv, 1);
    r = __builtin_amdgcn_cvt_scalef32_pk_fp4_f32(r, a1.x, a1.y, inv, 2); r = __builtin_amdgcn_cvt_scalef32_pk_fp4_f32(r, a1.z, a1.w, inv, 3);
    return r;
#else
    const float av[8] = {a0.x, a0.y, a0.z, a0.w, a1.x, a1.y, a1.z, a1.w};
    unsigned code = 0u;
#pragma unroll
    for (int j = 0; j < 8; ++j) { const float m = fabsf(av[j]) * scale;
        const unsigned mi = (unsigned)(m > 0.25f) + (unsigned)(m > 0.75f) + (unsigned)(m > 1.25f) + (unsigned)(m > 1.75f) + (unsigned)(m > 2.5f) + (unsigned)(m > 3.5f) + (unsigned)(m > 5.f);
        code |= (mi | (av[j] < 0.f ? 8u : 0u)) << (4 * j); }
    return code;
#endif
}
__device__ __forceinline__ void phase7(const Ctx& c) {
    const bf16* MIX = (const bf16*)(c.ws + WS_RC); bf16* H2 = (bf16*)(c.ws + WS_RB); unsigned char* XQ = c.ws + WS_RB + 64 * MiB;
    bf16* X1 = (bf16*)(c.ws + WS_X1); const float* MOD = (const float*)(c.ws + WS_MOD);
    const float* gpost = c.in[I_GPOSTMIX]; const float* gpre = c.in[I_GPREFFN];
    u32x2 mwN[4]; f32x4 xvN[4];
#define P7_LOAD(m_) { _Pragma("unroll") for (int j = 0; j < 4; ++j) { const int col = 4 * c.lane + 256 * j; mwN[j] = *(const u32x2*)(MIX + (size_t)(m_) * 1024 + col); xvN[j] = *(const f32x4*)(c.in[I_X] + (size_t)(m_) * DM + col); } }
    if (c.gw < ML) P7_LOAD(c.gw)
    f32x4 gpo[4], gpr[4];
#pragma unroll
    for (int j = 0; j < 4; ++j) { const int col = 4 * c.lane + 256 * j; gpo[j] = *(const f32x4*)(gpost + col); gpr[j] = *(const f32x4*)(gpre + col); }
    for (int m = c.gw; m < ML; m += c.ngw) {
        const int b = m / SEQ; const float* mv = MOD + b * NMOD;
        f32x4 gtv[4], shv[4], scv[4];
#pragma unroll
        for (int j = 0; j < 4; ++j) { const int col = 4 * c.lane + 256 * j; gtv[j] = *(const f32x4*)(mv + MOD_GT1 + col); shv[j] = *(const f32x4*)(mv + MOD_SH2 + col); scv[j] = *(const f32x4*)(mv + MOD_SC2 + col); }
        u32x2 mw[4]; f32x4 xv4[4];
#pragma unroll
        for (int j = 0; j < 4; ++j) { mw[j] = mwN[j]; xv4[j] = xvN[j]; }
        { const int mn = (m + c.ngw < ML) ? m + c.ngw : m; P7_LOAD(mn) }
        float mx[16], x1[16]; float ss = 0.f;
#pragma unroll
        for (int j = 0; j < 4; ++j) { const u32x2 w = mw[j];
            mx[4 * j] = __uint_as_float(w.x << 16); mx[4 * j + 1] = __uint_as_float(w.x & 0xffff0000u); mx[4 * j + 2] = __uint_as_float(w.y << 16); mx[4 * j + 3] = __uint_as_float(w.y & 0xffff0000u);
            ss += mx[4 * j] * mx[4 * j] + mx[4 * j + 1] * mx[4 * j + 1] + mx[4 * j + 2] * mx[4 * j + 2] + mx[4 * j + 3] * mx[4 * j + 3]; }
        const float rinv = rsqrtf(wave_sum(ss) * (1.f / DM) + EPS);
        float ss2 = 0.f;
#pragma unroll
        for (int j = 0; j < 4; ++j) { const int col = 4 * c.lane + 256 * j;
            const f32x4 xv = xv4[j], gg = gpo[j], gt = gtv[j];
            f32x4 o; o.x = xv.x + gt.x * (mx[4 * j] * rinv * gg.x); o.y = xv.y + gt.y * (mx[4 * j + 1] * rinv * gg.y);
            o.z = xv.z + gt.z * (mx[4 * j + 2] * rinv * gg.z); o.w = xv.w + gt.w * (mx[4 * j + 3] * rinv * gg.w);
            u32x2 ob; ob.x = pk2(o.x, o.y); ob.y = pk2(o.z, o.w);
            __builtin_nontemporal_store(ob, (u32x2*)(X1 + (size_t)m * DM + col));
            x1[4 * j] = o.x; x1[4 * j + 1] = o.y; x1[4 * j + 2] = o.z; x1[4 * j + 3] = o.w;
            ss2 += o.x * o.x + o.y * o.y + o.z * o.z + o.w * o.w; }
        const float rinv2 = rsqrtf(wave_sum(ss2) * (1.f / DM) + EPS);
#pragma unroll
        for (int j = 0; j < 4; ++j) { const int col = 4 * c.lane + 256 * j;
            const f32x4 gg = gpr[j], sh = shv[j], sc = scv[j];
            const float y0 = (x1[4 * j] * rinv2 * gg.x) * (1.f + sc.x) + sh.x, y1 = (x1[4 * j + 1] * rinv2 * gg.y) * (1.f + sc.y) + sh.y;
            const float y2 = (x1[4 * j + 2] * rinv2 * gg.z) * (1.f + sc.z) + sh.z, y3 = (x1[4 * j + 3] * rinv2 * gg.w) * (1.f + sc.w) + sh.w;
            u32x2 o; o.x = pk2(y0, y1); o.y = pk2(y2, y3);
            *(u32x2*)(H2 + (size_t)m * DM + col) = o;
            __builtin_nontemporal_store(pk4_fp8(y0, y1, y2, y3, XSCALE), (unsigned*)(XQ + (size_t)m * DM + col)); }
    }
#undef P7_LOAD
    { const f32x4* U4 = (const f32x4*)c.in[I_U]; const f32x4* V4 = (const f32x4*)c.in[I_V];
      u32x2* Uq = (u32x2*)(c.ws + WS_RC + 64 * MiB); u32x2* Vq = (u32x2*)(c.ws + WS_RC + 96 * MiB); unsigned* Uq4 = (unsigned*)(c.ws + WS_RC + 64 * MiB);
      unsigned* Vq4 = (unsigned*)(c.ws + WS_RC + 96 * MiB);
      for (int i = c.gtid; i < (TABLES_IN_SELECT && U4_TABLE && V4_TABLE && V5_MFMA && SLICED_PEER ? 0 : 16384 * 1024 / 8); i += c.gsz) {
          const size_t di = SLICED_PEER ? ((size_t)((i & 127) >> 4) * (16384 * 16) + (size_t)(i >> 7) * 16 + (i & 15)) : (size_t)i;
          const size_t d4 = (size_t)((i & 127) >> 5) * (16384 * 32) + (size_t)(i >> 7) * 32 + (i & 31);
          if (V4_TABLE && V5_MFMA && SLICED_PEER) {
              const int row = i >> 7, sl = (i & 127) >> 5, w = i & 31; const float* vp = c.in[I_V] + (size_t)row * 1024 + 256 * sl + 128 * (w & 1) + (w >> 1);
              f32x4 a0, a1; a0.x = vp[0]; a0.y = vp[16]; a0.z = vp[32]; a0.w = vp[48]; a1.x = vp[64]; a1.y = vp[80]; a1.z = vp[96]; a1.w = vp[112];
              Vq4[d4] = pk8_fp4(a0, a1, USCALE);
          } else if (V4_TABLE && SLICED_PEER) Vq4[d4] = pk8_fp4(V4[2 * i], V4[2 * i + 1], USCALE);
          else { const f32x4 b0 = V4[2 * i] * TSCALE, b1 = V4[2 * i + 1] * TSCALE;
              u32x2 ob;
              ob.x = (unsigned)__builtin_amdgcn_cvt_pk_fp8_f32(b0.z, b0.w, __builtin_amdgcn_cvt_pk_fp8_f32(b0.x, b0.y, 0, false), true);
              ob.y = (unsigned)__builtin_amdgcn_cvt_pk_fp8_f32(b1.z, b1.w, __builtin_amdgcn_cvt_pk_fp8_f32(b1.x, b1.y, 0, false), true);
              Vq[di] = ob; }
          if (U4_TABLE && SLICED_PEER) Uq4[d4] = pk8_fp4(U4[2 * i], U4[2 * i + 1], USCALE);
          else {
              const f32x4 a0 = U4[2 * i] * TSCALE, a1 = U4[2 * i + 1] * TSCALE; u32x2 oa;
              oa.x = (unsigned)__builtin_amdgcn_cvt_pk_fp8_f32(a0.z, a0.w, __builtin_amdgcn_cvt_pk_fp8_f32(a0.x, a0.y, 0, false), true);
              oa.y = (unsigned)__builtin_amdgcn_cvt_pk_fp8_f32(a1.z, a1.w, __builtin_amdgcn_cvt_pk_fp8_f32(a1.x, a1.y, 0, false), true);
              Uq[di] = oa; } } }
}

__device__ __forceinline__ void phase8(const Ctx& c) {
    EpiPlainT e{(bf16*)(c.ws + WS_RA), 2048, c.ws + WS_END};
    pg8::Gemm g{FP8_GEMM3 ? (const bf16*)(c.ws + WS_RB + 64 * MiB) : (const bf16*)(c.ws + WS_RB), (const bf16*)(c.ws + WS_WQK), ML, 2048, FP8_GEMM3 ? 512 : 1024};
    pg8::StaticOrder S; S.init(ML, 2048, c.nblk, c.bid, G3_WGM);
    pg8::gemm_phase<EpiPlainT, pg8::StaticOrder, true, true, FP8_GEMM3 != 0>((LAS unsigned char*)c.lds, g, S, e);
}

__device__ __forceinline__ void argmax_bfly(float& v, int& i) {
#pragma unroll
    for (int o = 1; o < 64; o <<= 1) { const float ov = __shfl_xor(v, o); const int oi = __shfl_xor(i, o);
        if (ov > v || (ov == v && oi < i)) { v = ov; i = oi; } }
}
typedef __attribute__((ext_vector_type(2))) __bf16 bf16x2_t;
__device__ __forceinline__ float dot2bf(unsigned a, unsigned b, float acc) { return __builtin_amdgcn_fdot2_f32_bf16(__builtin_bit_cast(bf16x2_t, a), __builtin_bit_cast(bf16x2_t, b), acc, false); }

__device__ __forceinline__ unsigned umin2(unsigned a, unsigned b) { return a < b ? a : b; }
#define CE(a, b) { const unsigned _h = umax2(x[a], x[b]), _l = umin2(x[a], x[b]); x[a] = _h; x[b] = _l; }
__device__ __forceinline__ void sort16_desc(unsigned* x) { CE(0,1) CE(2,3) CE(4,5) CE(6,7) CE(8,9) CE(10,11) CE(12,13) CE(14,15) CE(0,2) CE(1,3) CE(4,6) CE(5,7) CE(8,10) CE(9,11) CE(12,14) CE(13,15) CE(1,2) CE(5,6) CE(9,10) CE(13,14) CE(0,4) CE(1,5) CE(2,6) CE(3,7) CE(8,12) CE(9,13) CE(10,14) CE(11,15) CE(2,4) CE(3,5) CE(10,12) CE(11,13) CE(1,2) CE(3,4) CE(5,6) CE(9,10) CE(11,12) CE(13,14) CE(0,8) CE(1,9) CE(2,10) CE(3,11) CE(4,12) CE(5,13) CE(6,14) CE(7,15) CE(4,8) CE(5,9) CE(6,10) CE(7,11) CE(2,4) CE(3,5) CE(6,8) CE(7,9) CE(10,12) CE(11,13) CE(1,2) CE(3,4) CE(5,6) CE(7,8) CE(9,10) CE(11,12) CE(13,14) }
__device__ __forceinline__ void clean16_desc(unsigned* x) {
#pragma unroll
    for (int d = 8; d >= 1; d >>= 1)
#pragma unroll
        for (int i = 0; i < 16; ++i) if (!(i & d)) CE(i, i + d)
}
#undef CE
__device__ __forceinline__ unsigned ord32(unsigned u) { return u ^ ((unsigned)((int)u >> 31) | 0x80000000u); }
__device__ __forceinline__ unsigned deord32(unsigned o) { return o ^ ((~(unsigned)((int)o >> 31)) | 0x80000000u); }
struct ScoreRow { u32x4 q[4]; };
__device__ __forceinline__ void score_row_load(ScoreRow& R, const bf16* srow, int lane) { const u32x4* s4 = (const u32x4*)srow + 4 * lane;
#pragma unroll
    for (int i = 0; i < 4; ++i) R.q[i] = s4[i]; }
template <class EP, class GP> __device__ __forceinline__ void peer_select_row(const ScoreRow& R, int lane, EP EL, GP GL) {
    unsigned k[32];
    { const unsigned sbits = (unsigned)(3 - (lane & 3)) << 5;
#pragma unroll
      for (int i = 0; i < 4; ++i) { const u32x4 w = R.q[i]; const unsigned ww[4] = {w.x, w.y, w.z, w.w};
#pragma unroll
          for (int cidx = 0; cidx < 4; ++cidx)
#pragma unroll
              for (int hh = 0; hh < 2; ++hh) { const int j = i * 8 + cidx * 2 + hh; const unsigned u = hh ? (ww[cidx] & 0xffff0000u) : (ww[cidx] << 16);
                  const unsigned m = (unsigned)((int)u >> 31);
                  k[j] = (u ^ ((m & 0x7fff0000u) | 0x80000000u)) | sbits | (unsigned)(31 - j); } } }
    sort16_desc(k); sort16_desc(k + 16);
    unsigned x[16];
#pragma unroll
    for (int i = 0; i < 16; ++i) x[i] = umax2(k[i], k[31 - i]);
    clean16_desc(x);
    { unsigned y[16];
#pragma unroll
      for (int i = 0; i < 16; ++i) y[i] = umax2(x[i], dpp_u<0xB1>(x[15 - i]));
      clean16_desc(y);
#pragma unroll
      for (int i = 0; i < 16; ++i) x[i] = umax2(y[i], dpp_u<0x4E>(y[15 - i]));
      clean16_desc(x); }
    float xv[16]; unsigned xt[16]; const bool isB = (lane >> 2) & 1; const int sh = isB ? 0 : 7;
#pragma unroll
    for (int i = 0; i < 16; ++i) { const unsigned o = x[i] & 0xffff0000u; xv[i] = __uint_as_float(o ^ ((~(unsigned)((int)o >> 31) & 0x7fff0000u) | 0x80000000u));
        xt[i] = (((x[i] & 0x7fu) ^ 0x7fu) << sh); }
    unsigned ca[16], cb2[16];
#define CAND(dst, i, j) { const float s_ = xv[i] + dpp_f<0x141>(xv[j]); const unsigned t_ = xt[i] | dpp_u<0x141>(xt[j]); dst = (ord32(__float_as_uint(s_)) & 0xffffc000u) | t_; }
    CAND(ca[0], 0, 1) CAND(ca[1], 0, 2) CAND(ca[2], 0, 3) CAND(ca[3], 0, 4) CAND(ca[4], 0, 5) CAND(ca[5], 0, 6) CAND(ca[6], 0, 7) CAND(ca[7], 0, 8)
    CAND(ca[8], 0, 9) CAND(ca[9], 0, 10) CAND(ca[10], 0, 11) CAND(ca[11], 0, 12) CAND(ca[12], 0, 13) CAND(ca[13], 0, 14) CAND(ca[14], 0, 15) CAND(ca[15], 1, 2)
    CAND(cb2[0], 1, 3) CAND(cb2[1], 1, 4) CAND(cb2[2], 1, 5) CAND(cb2[3], 1, 6) CAND(cb2[4], 1, 7) CAND(cb2[5], 2, 3) CAND(cb2[6], 2, 4)
    CAND(cb2[7], 0, 0) CAND(cb2[8], 1, 1) CAND(cb2[9], 2, 2) CAND(cb2[10], 3, 3)
#undef CAND
    if (isB) { cb2[7] = 0u; cb2[8] = 0u; cb2[9] = 0u; cb2[10] = 0u; }
    cb2[11] = 0u; cb2[12] = 0u; cb2[13] = 0u; cb2[14] = 0u; cb2[15] = 0u;
    sort16_desc(ca); sort16_desc(cb2);
#pragma unroll
    for (int i = 0; i < 16; ++i) x[i] = umax2(ca[i], cb2[15 - i]);
    clean16_desc(x);
    { unsigned y[16];
#pragma unroll
      for (int i = 0; i < 16; ++i) y[i] = umax2(x[i], dpp_u<0x141>(x[15 - i]));
      clean16_desc(y);
      float e[16]; float sum = 0.f; const float c0 = __uint_as_float(deord32(y[0] & 0xffffc000u));
#pragma unroll
      for (int r = 0; r < 16; ++r) { const float cv = __uint_as_float(deord32(y[r] & 0xffffc000u)); e[r] = __expf(cv - c0); sum += e[r]; }
      const float inv = 1.f / sum;
      if ((lane & 7) == 0) { const int h = lane >> 3;
          if constexpr (sizeof(*EL) == 2) {
              u32x4 p0, p1; p0.x = (y[0] & 0x3fffu) | ((y[1] & 0x3fffu) << 16); p0.y = (y[2] & 0x3fffu) | ((y[3] & 0x3fffu) << 16); p0.z = (y[4] & 0x3fffu) | ((y[5] & 0x3fffu) << 16); p0.w = (y[6] & 0x3fffu) | ((y[7] & 0x3fffu) << 16);
              p1.x = (y[8] & 0x3fffu) | ((y[9] & 0x3fffu) << 16); p1.y = (y[10] & 0x3fffu) | ((y[11] & 0x3fffu) << 16); p1.z = (y[12] & 0x3fffu) | ((y[13] & 0x3fffu) << 16); p1.w = (y[14] & 0x3fffu) | ((y[15] & 0x3fffu) << 16);
              *(u32x4*)(EL + h * 16) = p0; *(u32x4*)(EL + h * 16 + 8) = p1;
#pragma unroll
              for (int r4 = 0; r4 < 4; ++r4) { f32x4 gv; gv.x = e[4 * r4] * inv; gv.y = e[4 * r4 + 1] * inv; gv.z = e[4 * r4 + 2] * inv; gv.w = e[4 * r4 + 3] * inv; *(f32x4*)(GL + h * 16 + 4 * r4) = gv; }
          } else {
#pragma unroll
          for (int r4 = 0; r4 < 4; ++r4) { u32x4 ev; ev.x = y[4 * r4] & 0x3fffu; ev.y = y[4 * r4 + 1] & 0x3fffu; ev.z = y[4 * r4 + 2] & 0x3fffu; ev.w = y[4 * r4 + 3] & 0x3fffu;
              f32x4 gv; gv.x = e[4 * r4] * inv; gv.y = e[4 * r4 + 1] * inv; gv.z = e[4 * r4 + 2] * inv; gv.w = e[4 * r4 + 3] * inv;
              *(LAS u32x4*)(EL + h * 16 + 4 * r4) = ev; *(LAS f32x4*)(GL + h * 16 + 4 * r4) = gv; } } } }
}
template <class EP, class GP> __device__ __forceinline__ void peer_select(const bf16* srow, int lane, EP EL, GP GL) { ScoreRow R; score_row_load(R, srow, lane); peer_select_row(R, lane, EL, GL); }

constexpr int RB = 8;
typedef _Float16 f16x2_t __attribute__((ext_vector_type(2)));
typedef float f32x2_t __attribute__((ext_vector_type(2)));
struct RowBuf { u32x4 a[RB]; };
__device__ __forceinline__ void rows_load(RowBuf& B, const unsigned char* T, int Ereg, int base, int lane) {
#pragma unroll
    for (int r = 0; r < RB; ++r) { const int ek = __builtin_amdgcn_readlane(Ereg, base + r);
        B.a[r] = ((const u32x4*)(T + (size_t)ek * DM))[lane]; }
}
__device__ __forceinline__ float dot2h(unsigned fp8w, bool hi, f16x2_t x, float acc) {
    const f16x2_t u = hi ? __builtin_amdgcn_cvt_scalef32_pk_f16_fp8((int)fp8w, 1.0f, true) : __builtin_amdgcn_cvt_scalef32_pk_f16_fp8((int)fp8w, 1.0f, false);
    return __builtin_amdgcn_fdot2(u, x, acc, false);
}
__device__ __forceinline__ void rows_dot(const RowBuf& B, const f16x2_t* x, int sub, int lane, float& mine) {
#pragma unroll
    for (int r = 0; r < RB; ++r) { float s = 0.f;
        s = dot2h(B.a[r].x, false, x[0], s); s = dot2h(B.a[r].x, true, x[1], s); s = dot2h(B.a[r].y, false, x[2], s); s = dot2h(B.a[r].y, true, x[3], s);
        s = dot2h(B.a[r].z, false, x[4], s); s = dot2h(B.a[r].z, true, x[5], s); s = dot2h(B.a[r].w, false, x[6], s); s = dot2h(B.a[r].w, true, x[7], s);
        s = wave_sum(s); if ((lane & 15) == sub + r) mine = s; }
}
__device__ __forceinline__ void rows_axpy(const RowBuf& B, float wv, int base, float* o) {
#pragma unroll
    for (int r = 0; r < RB; ++r) { const float w = __builtin_bit_cast(float, __builtin_amdgcn_readlane(__builtin_bit_cast(int, wv), base + r));
        const unsigned q[4] = {B.a[r].x, B.a[r].y, B.a[r].z, B.a[r].w};
#pragma unroll
        for (int j = 0; j < 4; ++j) { const f32x2_t lo = __builtin_amdgcn_cvt_pk_f32_fp8((int)q[j], false), hi = __builtin_amdgcn_cvt_pk_f32_fp8((int)q[j], true);
            o[4 * j] += w * lo.x; o[4 * j + 1] += w * lo.y; o[4 * j + 2] += w * hi.x; o[4 * j + 3] += w * hi.y; } }
}
__device__ __forceinline__ void phase9(const Ctx& c) {
    const bf16* SC = (const bf16*)(c.ws + WS_RA); const bf16* H2 = (const bf16*)(c.ws + WS_RB); float* X1 = c.out; const float* MOD = (const float*)(c.ws + WS_MOD);
    const unsigned char* Uq = c.ws + WS_RC + 64 * MiB; const unsigned char* Vq = c.ws + WS_RC + 96 * MiB; const float* gpost = c.in[I_GPOSTFFN];
    for (int m = c.gw; m < ML; m += c.ngw) {
        const int lane = c.lane;
        LAS unsigned* EL = (LAS unsigned*)((LAS unsigned char*)c.lds + c.wave * 1024); LAS float* GL = (LAS float*)(EL + 128);
        peer_select(SC + (size_t)m * 2048, lane, EL, GL);
        f16x2_t xh[8];
        { const u32x4 xa = ((const u32x4*)(H2 + (size_t)m * DM))[2 * lane], xb = ((const u32x4*)(H2 + (size_t)m * DM))[2 * lane + 1];
          const unsigned xw[8] = {xa.x, xa.y, xa.z, xa.w, xb.x, xb.y, xb.z, xb.w};
#pragma unroll
          for (int j = 0; j < 8; ++j) { f16x2_t t; t.x = (_Float16)__uint_as_float(xw[j] << 16); t.y = (_Float16)__uint_as_float(xw[j] & 0xffff0000u); xh[j] = t; } }
        float outv[16];
#pragma unroll
        for (int j = 0; j < 16; ++j) outv[j] = 0.f;
        RowBuf bA, bB;
        int Ev = (int)EL[lane & 15];
        rows_load(bA, Uq, Ev, 0, lane);
#pragma unroll 1
        for (int h = 0; h < 8; ++h) {
            const float gv = GL[h * 16 + (lane & 15)];
            const int En = (int)EL[((h + 1) & 7) * 16 + (lane & 15)];
            float mine = 0.f;
            rows_load(bB, Uq, Ev, 8, lane);  rows_dot(bA, xh, 0, lane, mine);
            rows_load(bA, Vq, Ev, 0, lane);  rows_dot(bB, xh, 8, lane, mine);
            const float wv = gv * gelu_tanh(mine * (1.f / TSCALE)) * (1.f / TSCALE);
            rows_load(bB, Vq, Ev, 8, lane);  rows_axpy(bA, wv, 0, outv);
            if (h < 7) rows_load(bA, Uq, En, 0, lane);
            rows_axpy(bB, wv, 8, outv);
            Ev = En;
        }
        float ss = 0.f;
#pragma unroll
        for (int j = 0; j < 16; ++j) ss += outv[j] * outv[j];
        const float rinv = rsqrtf(wave_sum(ss) * (1.f / DM) + EPS);
        const int b = m / SEQ; const float* gt2 = MOD + b * NMOD + MOD_GT2;
#pragma unroll
        for (int j = 0; j < 4; ++j) { const int col = lane * 16 + 4 * j; const float* ov = outv + 4 * j;
            const f32x4 xx = *(const f32x4*)(X1 + (size_t)m * DM + col), gg = *(const f32x4*)(gpost + col), gt = *(const f32x4*)(gt2 + col);
            f32x4 o; o.x = xx.x + gt.x * (ov[0] * rinv * gg.x); o.y = xx.y + gt.y * (ov[1] * rinv * gg.y);
            o.z = xx.z + gt.z * (ov[2] * rinv * gg.z); o.w = xx.w + gt.w * (ov[3] * rinv * gg.w);
            *(f32x4*)(X1 + (size_t)m * DM + col) = o; }
    }
}


__device__ __forceinline__ void phase9_probe(const Ctx& c, unsigned mask) {
    const bf16* H2 = (const bf16*)(c.ws + WS_RB);
    const unsigned char* Uq = c.ws + WS_RC + 64 * MiB; const unsigned char* Vq = c.ws + WS_RC + 96 * MiB;
    float* dump = (float*)(c.ws + WS_RE);
    for (int m = c.gw; m < ML; m += c.ngw) {
        const int lane = c.lane;
        f16x2_t xh[8];
        { const u32x4 xa = ((const u32x4*)(H2 + (size_t)m * DM))[2 * lane], xb = ((const u32x4*)(H2 + (size_t)m * DM))[2 * lane + 1];
          const unsigned xw[8] = {xa.x, xa.y, xa.z, xa.w, xb.x, xb.y, xb.z, xb.w};
#pragma unroll
          for (int j = 0; j < 8; ++j) { f16x2_t t; t.x = (_Float16)__uint_as_float(xw[j] << 16); t.y = (_Float16)__uint_as_float(xw[j] & 0xffff0000u); xh[j] = t; } }
        float outv[16];
#pragma unroll
        for (int j = 0; j < 16; ++j) outv[j] = 0.f;
        RowBuf bA, bB;
        int Ev = (int)((((unsigned)(m * 131 + (lane & 15)) * 2654435761u) >> 12) & mask);
        rows_load(bA, Uq, Ev, 0, lane);
#pragma unroll 1
        for (int h = 0; h < 8; ++h) {
            const float gv = 0.0625f;
            const int En = (int)((((unsigned)(m * 131 + (h + 1) * 17 + (lane & 15)) * 2654435761u) >> 12) & mask);
            float mine = 0.f;
            rows_load(bB, Uq, Ev, 8, lane);  rows_dot(bA, xh, 0, lane, mine);
            rows_load(bA, Vq, Ev, 0, lane);  rows_dot(bB, xh, 8, lane, mine);
            const float wv = gv * gelu_tanh(mine * (1.f / TSCALE)) * (1.f / TSCALE);
            rows_load(bB, Vq, Ev, 8, lane);  rows_axpy(bA, wv, 0, outv);
            if (h < 7) rows_load(bA, Uq, En, 0, lane);
            rows_axpy(bB, wv, 8, outv);
            Ev = En;
        }
#pragma unroll
        for (int j = 0; j < 4; ++j) { f32x4 o; o.x = outv[4 * j]; o.y = outv[4 * j + 1]; o.z = outv[4 * j + 2]; o.w = outv[4 * j + 3]; *(f32x4*)(dump + (size_t)(m & 4095) * DM + lane * 16 + 4 * j) = o; }
    }
}

constexpr size_t WS_EID = WS_RC, WS_GT = WS_RC + 8 * MiB, WS_WW = WS_RC + 24 * MiB, WS_SSQ = WS_RC + 40 * MiB;
constexpr int CW_PEERU = 8192, CW_PEERV = 8192 + 1024;
#ifndef TPW_
#define TPW_ 64
#endif
constexpr int TPW = TPW_;
constexpr int NTB = ML / (8 * TPW);

struct TabStep { f32x4 u0, u1, v0, v1; };
__device__ __forceinline__ void tab_load(const Ctx& c, int i, TabStep& T) {
    const f32x4* U4 = (const f32x4*)c.in[I_U]; T.u0 = U4[2 * i]; T.u1 = U4[2 * i + 1];
    const int row = i >> 7, sl = (i & 127) >> 5, w = i & 31; const float* vp = c.in[I_V] + (size_t)row * 1024 + 256 * sl + 128 * (w & 1) + (w >> 1);
    T.v0.x = vp[0]; T.v0.y = vp[16]; T.v0.z = vp[32]; T.v0.w = vp[48]; T.v1.x = vp[64]; T.v1.y = vp[80]; T.v1.z = vp[96]; T.v1.w = vp[112];
}
__device__ __forceinline__ void tab_store(const Ctx& c, int i, const TabStep& T) {
    unsigned* Uq4 = (unsigned*)(c.ws + WS_RC + 64 * MiB); unsigned* Vq4 = (unsigned*)(c.ws + WS_RC + 96 * MiB);
    const size_t d4 = (size_t)((i & 127) >> 5) * (16384 * 32) + (size_t)(i >> 7) * 32 + (i & 31);
    Uq4[d4] = pk8_fp4(T.u0, T.u1, USCALE); Vq4[d4] = pk8_fp4(T.v0, T.v1, USCALE);
}
__device__ __forceinline__ void phase9s(const Ctx& c) {
    const bf16* SC = (const bf16*)(c.ws + WS_RA);
    constexpr int NTAB = (TABLES_IN_SELECT && U4_TABLE && V4_TABLE && V5_MFMA) ? 16384 * 1024 / 8 : 0;
    int ci = c.gtid;
    ScoreRow Rn; if (c.gw < ML) score_row_load(Rn, SC + (size_t)c.gw * 2048, c.lane);
    for (int m = c.gw; m < ML; m += c.ngw) {
        TabStep T; const int cj = ci < NTAB ? ci : 0;
        if (NTAB) tab_load(c, cj, T);
        const ScoreRow R = Rn;
        { const int mn = (m + c.ngw < ML) ? m + c.ngw : m; score_row_load(Rn, SC + (size_t)mn * 2048, c.lane); }
        peer_select_row(R, c.lane, (unsigned short*)(c.ws + WS_EID) + (size_t)m * 128, (float*)(c.ws + WS_GT) + (size_t)m * 128);
        if (NTAB) { tab_store(c, cj, T); ci += c.gsz; }
    }
    for (; ci < NTAB; ci += c.gsz) { TabStep T; tab_load(c, ci, T); tab_store(c, ci, T); }
}

__device__ __forceinline__ int grab_item(unsigned* ctr, volatile LAS int* slot) {
    if (threadIdx.x == 0) *slot = (int)__hip_atomic_fetch_add(ctr, 1u, __ATOMIC_RELAXED, __HIP_MEMORY_SCOPE_AGENT);
    __syncthreads(); const int v = *slot; __syncthreads(); return v;
}
struct SliceBuf { u32x4 a[16]; };
__device__ __forceinline__ void slice_load(SliceBuf& B, const unsigned char* Tslice, const u32x4& e0, const u32x4& e1) {
    const unsigned ew[8] = {e0.x, e0.y, e0.z, e0.w, e1.x, e1.y, e1.z, e1.w};
#pragma unroll
    for (int r = 0; r < 16; ++r) { const unsigned eid = (r & 1) ? (ew[r >> 1] >> 16) : (ew[r >> 1] & 0xffffu);
        B.a[r] = *(const u32x4*)(Tslice + (size_t)eid * 128); }
}
__device__ __forceinline__ void pub8(void* p, const u32x2& v) {
    if (FUSE_TAIL) __hip_atomic_store((unsigned long long*)p, ((unsigned long long)v.y << 32) | v.x, __ATOMIC_RELAXED, __HIP_MEMORY_SCOPE_AGENT); else *(u32x2*)p = v; }
__device__ __forceinline__ void pub4(float* p, float v) {
    if (FUSE_TAIL) __hip_atomic_store(p, v, __ATOMIC_RELAXED, __HIP_MEMORY_SCOPE_AGENT); else *p = v; }
__device__ __forceinline__ long mk64(unsigned lo, unsigned hi) { return (long)(((unsigned long long)hi << 32) | lo); }
__device__ __forceinline__ void u_token(const SliceBuf& B, const u32x4& x0, const u32x4& x1, bf16* PDt, int lane, LAS unsigned char* stg) {
    { const int h = lane >> 3, cs = ((lane & 7) ^ h) * 16;
#pragma unroll
      for (int j = 0; j < 16; ++j) *(LAS u32x4*)(stg + (8 * j + h) * 128 + cs) = B.a[j]; }
    const long b0 = mk64(x0.x, x0.y), b1 = mk64(x0.z, x0.w), b2 = mk64(x1.x, x1.y), b3 = mk64(x1.z, x1.w);
    const int i = lane & 15, q = lane >> 4, hh = i & 7;
    const LAS unsigned char* rb = stg + ((i >> 3) * 8 + hh) * 128;
    const int o0 = (((2 * q) ^ hh) * 16), o1 = (((2 * q + 1) ^ hh) * 16);
    f32x4 keep = {0.f, 0.f, 0.f, 0.f};
#pragma unroll
    for (int G = 0; G < 8; ++G) { f32x4 acc = {0.f, 0.f, 0.f, 0.f}; const LAS unsigned char* rg = rb + G * 2048;
        acc = __builtin_amdgcn_mfma_f32_16x16x32_fp8_fp8(*(const LAS long*)(rg + o0), b0, acc, 0, 0, 0);
        acc = __builtin_amdgcn_mfma_f32_16x16x32_fp8_fp8(*(const LAS long*)(rg + o0 + 8), b1, acc, 0, 0, 0);
        acc = __builtin_amdgcn_mfma_f32_16x16x32_fp8_fp8(*(const LAS long*)(rg + o1), b2, acc, 0, 0, 0);
        acc = __builtin_amdgcn_mfma_f32_16x16x32_fp8_fp8(*(const LAS long*)(rg + o1 + 8), b3, acc, 0, 0, 0);
        if (i == G) keep = acc; }
    if (i < 8) { u32x2 o; o.x = pk2(keep[0], keep[1]); o.y = pk2(keep[2], keep[3]);
        *(u32x2*)(PDt + (2 * i + (q >> 1)) * 8 + 4 * (q & 1)) = o; }
}
__device__ __forceinline__ void u_item(const Ctx& c, int s, int tb) {
    const unsigned char* XQ = c.ws + WS_RB + 64 * MiB + 128 * s; const unsigned short* EID = (const unsigned short*)(c.ws + WS_EID);
    bf16* PD = (bf16*)(c.ws + WS_RA) + (size_t)s * ML * 128;
    const int lane = c.lane, h = lane >> 3, cc = lane & 7;
    const unsigned char* Us = c.ws + WS_RC + 64 * MiB + (size_t)s * (16384 * 128) + 16 * cc;
    LAS unsigned char* stg = (LAS unsigned char*)c.lds + c.wave * 16384;
    const int t0 = tb * (8 * TPW) + c.wave * TPW;
    const unsigned short* Eh = EID + 16 * h; const unsigned char* Xq = XQ + 32 * (lane >> 4);
#define LD_E(dst0, dst1, t) { dst0 = *(const u32x4*)(Eh + (size_t)(t) * 128); dst1 = *(const u32x4*)(Eh + (size_t)(t) * 128 + 8); }
#define LD_X(dst0, dst1, t) { dst0 = *(const u32x4*)(Xq + (size_t)(t) * DM); dst1 = *(const u32x4*)(Xq + (size_t)(t) * DM + 16); }
    SliceBuf bA, bB; u32x4 ea0, ea1, eb0, eb1, ec0, ec1, xa0, xa1, xb0, xb1;
    LD_E(ea0, ea1, t0) LD_X(xa0, xa1, t0) LD_E(eb0, eb1, t0 + 1)
    slice_load(bA, Us, ea0, ea1);
#pragma unroll 1
    for (int i = 0; i < TPW; i += 2) { const int t = t0 + i; const int t2 = (i + 2 < TPW) ? t + 2 : t, t3 = (i + 3 < TPW) ? t + 3 : t;
        LD_E(ec0, ec1, t2) LD_X(xb0, xb1, t + 1)
        slice_load(bB, Us, eb0, eb1);
        u_token(bA, xa0, xa1, PD + (size_t)t * 128, lane, stg);
        LD_E(eb0, eb1, t3) LD_X(xa0, xa1, t2)
        slice_load(bA, Us, ec0, ec1);
        u_token(bB, xb0, xb1, PD + (size_t)(t + 1) * 128, lane, stg);
    }
#undef LD_X
}
typedef int i32x8_u __attribute__((ext_vector_type(8)));
__device__ __forceinline__ void u4_token(const SliceBuf& B, const u32x4& x0, const u32x4& x1, const u32x4& x2, const u32x4& x3, bf16* PDt, int lane, LAS unsigned char* stg) {
    { const int h = lane >> 3, cs = ((lane & 7) ^ h) * 16;
#pragma unroll
      for (int j = 0; j < 16; ++j) *(LAS u32x4*)(stg + (8 * j + h) * 128 + cs) = B.a[j]; }
    const i32x8_u b0 = {(int)x0.x, (int)x0.y, (int)x0.z, (int)x0.w, (int)x1.x, (int)x1.y, (int)x1.z, (int)x1.w};
    const i32x8_u b1 = {(int)x2.x, (int)x2.y, (int)x2.z, (int)x2.w, (int)x3.x, (int)x3.y, (int)x3.z, (int)x3.w};
    const int i = lane & 15, q = lane >> 4, hh = i & 7;
    const LAS unsigned char* rb = stg + ((i >> 3) * 8 + hh) * 128;
    const int o0 = ((q ^ hh) * 16), o1 = (((4 + q) ^ hh) * 16);
    f32x4 keep = {0.f, 0.f, 0.f, 0.f};
#pragma unroll
    for (int G = 0; G < 8; ++G) { f32x4 acc = {0.f, 0.f, 0.f, 0.f}; const LAS unsigned char* rg = rb + G * 2048;
        const u32x4 a0 = *(const LAS u32x4*)(rg + o0), a1 = *(const LAS u32x4*)(rg + o1);
        const i32x8_u A0 = {(int)a0.x, (int)a0.y, (int)a0.z, (int)a0.w, 0, 0, 0, 0}, A1 = {(int)a1.x, (int)a1.y, (int)a1.z, (int)a1.w, 0, 0, 0, 0};
        acc = __builtin_amdgcn_mfma_scale_f32_16x16x128_f8f6f4(A0, b0, acc, 4, 0, 0, 127, 0, 127);
        acc = __builtin_amdgcn_mfma_scale_f32_16x16x128_f8f6f4(A1, b1, acc, 4, 0, 0, 127, 0, 127);
        if (i == G) keep = acc; }
    if (i < 8) { u32x2 o; o.x = pk2(keep[0], keep[1]); o.y = pk2(keep[2], keep[3]);
        pub8(PDt + (2 * i + (q >> 1)) * 8 + 4 * (q & 1), o); }
}
__device__ __forceinline__ void u4_item(const Ctx& c, int s, int tb) {
    const unsigned char* XQ = c.ws + WS_RB + 64 * MiB + 256 * s; const unsigned short* EID = (const unsigned short*)(c.ws + WS_EID);
    bf16* PD = (bf16*)(c.ws + WS_RA) + (size_t)s * ML * 128;
    const int lane = c.lane, h = lane >> 3, cc = lane & 7, q = lane >> 4;
    const unsigned char* Us = c.ws + WS_RC + 64 * MiB + (size_t)s * (16384 * 128) + 16 * cc;
    LAS unsigned char* stg = (LAS unsigned char*)c.lds + c.wave * 16384;
    const int t0 = tb * (8 * TPW) + c.wave * TPW;
    const unsigned short* Eh = EID + 16 * h; const unsigned char* Xq = XQ + 16 * q;
#define LD_E(dst0, dst1, t) { dst0 = *(const u32x4*)(Eh + (size_t)(t) * 128); dst1 = *(const u32x4*)(Eh + (size_t)(t) * 128 + 8); }
#define LD_X4(d0, d1, d2, d3, t) { d0 = *(const u32x4*)(Xq + (size_t)(t) * DM); d1 = *(const u32x4*)(Xq + (size_t)(t) * DM + 64); d2 = *(const u32x4*)(Xq + (size_t)(t) * DM + 128); d3 = *(const u32x4*)(Xq + (size_t)(t) * DM + 192); }
    SliceBuf bA, bB; u32x4 ea0, ea1, eb0, eb1, ec0, ec1, xa0, xa1, xa2, xa3, xb0, xb1, xb2, xb3;
    LD_E(ea0, ea1, t0) LD_X4(xa0, xa1, xa2, xa3, t0) LD_E(eb0, eb1, t0 + 1)
    slice_load(bA, Us, ea0, ea1);
#pragma unroll 1
    for (int i = 0; i < TPW; i += 2) { const int t = t0 + i; const int t2 = (i + 2 < TPW) ? t + 2 : t, t3 = (i + 3 < TPW) ? t + 3 : t;
        LD_E(ec0, ec1, t2) LD_X4(xb0, xb1, xb2, xb3, t + 1)
        slice_load(bB, Us, eb0, eb1);
        u4_token(bA, xa0, xa1, xa2, xa3, PD + (size_t)t * 128, lane, stg);
        LD_E(eb0, eb1, t3) LD_X4(xa0, xa1, xa2, xa3, t2)
        slice_load(bA, Us, ec0, ec1);
        u4_token(bB, xb0, xb1, xb2, xb3, PD + (size_t)(t + 1) * 128, lane, stg);
    }
#undef LD_X4
#undef LD_E
}
__device__ __forceinline__ float swap32_add(float a, float b) { auto r = __builtin_amdgcn_permlane32_swap(__builtin_bit_cast(unsigned, a), __builtin_bit_cast(unsigned, b), false, false);
    return __builtin_bit_cast(float, (unsigned)r[0]) + __builtin_bit_cast(float, (unsigned)r[1]); }
__device__ __forceinline__ float swap16_add(float a, float b) { auto r = __builtin_amdgcn_permlane16_swap(__builtin_bit_cast(unsigned, a), __builtin_bit_cast(unsigned, b), false, false);
    return __builtin_bit_cast(float, (unsigned)r[0]) + __builtin_bit_cast(float, (unsigned)r[1]); }
__device__ __forceinline__ void v_token(const SliceBuf& B, const f32x4* w4, bf16* POt, float* SSQt, int lane) {
    f32x2_t acc[8];
#pragma unroll
    for (int j = 0; j < 8; ++j) acc[j] = (f32x2_t){0.f, 0.f};
#pragma unroll
    for (int r = 0; r < 16; ++r) { const float w = w4[r >> 2][r & 3]; const f32x2_t ww = {w, w}; const unsigned q[4] = {B.a[r].x, B.a[r].y, B.a[r].z, B.a[r].w};
#pragma unroll
        for (int j = 0; j < 4; ++j) { const f32x2_t lo = __builtin_amdgcn_cvt_pk_f32_fp8((int)q[j], false), hi = __builtin_amdgcn_cvt_pk_f32_fp8((int)q[j], true);
            acc[2 * j] = ww * lo + acc[2 * j]; acc[2 * j + 1] = ww * hi + acc[2 * j + 1]; } }
    float b8[8], c4[4], d2[2];
#pragma unroll
    for (int j = 0; j < 4; ++j) { b8[2 * j] = swap32_add(acc[j].x, acc[j + 4].x); b8[2 * j + 1] = swap32_add(acc[j].y, acc[j + 4].y); }
#pragma unroll
    for (int j = 0; j < 4; ++j) c4[j] = swap16_add(b8[j], b8[j + 4]);
    const bool b3 = (lane >> 3) & 1;
#pragma unroll
    for (int j = 0; j < 2; ++j) { const float keep = b3 ? c4[j + 2] : c4[j], send = b3 ? c4[j] : c4[j + 2]; d2[j] = keep + dpp_f<0x128>(send); }
    const int col = 8 * (lane >> 5) + 4 * ((lane >> 4) & 1) + 2 * ((lane >> 3) & 1);
    *(unsigned*)(POt + 16 * (lane & 7) + col) = pk2(d2[0], d2[1]);
    const float ss = wave_sum(d2[0] * d2[0] + d2[1] * d2[1]);
    if (lane == 0) *SSQt = ss;
}
__device__ __forceinline__ void v4_token(const SliceBuf& B, const f32x4* w4, bf16* POt, float* SSQt, int lane) {
    f32x2_t acc[16];
#pragma unroll
    for (int j = 0; j < 16; ++j) acc[j] = (f32x2_t){0.f, 0.f};
#pragma unroll
    for (int r = 0; r < 16; ++r) { const float w = w4[r >> 2][r & 3]; const f32x2_t ww = {w, w}; const unsigned q[4] = {B.a[r].x, B.a[r].y, B.a[r].z, B.a[r].w};
#pragma unroll
        for (int j = 0; j < 4; ++j) {
            acc[4 * j]     = ww * __builtin_amdgcn_cvt_scalef32_pk_f32_fp4(q[j], 1.0f, 0) + acc[4 * j];
            acc[4 * j + 1] = ww * __builtin_amdgcn_cvt_scalef32_pk_f32_fp4(q[j], 1.0f, 1) + acc[4 * j + 1];
            acc[4 * j + 2] = ww * __builtin_amdgcn_cvt_scalef32_pk_f32_fp4(q[j], 1.0f, 2) + acc[4 * j + 2];
            acc[4 * j + 3] = ww * __builtin_amdgcn_cvt_scalef32_pk_f32_fp4(q[j], 1.0f, 3) + acc[4 * j + 3]; } }
    float b16[16], c8[8], d4[4];
#pragma unroll
    for (int j = 0; j < 8; ++j) { b16[2 * j] = swap32_add(acc[j].x, acc[j + 8].x); b16[2 * j + 1] = swap32_add(acc[j].y, acc[j + 8].y); }
#pragma unroll
    for (int j = 0; j < 8; ++j) c8[j] = swap16_add(b16[j], b16[j + 8]);
    const bool b3 = (lane >> 3) & 1;
#pragma unroll
    for (int j = 0; j < 4; ++j) { const float keep = b3 ? c8[j + 4] : c8[j], send = b3 ? c8[j] : c8[j + 4]; d4[j] = keep + dpp_f<0x128>(send); }
    const int col = 16 * (lane >> 5) + 8 * ((lane >> 4) & 1) + 4 * ((lane >> 3) & 1);
    u32x2 o; o.x = pk2(d4[0], d4[1]); o.y = pk2(d4[2], d4[3]);
    pub8(POt + 32 * (lane & 7) + col, o);
    const float ss = wave_sum(d4[0] * d4[0] + d4[1] * d4[1] + d4[2] * d4[2] + d4[3] * d4[3]);
    if (lane == 0) pub4(SSQt, ss);
}
typedef int v2i32_t __attribute__((ext_vector_type(2)));
__device__ __forceinline__ void v5_token(const SliceBuf& B, const u32x4& w0, const u32x4& w1, bf16* POt, float* SSQt, int lane, LAS unsigned char* stg) {
    { const int h = lane >> 3, cc = lane & 7;
#pragma unroll
      for (int j = 0; j < 16; ++j) { const u32x4 v = B.a[j]; const u32x4 sw = {v.z, v.w, v.x, v.y};
          *(LAS u32x4*)(stg + (8 * j + h) * 128 + ((cc ^ ((4 * j + (h >> 1)) & 7)) * 16)) = ((j >> 2) & 1) ? sw : v; } }
    const i32x8_u A = {(int)w0.x, (int)w0.y, (int)w0.z, (int)w0.w, (int)w1.x, (int)w1.y, (int)w1.z, (int)w1.w};
    const int l16 = lane & 15, q = lane >> 4, fx = (((l16 >> 1) & 7) * 16) | ((q & 1) * 8);
    const LAS unsigned char* rb = stg + (32 * q + l16) * 128;
    float val[16];
#pragma unroll
    for (int g = 0; g < 16; ++g) {
        const LAS unsigned char* pa = rb + (((g >> 1) * 16 + 8 * (g & 1)) ^ fx);
        const v2i32_t lo = __builtin_amdgcn_ds_read_tr4_b64_v2i32((LAS v2i32_t*)pa), hi = __builtin_amdgcn_ds_read_tr4_b64_v2i32((LAS v2i32_t*)(pa + 2048));
        const i32x8_u Bv = {lo.x, lo.y, hi.x, hi.y, 0, 0, 0, 0};
        f32x4 acc = {0.f, 0.f, 0.f, 0.f};
        acc = __builtin_amdgcn_mfma_scale_f32_16x16x128_f8f6f4(A, Bv, acc, 0, 4, 0, 127, 0, 127);
        val[g] = (acc[0] + acc[1] * (1.f / WLO)) * (1.f / (WSC * USCALE)); }
    float ss = 0.f;
#pragma unroll
    for (int g = 0; g < 16; ++g) ss += val[g] * val[g];
    u32x4 o0, o1; o0.x = pk2(val[0], val[1]); o0.y = pk2(val[2], val[3]); o0.z = pk2(val[4], val[5]); o0.w = pk2(val[6], val[7]);
    o1.x = pk2(val[8], val[9]); o1.y = pk2(val[10], val[11]); o1.z = pk2(val[12], val[13]); o1.w = pk2(val[14], val[15]);
    ss = row16_sum(ss);
    if (PO_FP8) { u32x4 o8; o8.x = pk4_fp8(val[0], val[1], val[2], val[3], POSCALE); o8.y = pk4_fp8(val[4], val[5], val[6], val[7], POSCALE);
        o8.z = pk4_fp8(val[8], val[9], val[10], val[11], POSCALE); o8.w = pk4_fp8(val[12], val[13], val[14], val[15], POSCALE);
        if (lane < 16) __builtin_nontemporal_store(o8, (u32x4*)((unsigned char*)POt + 16 * lane)); }
    else if (lane < 16) { *(u32x4*)(POt + 16 * lane) = o0; *(u32x4*)(POt + 16 * lane + 8) = o1; }
    if (lane == 0) *SSQt = ss;
}
__device__ __forceinline__ void v5_item(const Ctx& c, int s, int tb) {
    const unsigned short* EID = (const unsigned short*)(c.ws + WS_EID); const unsigned char* WQ = c.ws + WS_WW;
    bf16* PO = PO_FP8 ? (bf16*)(c.ws + WS_RA + 256 * s) : (bf16*)(c.ws + WS_RA) + 256 * s; float* SSQ = (float*)(c.ws + WS_SSQ) + (size_t)s * ML;
    const int lane = c.lane, h = lane >> 3, cc = lane & 7;
    const unsigned char* Vs = c.ws + WS_RC + 96 * MiB + (size_t)s * (16384 * 128) + 16 * cc;
    LAS unsigned char* stg = (LAS unsigned char*)c.lds + c.wave * 16384;
    const int t0 = tb * (8 * TPW) + c.wave * TPW;
    const unsigned short* Eh = EID + 16 * h; const unsigned char* Wl = WQ + 128 * (lane & 1) + 32 * (lane >> 4);
#define LD_E(dst0, dst1, t) { dst0 = *(const u32x4*)(Eh + (size_t)(t) * 128); dst1 = *(const u32x4*)(Eh + (size_t)(t) * 128 + 8); }
#define LD_A(dst0, dst1, t) { dst0 = *(const u32x4*)(Wl + (size_t)(t) * 256); dst1 = *(const u32x4*)(Wl + (size_t)(t) * 256 + 16); }
    SliceBuf bA, bB; u32x4 ea0, ea1, eb0, eb1, ec0, ec1, wa0, wa1, wb0, wb1;
    LD_E(ea0, ea1, t0) LD_A(wa0, wa1, t0) LD_E(eb0, eb1, t0 + 1)
    slice_load(bA, Vs, ea0, ea1);
#pragma unroll 1
    for (int i = 0; i < TPW; i += 2) { const int t = t0 + i; const int t2 = (i + 2 < TPW) ? t + 2 : t, t3 = (i + 3 < TPW) ? t + 3 : t;
        LD_E(ec0, ec1, t2) LD_A(wb0, wb1, t + 1)
        slice_load(bB, Vs, eb0, eb1);
        v5_token(bA, wa0, wa1, PO + (size_t)t * (PO_FP8 ? DM / 2 : DM), SSQ + t, lane, stg);
        LD_E(eb0, eb1, t3) LD_A(wa0, wa1, t2)
        slice_load(bA, Vs, ec0, ec1);
        v5_token(bB, wb0, wb1, PO + (size_t)(t + 1) * (PO_FP8 ? DM / 2 : DM), SSQ + t + 1, lane, stg);
    }
#undef LD_A
#undef LD_E
}
#ifndef LD_E
#define LD_E(dst0, dst1, t) { dst0 = *(const u32x4*)(Eh + (size_t)(t) * 128); dst1 = *(const u32x4*)(Eh + (size_t)(t) * 128 + 8); }
#endif
__device__ __forceinline__ void v_item(const Ctx& c, int s, int tb) {
    const unsigned short* EID = (const unsigned short*)(c.ws + WS_EID); const float* WW = (const float*)(c.ws + WS_WW);
    bf16* PO = (bf16*)(c.ws + WS_RA) + (V4_TABLE ? 256 : 128) * s; float* SSQ = (float*)(c.ws + WS_SSQ) + (size_t)s * ML;
    const int lane = c.lane, h = lane >> 3, cc = lane & 7;
    const unsigned char* Vs = c.ws + WS_RC + 96 * MiB + (size_t)s * (16384 * 128) + 16 * cc;
    const int t0 = tb * (8 * TPW) + c.wave * TPW;
    const unsigned short* Eh = EID + 16 * h; const float* Wh = WW + 16 * h;
#define LD_W(dst, t) { _Pragma("unroll") for (int j_ = 0; j_ < 4; ++j_) dst[j_] = *(const f32x4*)(Wh + (size_t)(t) * 128 + 4 * j_); }
    SliceBuf bA, bB; u32x4 ea0, ea1, eb0, eb1, ec0, ec1; f32x4 wa[4], wb[4];
    LD_E(ea0, ea1, t0) LD_W(wa, t0) LD_E(eb0, eb1, t0 + 1)
    slice_load(bA, Vs, ea0, ea1);
#pragma unroll 1
    for (int i = 0; i < TPW; i += 2) { const int t = t0 + i; const int t2 = (i + 2 < TPW) ? t + 2 : t, t3 = (i + 3 < TPW) ? t + 3 : t;
        LD_E(ec0, ec1, t2) LD_W(wb, t + 1)
        slice_load(bB, Vs, eb0, eb1);
        if (V4_TABLE) v4_token(bA, wa, PO + (size_t)t * DM, SSQ + t, lane); else v_token(bA, wa, PO + (size_t)t * DM, SSQ + t, lane);
        LD_E(eb0, eb1, t3) LD_W(wa, t2)
        slice_load(bA, Vs, ec0, ec1);
        if (V4_TABLE) v4_token(bB, wb, PO + (size_t)(t + 1) * DM, SSQ + t + 1, lane); else v_token(bB, wb, PO + (size_t)(t + 1) * DM, SSQ + t + 1, lane);
    }
#undef LD_W
#undef LD_E
}
__device__ __forceinline__ void reduce_range(const Ctx& c, int i0, int i1, int st);
__device__ __forceinline__ void final_range(const Ctx& c, int m0, int m1, int st, float* dst);
__device__ __forceinline__ void final_block(const Ctx& c, int m0, int nrows);
constexpr int CW_FINU = 10240, CW_FINV = 11264;
__device__ __forceinline__ bool arrive_last(unsigned* cnt, unsigned need, volatile LAS int* flag) {
    asm volatile("s_waitcnt vmcnt(0)" ::: "memory");
    __syncthreads();
    if (threadIdx.x == 0) {
        const unsigned old = __hip_atomic_fetch_add(cnt, 1u, __ATOMIC_RELAXED, __HIP_MEMORY_SCOPE_AGENT);
        const int last = (old == need - 1u);
        if (last) { __builtin_amdgcn_fence(__ATOMIC_ACQUIRE, "agent"); asm volatile("s_waitcnt vmcnt(0)" ::: "memory"); }
        *flag = last;
    }
    __syncthreads(); const int v = *flag; __syncthreads(); return v != 0;
}
template <int NS> __device__ __forceinline__ int grab_slice_item(unsigned* ctr, int xcc, volatile LAS int* slot) {
    if (threadIdx.x == 0) {
        unsigned head[NS];
#pragma unroll
        for (int s = 0; s < NS; ++s) head[s] = __hip_atomic_load(ctr + 64 * s, __ATOMIC_RELAXED, __HIP_MEMORY_SCOPE_AGENT);
        int res = -1;
#pragma unroll
        for (int so = 0; so < NS; ++so) { const int s = (xcc + so) & (NS - 1);
            unsigned hv = 0u;
#pragma unroll
            for (int k = 0; k < NS; ++k) hv = (k == s) ? head[k] : hv;
            if (res < 0 && hv < (unsigned)NTB) { const unsigned tb = __hip_atomic_fetch_add(ctr + 64 * s, 1u, __ATOMIC_RELAXED, __HIP_MEMORY_SCOPE_AGENT); if (tb < (unsigned)NTB) res = s * 65536 + (int)tb; } }
        *slot = res;
    }
    __syncthreads(); const int v = *slot; __syncthreads(); return v;
}
template <int WHICH> __device__ __forceinline__ void slice_pass(const Ctx& c) {
    unsigned* ctr = (unsigned*)(c.ws + WS_CTL) + (WHICH == 0 ? CW_PEERU : CW_PEERV) + 32 * c.qsel;
    unsigned* fin = (unsigned*)(c.ws + WS_CTL) + (WHICH == 0 ? CW_FINU : CW_FINV) + 512 * c.qsel;
    volatile LAS int* slot = (volatile LAS int*)((LAS unsigned char*)c.lds + MISC_OFF + 64);
    const int xcc = (int)(xb_xcc_id() & 7u);
    constexpr int NS = ((WHICH == 0 && U4_TABLE) || (WHICH == 1 && V4_TABLE)) ? 4 : 8;
    { volatile LAS unsigned* st = (volatile LAS unsigned*)((LAS unsigned char*)c.lds + MISC_OFF) + 8;
      if (STATIC_SLICE_ITEMS && NS == 4 && NTB == 64 && !FUSE_TAIL && c.qsel == 0 && st[3] == 1u) { const int s = xcc & 3, tb = 32 * (xcc >> 2) + (int)st[4];
          if (WHICH == 0) { if (U4_TABLE) u4_item(c, s, tb); else u_item(c, s, tb); } else { if (V5_MFMA) v5_item(c, s, tb); else v_item(c, s, tb); }
          return; } }
    for (;;) { const int it = grab_slice_item<NS>(ctr, xcc, slot); if (it < 0) break;
        const int s = it >> 16, tb = it & 0xffff;
        if (WHICH == 0) { if (U4_TABLE) u4_item(c, s, tb); else u_item(c, s, tb); } else { if (V5_MFMA) v5_item(c, s, tb); else v_item(c, s, tb); }
        if (FUSE_TAIL) { if (arrive_last(fin + tb, (unsigned)NS, slot + 1)) {
            if (WHICH == 0) reduce_range(c, tb * (8 * TPW * 32) + c.tid, (tb + 1) * (8 * TPW * 32), 512);
            else final_block(c, tb * (8 * TPW), 8 * TPW); } } }
}
__device__ __forceinline__ void phase10(const Ctx& c) { slice_pass<0>(c); }
__device__ __forceinline__ void reduce_range(const Ctx& c, int i0, int i1, int st) {
    const bf16* PD = (const bf16*)(c.ws + WS_RA); const float* GT = (const float*)(c.ws + WS_GT); float* WW = (float*)(c.ws + WS_WW);
    const float sc = U4_TABLE ? 1.f / (USCALE * XSCALE) : 1.f / (TSCALE * XSCALE);
#pragma unroll 4
    for (int idx = i0; idx < i1; idx += st) { const int t = idx >> 5, m = idx & 31, j = m >> 1, h0 = 4 * (m & 1);
        f32x4 s = {0.f, 0.f, 0.f, 0.f};
#pragma unroll
        for (int q = 0; q < (U4_TABLE ? 4 : 8); ++q) { const u32x2 w = ((const u32x2*)(PD + (size_t)q * ML * 128))[idx];
            s.x += __uint_as_float(w.x << 16); s.y += __uint_as_float(w.x & 0xffff0000u); s.z += __uint_as_float(w.y << 16); s.w += __uint_as_float(w.y & 0xffff0000u); }
        if (V5_MFMA) {
            float a[4], r[4];
#pragma unroll
            for (int e = 0; e < 4; ++e) a[e] = GT[(size_t)t * 128 + 16 * (h0 + e) + j] * gelu_tanh(s[e] * sc) * WSC;
            const unsigned hi = (unsigned)__builtin_amdgcn_cvt_pk_fp8_f32(a[2], a[3], __builtin_amdgcn_cvt_pk_fp8_f32(a[0], a[1], 0, false), true);
            const f32x2_t d0 = __builtin_amdgcn_cvt_pk_f32_fp8((int)hi, false), d1 = __builtin_amdgcn_cvt_pk_f32_fp8((int)hi, true);
            r[0] = (a[0] - d0.x) * WLO; r[1] = (a[1] - d0.y) * WLO; r[2] = (a[2] - d1.x) * WLO; r[3] = (a[3] - d1.y) * WLO;
            const unsigned lo = (unsigned)__builtin_amdgcn_cvt_pk_fp8_f32(r[2], r[3], __builtin_amdgcn_cvt_pk_fp8_f32(r[0], r[1], 0, false), true);
            unsigned char* wq = (unsigned char*)WW + (size_t)t * 256 + 32 * ((m >> 2) & 3) + 16 * (m >> 4) + 4 * (m & 3);
            *(unsigned*)wq = hi; *(unsigned*)(wq + 128) = lo;
        } else {
#pragma unroll
        for (int e = 0; e < 4; ++e) { const int k = 16 * (h0 + e) + j; WW[(size_t)t * 128 + k] = GT[(size_t)t * 128 + k] * gelu_tanh(s[e] * sc) * (V4_TABLE ? 1.f / USCALE : 1.f / TSCALE); } } }
}
__device__ __forceinline__ void phase11(const Ctx& c) { reduce_range(c, c.gtid, ML * 128 / 4, c.gsz); }
__device__ __forceinline__ void phase12(const Ctx& c) { slice_pass<1>(c); }
__device__ __forceinline__ void final_range(const Ctx& c, int m0, int m1, int st, float* dst = nullptr) {
    const bf16* PO = (const bf16*)(c.ws + WS_RA); const float* SSQ = (const float*)(c.ws + WS_SSQ); float* X1 = c.out; const bf16* X1b = (const bf16*)(c.ws + WS_X1); const float* MOD = (const float*)(c.ws + WS_MOD);
    const float* gpost = c.in[I_GPOSTFFN]; float* O = dst ? dst : X1;
    f32x4 gpo[4];
#pragma unroll
    for (int j = 0; j < 4; ++j) gpo[j] = *(const f32x4*)(gpost + 4 * c.lane + 256 * j);
    for (int m = m0; m < m1; m += 2 * st) {
        const int mb = (m + st < m1) ? m + st : m;
        const float* gt2a = MOD + (m / SEQ) * NMOD + MOD_GT2; const float* gt2b = MOD + (mb / SEQ) * NMOD + MOD_GT2;
        f32x4 gtav[4], gtbv[4];
#pragma unroll
        for (int j = 0; j < 4; ++j) { const int col = 4 * c.lane + 256 * j; gtav[j] = *(const f32x4*)(gt2a + col); gtbv[j] = *(const f32x4*)(gt2b + col); }
        float ssa = 0.f, ssb = 0.f; u32x2 pwa[4], pwb[4], xwa[4], xwb[4];
#pragma unroll
        for (int q = 0; q < (V4_TABLE ? 4 : 8); ++q) { ssa += SSQ[(size_t)q * ML + m]; ssb += SSQ[(size_t)q * ML + mb]; }
#pragma unroll
        for (int j = 0; j < 4; ++j) { const int col = 4 * c.lane + 256 * j;
            if (PO_FP8) { pwa[j].x = *(const unsigned*)((const unsigned char*)PO + (size_t)m * DM + col); pwb[j].x = *(const unsigned*)((const unsigned char*)PO + (size_t)mb * DM + col); pwa[j].y = 0u; pwb[j].y = 0u; }
            else { pwa[j] = *(const u32x2*)(PO + (size_t)m * DM + col); pwb[j] = *(const u32x2*)(PO + (size_t)mb * DM + col); }
            xwa[j] = *(const u32x2*)(X1b + (size_t)m * DM + col); xwb[j] = *(const u32x2*)(X1b + (size_t)mb * DM + col); }
        const float rinva = rsqrtf(ssa * (1.f / DM) + EPS), rinvb = rsqrtf(ssb * (1.f / DM) + EPS);
#pragma unroll
        for (int j = 0; j < 4; ++j) { const int col = 4 * c.lane + 256 * j;
            const f32x4 gg = gpo[j], gta = gtav[j], gtb = gtbv[j];
            f32x4 po, xx;
            if (PO_FP8) { float f_[4]; un4_fp8(pwa[j].x, f_); po.x = f_[0] * (1.f / POSCALE); po.y = f_[1] * (1.f / POSCALE); po.z = f_[2] * (1.f / POSCALE); po.w = f_[3] * (1.f / POSCALE); }
            else { po.x = __uint_as_float(pwa[j].x << 16); po.y = __uint_as_float(pwa[j].x & 0xffff0000u); po.z = __uint_as_float(pwa[j].y << 16); po.w = __uint_as_float(pwa[j].y & 0xffff0000u); }
            xx.x = __uint_as_float(xwa[j].x << 16); xx.y = __uint_as_float(xwa[j].x & 0xffff0000u); xx.z = __uint_as_float(xwa[j].y << 16); xx.w = __uint_as_float(xwa[j].y & 0xffff0000u);
            *(f32x4*)(O + (size_t)m * DM + col) = xx + gta * (po * rinva * gg);
            if (PO_FP8) { float f_[4]; un4_fp8(pwb[j].x, f_); po.x = f_[0] * (1.f / POSCALE); po.y = f_[1] * (1.f / POSCALE); po.z = f_[2] * (1.f / POSCALE); po.w = f_[3] * (1.f / POSCALE); }
            else { po.x = __uint_as_float(pwb[j].x << 16); po.y = __uint_as_float(pwb[j].x & 0xffff0000u); po.z = __uint_as_float(pwb[j].y << 16); po.w = __uint_as_float(pwb[j].y & 0xffff0000u); }
            xx.x = __uint_as_float(xwb[j].x << 16); xx.y = __uint_as_float(xwb[j].x & 0xffff0000u); xx.z = __uint_as_float(xwb[j].y << 16); xx.w = __uint_as_float(xwb[j].y & 0xffff0000u);
            *(f32x4*)(O + (size_t)mb * DM + col) = xx + gtb * (po * rinvb * gg); }
    }
}
__device__ __forceinline__ void phase13(const Ctx& c) { if (PROBE_DBL == 13) final_range(c, c.gw, ML, c.ngw, (float*)(c.ws + WS_RB)); final_range(c, c.gw, ML, c.ngw); }
__device__ __forceinline__ void final_block(const Ctx& c, int m0, int nrows) {
    const bf16* PO = (const bf16*)(c.ws + WS_RA); const float* SSQ = (const float*)(c.ws + WS_SSQ); float* X1 = c.out; const float* MOD = (const float*)(c.ws + WS_MOD);
    const float* gpost = c.in[I_GPOSTFFN]; const float* gt2 = MOD + (m0 / SEQ) * NMOD + MOD_GT2;
    f32x4 gg[4];
#pragma unroll
    for (int j = 0; j < 4; ++j) { const int col = 4 * c.lane + 256 * j; gg[j] = *(const f32x4*)(gpost + col) * *(const f32x4*)(gt2 + col); }
    for (int r0 = c.wave; r0 < nrows; r0 += 32) {
        float ss[4]; u32x2 pw[4][4]; f32x4 xx[4][4];
#pragma unroll
        for (int r = 0; r < 4; ++r) { const int m = m0 + r0 + 8 * r; ss[r] = 0.f;
#pragma unroll
            for (int q = 0; q < (V4_TABLE ? 4 : 8); ++q) ss[r] += SSQ[(size_t)q * ML + m];
#pragma unroll
            for (int j = 0; j < 4; ++j) { const int col = 4 * c.lane + 256 * j; pw[r][j] = *(const u32x2*)(PO + (size_t)m * DM + col); xx[r][j] = *(const f32x4*)(X1 + (size_t)m * DM + col); } }
#pragma unroll
        for (int r = 0; r < 4; ++r) { const int m = m0 + r0 + 8 * r; const float rinv = rsqrtf(ss[r] * (1.f / DM) + EPS);
#pragma unroll
            for (int j = 0; j < 4; ++j) { const int col = 4 * c.lane + 256 * j; f32x4 po;
                po.x = __uint_as_float(pw[r][j].x << 16); po.y = __uint_as_float(pw[r][j].x & 0xffff0000u); po.z = __uint_as_float(pw[r][j].y << 16); po.w = __uint_as_float(pw[r][j].y & 0xffff0000u);
                *(f32x4*)(X1 + (size_t)m * DM + col) = xx[r][j] + gg[j] * (po * rinv); } }
    }
}

constexpr int NPHASE = SLICED_PEER ? (FUSE_TAIL ? 12 : 14) : 10;
__global__ void __launch_bounds__(512, 2) mega(Args args) {
    extern __shared__ __attribute__((aligned(16))) unsigned char lds[];
    Ctx c; c.in = args.in; c.out = args.out; c.ws = args.ws; c.lds = lds;
    c.tid = threadIdx.x; c.lane = c.tid & 63; c.wave = __builtin_amdgcn_readfirstlane(c.tid >> 6);
    c.qsel = 0; c.bid = blockIdx.x; c.nblk = gridDim.x; c.gw = c.bid * 8 + c.wave; c.ngw = c.nblk * 8; c.gtid = c.bid * 512 + c.tid; c.gsz = c.nblk * 512;
    volatile LAS unsigned* MISC = (volatile LAS unsigned*)((LAS unsigned char*)lds + MISC_OFF);
    if (c.tid < 32) MISC[c.tid] = 0u;
    __syncthreads();
    const int lo = args.ph_lo, hi = args.ph_hi;
    XcdBarrier bar; bar.bar = (unsigned*)(args.ws + WS_CTL) + CW_BAR; bar.x = 0; bar.st = nullptr;
    if (hi - lo > 1) bar = xcd_barrier_post((unsigned*)(args.ws + WS_CTL) + CW_BAR, MISC + 8);
#define REFRESH_TID() do { int t_ = threadIdx.x; asm volatile("" : "+v"(t_)); c.tid = t_; c.lane = t_ & 63; c.gtid = c.bid * 512 + t_; } while (0)
#define PHASE(k, fn) if (lo <= (k) && (k) < hi) { if (PROBE_DBL == 5 && (k) == 5) { c.qsel = 1; fn(c); c.qsel = 0; xcd_barrier(bar); } fn(c); if (PROBE_DBL == (k) && (k) != 4 && (k) != 13 && (k) != 5) { xcd_barrier(bar); c.qsel = 1; fn(c); c.qsel = 0; } if ((k) + 1 < hi) { xcd_barrier(bar); if (PROBE_DBL == 99) xcd_barrier(bar); } }
    PHASE(0, phase0)
    PHASE(1, phase1)
    PHASE(2, phase2)
#if FAST_SSD
    PHASE(3, phase3f)
    PHASE(4, phase4f)
    PHASE(5, phase5f)
#else
    PHASE(3, phase3)
    PHASE(4, phase4)
    PHASE(5, phase5)
#endif
    PHASE(6, phase6)
    PHASE(7, phase7)
    PHASE(8, phase8)
    if (PROBE_DBL == 90 || PROBE_DBL == 91) { if (lo <= 8 && 8 < hi) { phase9_probe(c, PROBE_DBL == 90 ? 0x3ffu : 0x3fffu); xcd_barrier(bar); } }
#if SLICED_PEER && FUSE_TAIL
    PHASE(9, phase9s)
    PHASE(10, phase10)
    PHASE(11, phase12)
#elif SLICED_PEER
    PHASE(9, phase9s)
    PHASE(10, phase10)
    PHASE(11, phase11)
    PHASE(12, phase12)
    PHASE(13, phase13)
#else
    PHASE(9, phase9)
#endif
#undef PHASE
}

extern "C" void kernel_launch(void* const* d_in, const int* in_sizes, int n_in, void* d_out, int out_size, void* d_ws, size_t ws_size, hipStream_t stream) {
    static int grid = 0;
    if (grid == 0) {
        if (n_in != 24 || out_size != ML * DM || ws_size < WS_END) { fprintf(stderr, "kernel_launch: unexpected shapes n_in %d out %d ws %zu\n", n_in, out_size, ws_size); grid = -1; return; }
        int dev = 0, cus = 0;
        if (hipGetDevice(&dev) != hipSuccess || hipDeviceGetAttribute(&cus, hipDeviceAttributeMultiprocessorCount, dev) != hipSuccess) { grid = -1; return; }
        if (hipFuncSetAttribute((const void*)mega, hipFuncAttributeMaxDynamicSharedMemorySize, LDS_BYTES) != hipSuccess) { fprintf(stderr, "kernel_launch: hipFuncSetAttribute failed\n"); grid = -1; return; }
        int per_cu = 0;
        if (hipOccupancyMaxActiveBlocksPerMultiprocessor(&per_cu, (const void*)mega, 512, LDS_BYTES) != hipSuccess || per_cu < 1) fprintf(stderr, "kernel_launch: occupancy query says %d\n", per_cu);
        (void)hipGetLastError();
        grid = cus;
    }
    if (grid < 0) return;
    (void)hipMemsetAsync((char*)d_ws + WS_CTL, 0, CTL_ZERO_BYTES, stream);
    Args a{};
    for (int i = 0; i < 24; ++i) a.in[i] = (const float*)d_in[i];
    a.out = (float*)d_out; a.ws = (unsigned char*)d_ws;
#if N_LAUNCH_PER_PHASE
    for (int p = 0; p < NPHASE; ++p) { a.ph_lo = p; a.ph_hi = p + 1; hipLaunchKernelGGL(mega, dim3(grid), dim3(512), LDS_BYTES, stream, a); }
#else
    a.ph_lo = 0; a.ph_hi = NPHASE; hipLaunchKernelGGL(mega, dim3(grid), dim3(512), LDS_BYTES, stream, a);
#endif
}
```
